# Optimizing an MI355X kernel written in HIP

```python
import jax, jax.numpy as jnp
from jax import lax
import numpy as np

D_MODEL = 2048
BATCH = 16
SEQ = 2048
DEPTH = 2

N_ATTN_HEADS = 8
ATTN_HEAD_DIM = 128
ATTN_ROT_DIM = ATTN_HEAD_DIM // 4
ROPE_THETA = 500000.0
Q_BLOCK = 128
TOPK_MAX = 256
N_IDX_HEADS = 16
IDX_HEAD_DIM = 64
IDX_ROT_DIM = IDX_HEAD_DIM // 4
N_RET_HEADS = 8
RET_KEY_DIM = 64
RET_VAL_DIM = 128
RET_CHUNK = 128
RET_THETA = 10000.0
ATTN_WIDTH = N_ATTN_HEADS * ATTN_HEAD_DIM
RET_WIDTH = N_RET_HEADS * RET_VAL_DIM
MIX_WIDTH = ATTN_WIDTH + RET_WIDTH
D_FF = 4 * D_MODEL
PLE_DIM = 256
RMS_EPS = 1e-6
GN_EPS = 1e-5
SPLIT_SIZES = (
    ATTN_WIDTH,
    ATTN_HEAD_DIM,
    ATTN_HEAD_DIM,
    N_IDX_HEADS * IDX_HEAD_DIM,
    IDX_HEAD_DIM,
    N_IDX_HEADS,
    N_RET_HEADS * RET_KEY_DIM,
    N_RET_HEADS * RET_KEY_DIM,
    RET_WIDTH,
    RET_WIDTH,
)
IN_WIDTH = sum(SPLIT_SIZES)

kernel_name = "hymba_dsa_retention_hybrid"


def rmsnorm(x, w):
    xf = x.astype(jnp.float32)
    y = xf * lax.rsqrt(jnp.mean(xf * xf, axis=-1, keepdims=True) + RMS_EPS)
    return (y * w.astype(jnp.float32)).astype(x.dtype)


def rope_tables(positions, rot_dim, theta):
    half = rot_dim // 2
    inv = theta ** (-jnp.arange(half, dtype=jnp.float32) / half)
    ang = positions.astype(jnp.float32)[..., None] * inv
    return jnp.cos(ang), jnp.sin(ang)


def apply_rope(x, cos, sin):
    half = cos.shape[-1]
    if x.ndim == 4:
        cos, sin = cos[:, :, None, :], sin[:, :, None, :]
    cos, sin = cos.astype(x.dtype), sin.astype(x.dtype)
    x1, x2, rest = x[..., :half], x[..., half:2 * half], x[..., 2 * half:]
    return jnp.concatenate([x1 * cos - x2 * sin, x2 * cos + x1 * sin, rest], axis=-1)


def split_columns(z):
    offsets, acc = [], 0
    for s in SPLIT_SIZES[:-1]:
        acc += s
        offsets.append(acc)
    return jnp.split(z, offsets, axis=-1)


def dsa_attention(q, k, v, iq, ik, iw, topk):
    B, S = q.shape[0], q.shape[1]
    nb = S // Q_BLOCK
    key_pos = jnp.arange(S)
    ikf = ik.astype(jnp.float32)
    idx_scale = IDX_HEAD_DIM ** -0.5
    w_scale = N_IDX_HEADS ** -0.5
    attn_scale = ATTN_HEAD_DIM ** -0.5
    gather = jax.vmap(lambda arr, ids: arr[ids])

    def to_blocks(a):
        return a.reshape((B, nb, Q_BLOCK) + a.shape[2:]).swapaxes(0, 1)

    def one_block(args):
        qb, iqb, iwb, qpos = args
        logits = jnp.einsum('bqhd,bsd->bqhs', iqb.astype(jnp.float32), ikf) * idx_scale
        score = jnp.einsum('bqh,bqhs->bqs', iwb.astype(jnp.float32) * w_scale,
                           jax.nn.relu(logits))
        causal = key_pos[None, :] <= qpos[:, None]
        score = jnp.where(causal[None], score, -jnp.inf)
        _, sel = lax.top_k(score, topk)
        k_sel = gather(k, sel)
        v_sel = gather(v, sel)
        valid = sel <= qpos[None, :, None]
        s = jnp.einsum('bqhd,bqkd->bqhk', qb, k_sel).astype(jnp.float32) * attn_scale
        s = jnp.where(valid[:, :, None, :], s, -jnp.inf)
        pr = jax.nn.softmax(s, axis=-1).astype(v.dtype)
        return jnp.einsum('bqhk,bqkd->bqhd', pr, v_sel)

    qpos = jnp.arange(S).reshape(nb, Q_BLOCK)
    out = lax.map(one_block, (to_blocks(q), to_blocks(iq), to_blocks(iw), qpos))
    return out.swapaxes(0, 1).reshape(B, S, N_ATTN_HEADS, ATTN_HEAD_DIM)


def retention(q, k, v):
    B, S, H, dk = q.shape
    dv = v.shape[-1]
    C = RET_CHUNK
    nc = S // C
    gamma = 1.0 - 2.0 ** (-5.0 - jnp.arange(H, dtype=jnp.float32))
    log_g = jnp.log(gamma)
    i = jnp.arange(C, dtype=jnp.float32)
    diff = i[:, None] - i[None, :]
    decay = jnp.where(diff[None] >= 0, jnp.exp(jnp.maximum(diff, 0.0)[None] * log_g[:, None, None]), 0.0)
    zeta = jnp.exp((C - 1.0 - i)[None, :] * log_g[:, None])
    xi = jnp.exp((i + 1.0)[None, :] * log_g[:, None])
    g_chunk = jnp.exp(C * log_g)

    def to_chunks(a):
        return a.astype(jnp.float32).reshape(B, nc, C, H, a.shape[-1]).transpose(1, 0, 3, 2, 4)

    qc = to_chunks(q)
    kc = to_chunks(k) * (dk ** -0.5)
    vc = to_chunks(v)

    def step(R, inp):
        qb, kb, vb = inp
        inner = jnp.einsum('bhid,bhjd->bhij', qb, kb) * decay[None]
        o = (jnp.einsum('bhij,bhjv->bhiv', inner, vb)
             + jnp.einsum('bhid,bhdv->bhiv', qb, R) * xi[None, :, :, None])
        R = g_chunk[None, :, None, None] * R + jnp.einsum(
            'bhjd,bhjv->bhdv', kb * zeta[None, :, :, None], vb)
        return R, o

    R0 = jnp.zeros((B, H, dk, dv), jnp.float32)
    _, o = lax.scan(step, R0, (qc, kc, vc))
    return o.transpose(1, 0, 3, 2, 4).reshape(B, S, H, dv)


def head_groupnorm(o, w):
    mu = jnp.mean(o, axis=-1, keepdims=True)
    var = jnp.mean(jnp.square(o - mu), axis=-1, keepdims=True)
    y = (o - mu) * lax.rsqrt(var + GN_EPS)
    return y.reshape(o.shape[0], o.shape[1], -1) * w.astype(jnp.float32)


def hybrid_layer(h, p_i, rope_attn, rope_idx, rope_ret, w_in, w_out, w_ff1, w_ff2,
                 w_ple, w_ple_gate, pre_mix_norm, post_mix_norm, pre_ff_norm,
                 post_ff_norm, ple_norm, ret_gn, topk):
    B, S, _ = h.shape
    a = rmsnorm(h, pre_mix_norm)
    z = a @ w_in
    aq, ak, av, iq, ik, iw, rq, rk, rv, rg = split_columns(z)
    aq = apply_rope(aq.reshape(B, S, N_ATTN_HEADS, ATTN_HEAD_DIM), *rope_attn)
    ak = apply_rope(ak, *rope_attn)
    iq = apply_rope(iq.reshape(B, S, N_IDX_HEADS, IDX_HEAD_DIM), *rope_idx)
    ik = apply_rope(ik, *rope_idx)
    attn = dsa_attention(aq, ak, av, iq, ik, iw, topk).reshape(B, S, ATTN_WIDTH)

    rq = apply_rope(rq.reshape(B, S, N_RET_HEADS, RET_KEY_DIM), *rope_ret)
    rk = apply_rope(rk.reshape(B, S, N_RET_HEADS, RET_KEY_DIM), *rope_ret)
    rv = rv.reshape(B, S, N_RET_HEADS, RET_VAL_DIM)
    ret = retention(rq, rk, rv)
    ret = (head_groupnorm(ret, ret_gn) * jax.nn.silu(rg.astype(jnp.float32))).astype(h.dtype)

    mix = jnp.concatenate([attn, ret], axis=-1) @ w_out
    h = h + rmsnorm(mix, post_mix_norm)
    m = rmsnorm(h, pre_ff_norm)
    y = jnp.square(jax.nn.relu(m @ w_ff1)) @ w_ff2
    h = h + rmsnorm(y, post_ff_norm)
    e = p_i @ w_ple
    g = jax.nn.sigmoid(h @ w_ple_gate)
    h = h + rmsnorm(g * e, ple_norm)
    return h


def setup_inputs(seed: int = 0) -> dict:
    key = jax.random.key(seed)
    ks = jax.random.split(key, 16)
    f32 = jnp.float32

    def nrm(k, shape, scale):
        return jax.random.normal(k, shape, f32) * scale

    def gain(k, n):
        return 1.0 + 0.02 * jax.random.normal(k, (DEPTH, n), f32)

    return {
        "x": nrm(ks[0], (BATCH, SEQ, D_MODEL), 1.0),
        "p": nrm(ks[1], (DEPTH, BATCH, SEQ, PLE_DIM), 1.0),
        "positions": jnp.broadcast_to(jnp.arange(SEQ, dtype=jnp.int32), (BATCH, SEQ)),
        "w_in": nrm(ks[2], (DEPTH, D_MODEL, IN_WIDTH), D_MODEL ** -0.5),
        "w_out": nrm(ks[3], (DEPTH, MIX_WIDTH, D_MODEL), MIX_WIDTH ** -0.5),
        "w_ff1": nrm(ks[4], (DEPTH, D_MODEL, D_FF), D_MODEL ** -0.5),
        "w_ff2": nrm(ks[5], (DEPTH, D_FF, D_MODEL), D_FF ** -0.5),
        "w_ple": nrm(ks[6], (DEPTH, PLE_DIM, D_MODEL), PLE_DIM ** -0.5),
        "w_ple_gate": nrm(ks[7], (DEPTH, D_MODEL, D_MODEL), D_MODEL ** -0.5),
        "pre_mix_norm": gain(ks[8], D_MODEL),
        "post_mix_norm": gain(ks[9], D_MODEL),
        "pre_ff_norm": gain(ks[10], D_MODEL),
        "post_ff_norm": gain(ks[11], D_MODEL),
        "ple_norm": gain(ks[12], D_MODEL),
        "ret_gn": gain(ks[13], RET_WIDTH),
    }


def reference(x, p, positions, w_in, w_out, w_ff1, w_ff2, w_ple, w_ple_gate,
              pre_mix_norm, post_mix_norm, pre_ff_norm, post_ff_norm, ple_norm, ret_gn):
    seq = x.shape[1]
    topk = min(TOPK_MAX, seq // 4)
    rope_attn = rope_tables(positions, ATTN_ROT_DIM, ROPE_THETA)
    rope_idx = rope_tables(positions, IDX_ROT_DIM, ROPE_THETA)
    rope_ret = rope_tables(positions, RET_KEY_DIM, RET_THETA)
    h = x
    for i in range(DEPTH):
        h = hybrid_layer(h, p[i], rope_attn, rope_idx, rope_ret,
                         w_in[i], w_out[i], w_ff1[i], w_ff2[i], w_ple[i], w_ple_gate[i],
                         pre_mix_norm[i], post_mix_norm[i], pre_ff_norm[i],
                         post_ff_norm[i], ple_norm[i], ret_gn[i], topk)
    return h
```

```cpp
#define MK_N_LAUNCHES 21
#include <hip/hip_runtime.h>
#include <cstdio>
#include <cstdint>

constexpr int NWAVES = 8;
constexpr int BATCH = 16, SEQ = 2048, DM = 2048, DEPTH = 2, M = BATCH * SEQ;
constexpr int NINL = 5456, NINP = 5632, DFF = 8192, PLE = 256;
constexpr float RMS_EPS = 1e-6f, GN_EPS = 1e-5f;
constexpr float QSCALE = 0.08838834764831845f * 1.4426950408889634f;
constexpr float LOG2_THETA_A = 18.931568569324174f, LOG2_THETA_R = 13.287712379549449f;

constexpr size_t MiB = 1u << 20;
constexpr size_t WS_CTL = 0, CTL_ZERO_BYTES = 65536;
constexpr size_t WS_W = 1 * MiB, W_LAYER = 103 * MiB;
constexpr size_t WO_IN = 0, WO_OUT = 22 * MiB, WO_FF1 = 30 * MiB, WO_FF2 = 62 * MiB, WO_PLE = 94 * MiB, WO_GATE = 95 * MiB;
constexpr size_t WS_ROPE = 207 * MiB;
constexpr size_t WS_HB = 221 * MiB, WS_Y = 349 * MiB, WS_SS = 477 * MiB, WS_RS = 481 * MiB, WS_BIG = 482 * MiB;
constexpr size_t BO_AQ = 0, BO_AKV = 64 * MiB, BO_IQ = 80 * MiB, BO_IK = 144 * MiB, BO_IW = 148 * MiB, BO_RQ = 150 * MiB, BO_RK = 182 * MiB,
                 BO_RV = 214 * MiB, BO_RG = 278 * MiB, BO_MIX = 342 * MiB;
constexpr size_t BO_HID = 0, BO_E = 0, BO_PB = 128 * MiB;
constexpr size_t WS_END = 994 * MiB;
constexpr int ROPE_W = 112;
constexpr int CW_BAR = 4096, CW_Q = 8192;
constexpr int RING_OFF = 0, RING_BYTES = 131072;
constexpr int LDSCTL_OFF = RING_BYTES, MISC_OFF = LDSCTL_OFF + 320;
constexpr int LDS_BYTES = 147456;
static_assert(MISC_OFF + 128 <= LDS_BYTES, "LDS map");
namespace pg8 {
#define PG8_LAS __attribute__((address_space(3)))
typedef unsigned short bf16_t;
typedef short bf16x8 __attribute__((ext_vector_type(8)));
typedef float f32x4 __attribute__((ext_vector_type(4)));
typedef unsigned u32x4 __attribute__((ext_vector_type(4)));
constexpr int BM = 256, BK = 64, HALF = 128, HTB = HALF * BK * 2  , STAGE_BYTES = 8 * HTB, NXCD = 8, WGM = 8;

__host__ __device__ __forceinline__ int lds_byte(int r, int c) { const int st = (r >> 4) * 2 + (c >> 5), rr = r & 15, cc = c & 31, ob = rr * 64 + cc * 2; return st * 1024 + (ob ^ (((ob >> 9) & 1) << 5)); }
__host__ __device__ __forceinline__ void stage_rc(int b, int& R, int& C) { const int st = b / 1024, sb = b % 1024, swz = sb ^ (((sb >> 9) & 1) << 5); R = (st >> 1) * 16 + swz / 64; C = (st & 1) * 32 + (swz % 64) / 2; }
__host__ __device__ __forceinline__ int perm32(int rho) { const int n = rho >> 4, i = rho & 15; return 8 * (i >> 2) + 4 * n + (i & 3); }

struct Unit { int pm, pn; };
struct Gemm { const bf16_t* A; const bf16_t* Bt; int M, N, K; };

struct StaticOrder {
    int nM, nN, nwg, G, c;
    __host__ __device__ void init(int M, int N, int G_, int c_) { nM = M / BM; nN = N / BM; nwg = nM * nN; G = G_; c = c_; }
    __host__ __device__ bool next(int i, Unit& u) const {
        const long L = (long)i * G + c; if (L >= nwg) return false;
        int wgid = (int)L; { const int q = nwg / NXCD, r = nwg % NXCD, xcd = wgid % NXCD, off = wgid / NXCD; wgid = (xcd < r ? xcd * (q + 1) : r * (q + 1) + (xcd - r) * q) + off; }
        const int nig = WGM * nN, gid = wgid / nig, fm = gid * WGM, gsz = (nM - fm) < WGM ? (nM - fm) : WGM;
        u.pm = fm + ((wgid % nig) % gsz); u.pn = (wgid % nig) / gsz; return true;
    }
    __device__ __forceinline__ void a_ready(const Unit&) const {}
    __device__ __forceinline__ void done(const Unit&) const {}
};
__device__ __forceinline__ unsigned cvt_pk_bf16(float lo, float hi) { unsigned r; asm volatile("v_cvt_pk_bf16_f32 %0, %1, %2" : "=v"(r) : "v"(lo), "v"(hi)); return r; }
typedef float f32x2 __attribute__((ext_vector_type(2)));

__device__ __forceinline__ u32x4 pack8(const f32x4& v0, const f32x4& v1) { u32x4 w; w.x = cvt_pk_bf16(v0[0], v0[1]); w.y = cvt_pk_bf16(v0[2], v0[3]); w.z = cvt_pk_bf16(v1[0], v1[1]); w.w = cvt_pk_bf16(v1[2], v1[3]); return w; }
__device__ __forceinline__ float bf_lo(unsigned w) { return __uint_as_float(w << 16); }
__device__ __forceinline__ float bf_hi(unsigned w) { return __uint_as_float(w & 0xffff0000u); }
__device__ __forceinline__ float fast_sigmoid(float x) { return __builtin_amdgcn_rcpf(1.0f + __builtin_amdgcn_exp2f(-1.4426950408889634f * x)); }
__device__ __forceinline__ float log2_gamma(int h) { const float e = __builtin_amdgcn_exp2f(-5.0f - (float)h); return -(e * (1.0f + e * (0.5f + e * (0.33333333f + e * (0.25f + e * 0.2f))))) * 1.4426950408889634f; }

struct EpiIn {
    static constexpr bool PERM = true, AFTER_DRAIN = false;
    unsigned char* big; const float* RS; const float* ROPE;
    __device__ __forceinline__ void operator()(const f32x4 (&acc)[2][2][4][2], const Unit& u, int wr, int wc, int fr_, int fq_) const {
        int fr = fr_, fq = fq_; asm volatile("" : "+v"(fr), "+v"(fq));
        const int pn = u.pn;
#pragma unroll
        for (int bj = 0; bj < 2; ++bj) {
            const int c256 = 128 * bj + 32 * wc + 8 * fq;
            size_t dofs = 0; bool has = false; int ldc = 0, dcol = 0; bool rot = false; int coff = 0, soff = 0; float scale = 1.f; int mode = 0;
            float lg = 0.f;
            if (pn < 4)       { dofs = BO_AQ; has = true; ldc = 1024; dcol = pn * 256 + c256;        rot = (wc == 0); coff = 4 * fq; soff = 16 + 4 * fq; scale = QSCALE; }
            else if (pn == 4) { dofs = BO_AKV; has = true; ldc = 256;  dcol = c256;                   rot = (bj == 0 && wc == 0); coff = 4 * fq; soff = 16 + 4 * fq; }
            else if (pn < 9)  { dofs = BO_IQ; has = true; ldc = 1024; dcol = (pn - 5) * 256 + c256;  rot = ((wc & 1) == 0 && fq < 2); coff = 32 + 4 * fq; soff = 40 + 4 * fq; }
            else if (pn == 9) { if (bj == 0 && wc < 2) { dofs = BO_IK; has = true; ldc = 64; dcol = c256; rot = (wc == 0 && fq < 2); coff = 32 + 4 * fq; soff = 40 + 4 * fq; }
                                else if (bj == 0 && wc == 2 && fq < 2) { mode = 3; } }
            else if (pn < 12) { dofs = BO_RQ; has = true; ldc = 512;  dcol = (pn - 10) * 256 + c256; rot = true; coff = 48 + 16 * (wc & 1) + 4 * fq; soff = 80 + 16 * (wc & 1) + 4 * fq; }
            else if (pn < 14) { dofs = BO_RK; has = true; ldc = 512;  dcol = (pn - 12) * 256 + c256; rot = true; coff = 48 + 16 * (wc & 1) + 4 * fq; soff = 80 + 16 * (wc & 1) + 4 * fq; scale = 0.125f; mode = 2;
                                lg = log2_gamma(4 * (pn - 12) + 2 * bj + (wc >> 1)); }
            else if (pn < 18) { dofs = BO_RV; has = true; ldc = 1024; dcol = (pn - 14) * 256 + c256; }
            else              { dofs = BO_RG; has = true; ldc = 1024; dcol = (pn - 18) * 256 + c256; mode = 1; }
            if (!has && mode != 3) continue;
            bf16_t* dst = (bf16_t*)(big + dofs); float* IW = (float*)(big + BO_IW);
#pragma unroll
            for (int ai = 0; ai < 2; ++ai)
#pragma unroll
                for (int m = 0; m < 4; ++m) {
                    const int row = u.pm * BM + ai * HALF + wr * 64 + m * 16 + fr;
                    float sc = RS[row] * scale;
                    if (mode == 2) sc *= __builtin_amdgcn_exp2f((float)(127 - (row & 127)) * lg);
                    f32x4 v0 = acc[ai][bj][m][0], v1 = acc[ai][bj][m][1];
                    if (rot) { const float* rp = ROPE + (size_t)row * ROPE_W; const f32x4 cs = *(const f32x4*)(rp + coff), sn = *(const f32x4*)(rp + soff);
                        const f32x4 a = v0 * cs - v1 * sn, b = v1 * cs + v0 * sn; v0 = a; v1 = b; }
                    v0 = v0 * sc; v1 = v1 * sc;
                    if (mode == 1) {
#pragma unroll
                        for (int j = 0; j < 4; ++j) { v0[j] = v0[j] * fast_sigmoid(v0[j]); v1[j] = v1[j] * fast_sigmoid(v1[j]); } }
                    if (mode == 3) { float* p = IW + (size_t)row * 16 + 8 * fq; *(f32x4*)p = v0; *(f32x4*)(p + 4) = v1; }
                    else *(u32x4*)(dst + (size_t)row * ldc + dcol) = pack8(v0, v1);
                    asm volatile("" ::: "memory");
                }
        }
    }
};
struct EpiY {
    static constexpr bool PERM = true, AFTER_DRAIN = false;
    bf16_t* Y; float* SS; const bf16_t* E;
    __device__ __forceinline__ void operator()(const f32x4 (&acc)[2][2][4][2], const Unit& u, int wr, int wc, int fr_, int fq_) const {
        int fr = fr_, fq = fq_; asm volatile("" : "+v"(fr), "+v"(fq));
        const int col0 = u.pn * BM + wc * 32 + 8 * fq;
#pragma unroll
        for (int ai = 0; ai < 2; ++ai)
#pragma unroll
            for (int m = 0; m < 4; ++m) {
                const int row = u.pm * BM + ai * HALF + wr * 64 + m * 16 + fr; float q = 0.f;
#pragma unroll
                for (int bj = 0; bj < 2; ++bj) {
                    f32x4 v0 = acc[ai][bj][m][0], v1 = acc[ai][bj][m][1];
                    if (E) { const u32x4 e = *(const u32x4*)(E + (size_t)row * DM + col0 + bj * HALF);
                        v0[0] = fast_sigmoid(v0[0]) * bf_lo(e.x); v0[1] = fast_sigmoid(v0[1]) * bf_hi(e.x); v0[2] = fast_sigmoid(v0[2]) * bf_lo(e.y); v0[3] = fast_sigmoid(v0[3]) * bf_hi(e.y);
                        v1[0] = fast_sigmoid(v1[0]) * bf_lo(e.z); v1[1] = fast_sigmoid(v1[1]) * bf_hi(e.z); v1[2] = fast_sigmoid(v1[2]) * bf_lo(e.w); v1[3] = fast_sigmoid(v1[3]) * bf_hi(e.w); }
                    q += (v0[0] * v0[0] + v0[1] * v0[1]) + (v0[2] * v0[2] + v0[3] * v0[3]) + (v1[0] * v1[0] + v1[1] * v1[1]) + (v1[2] * v1[2] + v1[3] * v1[3]);
                    *(u32x4*)(Y + (size_t)row * DM + col0 + bj * HALF) = pack8(v0, v1);
                }
                q += __shfl_xor(q, 16); q += __shfl_xor(q, 32);
                if (fq == 0) SS[(size_t)row * 32 + u.pn * 4 + wc] = q;
            }
    }
};
struct EpiFF1 {
    static constexpr bool PERM = true, AFTER_DRAIN = false;
    bf16_t* H; const float* RS;
    __device__ __forceinline__ void operator()(const f32x4 (&acc)[2][2][4][2], const Unit& u, int wr, int wc, int fr_, int fq_) const {
        int fr = fr_, fq = fq_; asm volatile("" : "+v"(fr), "+v"(fq));
        const int col0 = u.pn * BM + wc * 32 + 8 * fq;
#pragma unroll
        for (int ai = 0; ai < 2; ++ai)
#pragma unroll
            for (int m = 0; m < 4; ++m) {
                const int row = u.pm * BM + ai * HALF + wr * 64 + m * 16 + fr; const float rs = RS[row];
#pragma unroll
                for (int bj = 0; bj < 2; ++bj) {
                    f32x4 v0 = acc[ai][bj][m][0] * rs, v1 = acc[ai][bj][m][1] * rs;
#pragma unroll
                    for (int j = 0; j < 4; ++j) { const float a = fmaxf(v0[j], 0.f), b = fmaxf(v1[j], 0.f); v0[j] = a * a; v1[j] = b * b; }
                    *(u32x4*)(H + (size_t)row * DFF + col0 + bj * HALF) = pack8(v0, v1);
                }
            }
    }
};
struct EpiPlain {
    static constexpr bool PERM = true, AFTER_DRAIN = false;
    bf16_t* O; int ldc;
    __device__ __forceinline__ void operator()(const f32x4 (&acc)[2][2][4][2], const Unit& u, int wr, int wc, int fr_, int fq_) const {
        int fr = fr_, fq = fq_; asm volatile("" : "+v"(fr), "+v"(fq));
        const int col0 = u.pn * BM + wc * 32 + 8 * fq;
#pragma unroll
        for (int ai = 0; ai < 2; ++ai)
#pragma unroll
            for (int m = 0; m < 4; ++m) {
                const int row = u.pm * BM + ai * HALF + wr * 64 + m * 16 + fr;
#pragma unroll
                for (int bj = 0; bj < 2; ++bj) *(u32x4*)(O + (size_t)row * ldc + col0 + bj * HALF) = pack8(acc[ai][bj][m][0], acc[ai][bj][m][1]);
            }
    }
};
template <class Epi, class Sched, bool ALIGN_EPI = false, bool SP2 = false>
__device__ __forceinline__ void gemm_phase(PG8_LAS unsigned char* lds, const Gemm g, const Sched& S, const Epi& E) {
    int tid_ = threadIdx.x; asm volatile("" : "+v"(tid_));
    const int tid = tid_, wid = __builtin_amdgcn_readfirstlane(tid >> 6), lane = tid & 63, wr = wid >> 2, wc = wid & 3, fr = lane & 15, fq = lane >> 4;
    const int K = g.K, nt = K / BK;
    unsigned voffA[2], voffB[2];
#pragma unroll
    for (int i = 0; i < 2; ++i) { int R, C; stage_rc(tid * 16 + i * 8192, R, C); const int Rb = Epi::PERM ? ((R & ~31) + perm32(R & 31)) : R;
        voffA[i] = (unsigned)(R * K + C) * 2u; voffB[i] = (unsigned)(Rb * K + C) * 2u; }
    const size_t kstep = (size_t)(BK * 2);
    const size_t hstep = (size_t)HALF * K * 2;
    const size_t tstep = 2 * hstep;
    const unsigned ldsw = (unsigned)wid * 1024u;
    const int aoff = lds_byte(wr * 64 + fr, fq * 8), boff = lds_byte(wc * 32 + fr, fq * 8);
#define PG8_SA(b, h) (((b) * 2 + (h)) * HTB)
#define PG8_SB(b, h) ((4 + (b) * 2 + (h)) * HTB)
#define PG8_STAGE(bufoff, gbase, voff) do { _Pragma("unroll") for (int _i = 0; _i < 2; ++_i) \
        __builtin_amdgcn_global_load_lds((const unsigned*)((const char*)(gbase) + (voff)[_i]), (PG8_LAS unsigned*)(lds + (bufoff) + ldsw + _i * 8192), 16, 0, 0); } while (0)
#define PG8_LDA(dst, b, h) do { _Pragma("unroll") for (int m = 0; m < 4; ++m) _Pragma("unroll") for (int k = 0; k < 2; ++k) dst[m][k] = *(const PG8_LAS bf16x8*)(lds + PG8_SA(b, h) + aoff + m * 2048 + k * 1024); } while (0)
#define PG8_LDB(dst, b, h) do { _Pragma("unroll") for (int n = 0; n < 2; ++n) _Pragma("unroll") for (int k = 0; k < 2; ++k) dst[n][k] = *(const PG8_LAS bf16x8*)(lds + PG8_SB(b, h) + boff + n * 2048 + k * 1024); } while (0)
#define PG8_MMA(ai, bj, At, Bt) do { __builtin_amdgcn_s_setprio(1); _Pragma("unroll") for (int m = 0; m < 4; ++m) _Pragma("unroll") for (int n = 0; n < 2; ++n) _Pragma("unroll") for (int k = 0; k < 2; ++k) \
        acc[ai][bj][m][n] = __builtin_amdgcn_mfma_f32_16x16x32_bf16(Bt[n][k], At[m][k], acc[ai][bj][m][n], 0, 0, 0); __builtin_amdgcn_s_setprio(0); } while (0)
#define PG8_WAIT_V(n) asm volatile("s_waitcnt vmcnt(" #n ")" ::: "memory")
#define PG8_WAIT_L(n) asm volatile("s_waitcnt lgkmcnt(" #n ")" ::: "memory")
#define PG8_BAR __builtin_amdgcn_s_barrier()
#define PG8_SCHED __builtin_amdgcn_sched_barrier(0)
    Unit cur, nxt; int ui = 0;
    if (!S.next(0, cur)) return;
    f32x4 acc[2][2][4][2];
#pragma unroll
    for (int a = 0; a < 2; ++a)
#pragma unroll
        for (int b = 0; b < 2; ++b)
#pragma unroll
            for (int m = 0; m < 4; ++m)
#pragma unroll
                for (int n = 0; n < 2; ++n) acc[a][b][m][n] = (f32x4){0.f, 0.f, 0.f, 0.f};
    bf16x8 At[4][2], B0[2][2], B1[2][2];
    const char* cA = (const char*)g.A + (size_t)cur.pm * tstep; const char* cB = (const char*)g.Bt + (size_t)cur.pn * tstep;
    S.a_ready(cur);
    if constexpr (SP2) {
        PG8_STAGE(PG8_SB(0, 0), cB, voffB); PG8_STAGE(PG8_SB(0, 1), cB + hstep, voffB); PG8_STAGE(PG8_SA(0, 0), cA, voffA); PG8_STAGE(PG8_SA(0, 1), cA + hstep, voffA);
        if (wr == 1) PG8_BAR;
        PG8_WAIT_V(2); PG8_BAR;
        PG8_STAGE(PG8_SB(1, 0), cB + kstep, voffB); PG8_STAGE(PG8_SA(1, 0), cA + kstep, voffA); PG8_STAGE(PG8_SB(1, 1), cB + hstep + kstep, voffB);
        PG8_WAIT_V(6); PG8_BAR;
    } else {
        PG8_STAGE(PG8_SB(0, 0), cB, voffB); PG8_STAGE(PG8_SA(0, 0), cA, voffA); PG8_STAGE(PG8_SB(0, 1), cB + hstep, voffB); PG8_STAGE(PG8_SA(0, 1), cA + hstep, voffA);
        if (wr == 1) PG8_BAR;
        PG8_WAIT_V(4); PG8_BAR;
        PG8_STAGE(PG8_SB(1, 0), cB + kstep, voffB); PG8_STAGE(PG8_SA(1, 0), cA + kstep, voffA); PG8_STAGE(PG8_SB(1, 1), cB + hstep + kstep, voffB);
        PG8_WAIT_V(6); PG8_BAR;
    }
    for (;;) {
        const bool has_next = S.next(ui + 1, nxt);
        const char* nA = has_next ? (const char*)g.A + (size_t)nxt.pm * tstep : cA; const char* nB = has_next ? (const char*)g.Bt + (size_t)nxt.pn * tstep : cB;
        for (int t = 0; t < nt; t += 2) {
            const bool last = (t == nt - 2);
            const char* a1 = cA + (size_t)(t + 1) * kstep;
            const char* a2 = last ? nA : cA + (size_t)(t + 2) * kstep; const char* b2 = last ? nB : cB + (size_t)(t + 2) * kstep;
            const char* a3 = a2 + kstep; const char* b3 = b2 + kstep;
            if (last && has_next) S.a_ready(nxt);
            if constexpr (SP2) {
            PG8_LDB(B0, 0, 0); PG8_LDB(B1, 0, 1); PG8_SCHED; PG8_LDA(At, 0, 0); PG8_STAGE(PG8_SA(1, 1), a1 + hstep, voffA);
            PG8_WAIT_V(8); PG8_WAIT_L(0); PG8_BAR; PG8_MMA(0, 0, At, B0); PG8_MMA(0, 1, At, B1); PG8_BAR; PG8_SCHED;
            PG8_LDA(At, 0, 1); PG8_STAGE(PG8_SB(0, 0), b2, voffB); PG8_STAGE(PG8_SB(0, 1), b2 + hstep, voffB); PG8_STAGE(PG8_SA(0, 0), a2, voffA);
            PG8_WAIT_V(8); PG8_WAIT_L(0); PG8_BAR; PG8_MMA(1, 0, At, B0); PG8_MMA(1, 1, At, B1); PG8_BAR; PG8_SCHED;
            PG8_LDB(B0, 1, 0); PG8_LDB(B1, 1, 1); PG8_SCHED; PG8_LDA(At, 1, 0); PG8_STAGE(PG8_SA(0, 1), a2 + hstep, voffA);
            PG8_WAIT_V(8); PG8_WAIT_L(0); PG8_BAR; PG8_MMA(0, 0, At, B0); PG8_MMA(0, 1, At, B1); PG8_BAR; PG8_SCHED;
            PG8_LDA(At, 1, 1); PG8_STAGE(PG8_SB(1, 0), b3, voffB); PG8_STAGE(PG8_SB(1, 1), b3 + hstep, voffB); PG8_STAGE(PG8_SA(1, 0), a3, voffA);
            PG8_WAIT_V(8); PG8_WAIT_L(0); PG8_BAR; PG8_MMA(1, 0, At, B0); PG8_MMA(1, 1, At, B1); PG8_BAR; PG8_SCHED;
            } else {
            PG8_LDB(B0, 0, 0); PG8_SCHED; PG8_LDA(At, 0, 0); PG8_STAGE(PG8_SA(1, 1), a1 + hstep, voffA);
            PG8_WAIT_L(8); PG8_BAR; PG8_WAIT_L(0); PG8_MMA(0, 0, At, B0); PG8_BAR; PG8_SCHED;
            PG8_LDB(B1, 0, 1); PG8_STAGE(PG8_SB(0, 0), b2, voffB);
            PG8_BAR; PG8_WAIT_L(0); PG8_MMA(0, 1, At, B1); PG8_BAR;
            PG8_LDA(At, 0, 1); PG8_STAGE(PG8_SA(0, 0), a2, voffA);
            PG8_BAR; PG8_WAIT_L(0); PG8_MMA(1, 0, At, B0); PG8_BAR; PG8_SCHED;
            PG8_STAGE(PG8_SB(0, 1), b2 + hstep, voffB);
            PG8_WAIT_V(6); PG8_BAR; PG8_MMA(1, 1, At, B1); PG8_BAR;
            PG8_LDB(B0, 1, 0); PG8_SCHED; PG8_LDA(At, 1, 0); PG8_STAGE(PG8_SA(0, 1), a2 + hstep, voffA);
            PG8_WAIT_L(8); PG8_BAR; PG8_WAIT_L(0); PG8_MMA(0, 0, At, B0); PG8_BAR; PG8_SCHED;
            PG8_LDB(B1, 1, 1); PG8_STAGE(PG8_SB(1, 0), b3, voffB);
            PG8_BAR; PG8_WAIT_L(0); PG8_MMA(0, 1, At, B1); PG8_BAR;
            PG8_LDA(At, 1, 1); PG8_STAGE(PG8_SA(1, 0), a3, voffA);
            PG8_BAR; PG8_WAIT_L(0); PG8_MMA(1, 0, At, B0); PG8_BAR; PG8_SCHED;
            PG8_STAGE(PG8_SB(1, 1), b3 + hstep, voffB);
            PG8_WAIT_V(6); PG8_BAR; PG8_MMA(1, 1, At, B1); PG8_BAR;
            }
        }
        if constexpr (ALIGN_EPI) { if (wr == 0) PG8_BAR; }
        if constexpr (!Epi::AFTER_DRAIN) { E(acc, cur, wr, wc, fr, fq); S.done(cur); }
        if (!has_next) break;
#pragma unroll
        for (int a = 0; a < 2; ++a)
#pragma unroll
            for (int b = 0; b < 2; ++b)
#pragma unroll
                for (int m = 0; m < 4; ++m)
#pragma unroll
                    for (int n = 0; n < 2; ++n) acc[a][b][m][n] = (f32x4){0.f, 0.f, 0.f, 0.f};
        cur = nxt; cA = nA; cB = nB; ++ui;
        if constexpr (ALIGN_EPI) { if (wr == 1) PG8_BAR; }
    }
    PG8_WAIT_V(0);
    if constexpr (!ALIGN_EPI) { if (wr == 0) PG8_BAR; }
    PG8_BAR;
    if constexpr (Epi::AFTER_DRAIN) { E.fused(acc, cur, wr, wc, fr, fq, lds, wid, lane); S.done(cur); }
#undef PG8_SA
#undef PG8_SB
#undef PG8_STAGE
#undef PG8_LDA
#undef PG8_LDB
#undef PG8_MMA
#undef PG8_WAIT_V
#undef PG8_WAIT_L
#undef PG8_BAR
#undef PG8_SCHED
}
}
#define GAS __attribute__((address_space(1)))
#define LAS __attribute__((address_space(3)))
typedef unsigned short bf16;
typedef unsigned v4u __attribute__((ext_vector_type(4)));
typedef float f32x4 __attribute__((ext_vector_type(4)));
typedef short bf16x8 __attribute__((ext_vector_type(8)));
typedef GAS unsigned gu32;
typedef GAS unsigned long long gu64;
#define RLX_AGENT __ATOMIC_RELAXED, __HIP_MEMORY_SCOPE_AGENT
#define LDS_WAIT() asm volatile("s_waitcnt lgkmcnt(0)" ::: "memory")
#define VM_WAIT() asm volatile("s_waitcnt vmcnt(0)" ::: "memory")
__device__ __forceinline__ unsigned long long rt() { return __builtin_amdgcn_s_memrealtime(); }
__device__ __forceinline__ unsigned f2bf(float f) { unsigned u = __builtin_bit_cast(unsigned, f); return (u + 0x7fffu + ((u >> 16) & 1u)) >> 16; }
__device__ __forceinline__ unsigned pk2(float lo, float hi) { return f2bf(lo) | (f2bf(hi) << 16); }

#define XB_TMO      128
#define XB_XCNT(j)  (256  + 64 * (j))
#define XB_XSUB(j)  (1280 + 64 * (j))
#define XB_XGEN(j)  (2304 + 64 * (j))
#define XB_TOP      3328
#define XB_TOPGEN   3392
#define XCD_BAR_WORDS 3456
#define XB_SPIN_CAP (1u << 22)

__device__ __forceinline__ unsigned xb_ld(unsigned* p)              { return __hip_atomic_load(p, __ATOMIC_RELAXED, __HIP_MEMORY_SCOPE_AGENT); }
__device__ __forceinline__ unsigned xb_add(unsigned* p, unsigned v) { return __hip_atomic_fetch_add(p, v, __ATOMIC_RELAXED, __HIP_MEMORY_SCOPE_AGENT); }
__device__ __forceinline__ unsigned xb_xcc_id() { return (unsigned)__builtin_amdgcn_s_getreg((3 << 11) | 20) & 0xFu; }
#define XB_SPIN(cond, bar) do { unsigned _sp = 0; while (cond) { __builtin_amdgcn_s_sleep(1); \
    if ((++_sp & 255u) == 0u) { if (xb_ld(&(bar)[XB_TMO])) break; if (_sp > XB_SPIN_CAP) { atomicAdd(&(bar)[XB_TMO], 1u); break; } } } } while (0)

struct XcdBarrier {
    unsigned* bar; unsigned x;
    volatile LAS unsigned* st;
};

__device__ __forceinline__ XcdBarrier xcd_barrier_post(unsigned* bar, volatile LAS unsigned* st) {
    XcdBarrier b; b.bar = bar; b.x = xb_xcc_id(); b.st = st;
    if (threadIdx.x == 0) (void)xb_add(&bar[XB_XCNT(b.x)], 1u);
    return b;
}
__device__ __forceinline__ void xcd_barrier_complete(unsigned* bar, unsigned x, unsigned& nloc, unsigned& nx) {
    const unsigned G = gridDim.x * gridDim.y * gridDim.z;
    unsigned sum, cnt, mine, sp = 0u;
    for (;;) {
        sum = 0u; cnt = 0u; mine = 0u;
#pragma unroll
        for (unsigned j = 0; j < 16; ++j) { const unsigned c = xb_ld(&bar[XB_XCNT(j)]); sum += c; cnt += (c > 0u) ? 1u : 0u; mine = (j == x) ? c : mine; }
        if (sum == G) break;
        __builtin_amdgcn_s_sleep(1);
        if ((++sp & 255u) == 0u) { if (xb_ld(&bar[XB_TMO])) break; if (sp > XB_SPIN_CAP) { atomicAdd(&bar[XB_TMO], 1u); break; } }
    }
    nloc = mine > 0u ? mine : 1u; nx = cnt > 0u ? cnt : 1u;
}

__device__ __forceinline__ void xcd_barrier(const XcdBarrier& b) {
    asm volatile("s_waitcnt vmcnt(0)" ::: "memory");
    __syncthreads();
    if (threadIdx.x == 0) {
        unsigned* bar = b.bar;
        __builtin_amdgcn_s_waitcnt(0);
        unsigned nloc = b.st[0], nx = b.st[1];
        if (nloc == 0u) { xcd_barrier_complete(bar, b.x, nloc, nx); b.st[0] = nloc; b.st[1] = nx; }
        const unsigned old = xb_add(&bar[XB_XSUB(b.x)], 1u);
        const unsigned gen = old / nloc;
        if (old + 1u == (gen + 1u) * nloc) {
            __builtin_amdgcn_fence(__ATOMIC_RELEASE, "agent");
            asm volatile("s_waitcnt vmcnt(0)" ::: "memory");
            const unsigned og = xb_add(&bar[XB_TOP], 1u);
            const unsigned tg = og / nx;
            if (og + 1u == (tg + 1u) * nx) xb_add(&bar[XB_TOPGEN], 1u);
            else XB_SPIN(xb_ld(&bar[XB_TOPGEN]) == tg, bar);
            __builtin_amdgcn_fence(__ATOMIC_ACQUIRE, "agent");
            xb_add(&bar[XB_XGEN(b.x)], 1u);
            asm volatile("s_waitcnt vmcnt(0)" ::: "memory");
        } else {
            XB_SPIN(xb_ld(&bar[XB_XGEN(b.x)]) == gen, bar);
            __builtin_amdgcn_fence(__ATOMIC_ACQUIRE, "agent");
            asm volatile("s_waitcnt vmcnt(0)" ::: "memory");
        }
    }
    __syncthreads();
}

typedef unsigned u32x4 __attribute__((ext_vector_type(4)));
typedef unsigned u32x2 __attribute__((ext_vector_type(2)));
typedef short s16x4 __attribute__((ext_vector_type(4)));
typedef float f32x2t __attribute__((ext_vector_type(2)));
typedef __bf16 bf16x2t __attribute__((ext_vector_type(2)));
#define DI __device__ __forceinline__
DI unsigned cvtpk(float lo, float hi) { f32x2t v = {lo, hi}; bf16x2t b = __builtin_convertvector(v, bf16x2t); return __builtin_bit_cast(unsigned, b); }
DI float bflo(unsigned w) { return __uint_as_float(w << 16); }
DI float bfhi(unsigned w) { return __uint_as_float(w & 0xffff0000u); }
DI s16x4 tr_read(LAS unsigned char* p) { return __builtin_bit_cast(s16x4, __builtin_amdgcn_ds_read_tr16_b64_v4i16((LAS s16x4*)p)); }
DI bf16x8 cat8(s16x4 lo, s16x4 hi) { return (bf16x8){lo[0], lo[1], lo[2], lo[3], hi[0], hi[1], hi[2], hi[3]}; }
DI int fresh_tid() { int t = threadIdx.x; asm volatile("" : "+v"(t)); return t; }
#define MFMA16(a, b, c) __builtin_amdgcn_mfma_f32_16x16x32_bf16((a), (b), (c), 0, 0, 0)
DI float wave_sum(float v) {
#pragma unroll
    for (int o = 1; o < 64; o <<= 1) v += __shfl_xor(v, o);
    return v;
}

struct Frame {
    LAS unsigned char* lds;
    volatile LAS unsigned* MISC;
    gu32* ctl;
    int G;
    unsigned char* ws;
    const float* const* in;
};

DI int perm_pairs(int p, int half) {
    const int g = p >> 3, r = p & 7; return (r < 4) ? 4 * g + r : half + 4 * g + (r - 4);
}
DI int inmap(int np) {
    if (np < 1024) { const int head = np >> 7, p = np & 127; return head * 128 + (p < 32 ? perm_pairs(p, 16) : p); }
    if (np < 1280) { const int c = np - 1024; if (c < 128) return 1024 + (c < 32 ? perm_pairs(c, 16) : c); return 1152 + (c - 128); }
    if (np < 2304) { const int q = np - 1280, head = q >> 6, p = q & 63; return 1280 + head * 64 + (p < 16 ? perm_pairs(p, 8) : p); }
    if (np < 2560) { const int c = np - 2304; if (c < 64) return 2304 + (c < 16 ? perm_pairs(c, 8) : c); if (c < 80) return 2368 + (c - 64); return -1; }
    if (np < 3584) { const int q = np - 2560, which = q >> 9, qq = q & 511, head = qq >> 6, p = qq & 63; return (which ? 2896 : 2384) + head * 64 + perm_pairs(p, 32); }
    if (np < 4608) return 3408 + (np - 3584);
    return 4432 + (np - 4608);
}
template <bool INMAP>
DI void transpose_item(const float* W, int K, int N, int NP, bf16* WT, const float* gain, LAS float* scr, int item, int lane) {
    const int nblk = NP / 32, kb = item / nblk, nb = item % nblk, k0 = 64 * kb, n0 = 32 * nb;
    const int np = n0 + (lane & 31); const int L = INMAP ? inmap(np) : np;
#pragma unroll 8
    for (int i = 0; i < 32; ++i) { const int kk = 2 * i + (lane >> 5); float v = 0.f; if (L >= 0) { v = W[(size_t)(k0 + kk) * N + L]; if (gain) v *= gain[k0 + kk]; } scr[kk * 33 + (lane & 31)] = v; }
    LDS_WAIT(); asm volatile("" ::: "memory");
    const int c = lane & 7;
#pragma unroll
    for (int j = 0; j < 4; ++j) { const int n = (lane >> 3) + 8 * j; const LAS float* s = scr + (8 * c) * 33 + n;
        v4u o; o.x = pk2(s[0 * 33], s[1 * 33]); o.y = pk2(s[2 * 33], s[3 * 33]); o.z = pk2(s[4 * 33], s[5 * 33]); o.w = pk2(s[6 * 33], s[7 * 33]);
        *(GAS v4u*)(WT + (size_t)(n0 + n) * K + k0 + 8 * c) = o; }
    LDS_WAIT(); asm volatile("" ::: "memory");
}
DI void sincos_rr(float x, float& s, float& c) {
    const float k = rintf(x * 0.15915494309189535f);
    float r = fmaf(-k, 6.28318548202514648f, x); r = fmaf(-k, -1.74845553e-7f, r);
    const float f = r * 0.15915494309189535f;
    s = __builtin_amdgcn_sinf(f); c = __builtin_amdgcn_cosf(f);
}

DI void p0_prologue(Frame& F, const float* x, const int* positions, const float* w_in, const float* w_out, const float* w_ff1, const float* w_ff2, const float* w_ple, const float* w_gate,
                    const float* pre_mix, const float* pre_ff) {
    const int tid = fresh_tid(), lane = tid & 63, wave = __builtin_amdgcn_readfirstlane(tid >> 6);
    LAS float* scr = (LAS float*)(F.lds + RING_OFF + wave * 16384);
    const int gw = blockIdx.x * NWAVES + wave, NGW = F.G * NWAVES;
    constexpr int I_IN = (DM / 64) * (NINP / 32), I_OUT = (DM / 64) * (DM / 32), I_FF1 = (DM / 64) * (DFF / 32), I_FF2 = (DFF / 64) * (DM / 32), I_PLE = (PLE / 64) * (DM / 32), I_GATE = I_OUT;
    constexpr int PER_LAYER = I_IN + I_OUT + I_FF1 + I_FF2 + I_PLE + I_GATE;
    for (int it = gw; it < DEPTH * PER_LAYER; it += NGW) {
        const int l = it / PER_LAYER; int r = it % PER_LAYER;
        unsigned char* wl = F.ws + WS_W + (size_t)l * W_LAYER;
        if (r < I_IN)  { transpose_item<true >(w_in  + (size_t)l * DM * NINL, DM, NINL, NINP, (bf16*)(wl + WO_IN),  pre_mix + l * DM, scr, r, lane); continue; } r -= I_IN;
        if (r < I_OUT) { transpose_item<false>(w_out + (size_t)l * DM * DM,   DM, DM,  DM,    (bf16*)(wl + WO_OUT), nullptr,          scr, r, lane); continue; } r -= I_OUT;
        if (r < I_FF1) { transpose_item<false>(w_ff1 + (size_t)l * DM * DFF,  DM, DFF, DFF,   (bf16*)(wl + WO_FF1), pre_ff + l * DM,  scr, r, lane); continue; } r -= I_FF1;
        if (r < I_FF2) { transpose_item<false>(w_ff2 + (size_t)l * DFF * DM,  DFF, DM, DM,    (bf16*)(wl + WO_FF2), nullptr,          scr, r, lane); continue; } r -= I_FF2;
        if (r < I_PLE) { transpose_item<false>(w_ple + (size_t)l * PLE * DM,  PLE, DM, DM,    (bf16*)(wl + WO_PLE), nullptr,          scr, r, lane); continue; } r -= I_PLE;
        transpose_item<false>(w_gate + (size_t)l * DM * DM, DM, DM, DM, (bf16*)(wl + WO_GATE), nullptr, scr, r, lane);
    }
    float* rope = (float*)(F.ws + WS_ROPE);
    for (int e = blockIdx.x * (NWAVES * 64) + tid; e < M * 56; e += F.G * NWAVES * 64) {
        const int m = e / 56, i = e % 56; const float pos = (float)positions[m];
        float inv; int co, so;
        if (i < 16)      { inv = __builtin_amdgcn_exp2f(-(float)i * (1.0f / 16.0f) * LOG2_THETA_A);        co = i;             so = 16 + i; }
        else if (i < 24) { inv = __builtin_amdgcn_exp2f(-(float)(i - 16) * (1.0f / 8.0f) * LOG2_THETA_A);  co = 32 + (i - 16); so = 40 + (i - 16); }
        else             { inv = __builtin_amdgcn_exp2f(-(float)(i - 24) * (1.0f / 32.0f) * LOG2_THETA_R); co = 48 + (i - 24); so = 80 + (i - 24); }
        float s, c; sincos_rr(pos * inv, s, c);
        rope[(size_t)m * ROPE_W + co] = c; rope[(size_t)m * ROPE_W + so] = s;
    }
    bf16* HB = (bf16*)(F.ws + WS_HB); float* RS = (float*)(F.ws + WS_RS);
    for (int row = gw; row < M; row += NGW) {
        const GAS f32x4* xr = (const GAS f32x4*)(x + (size_t)row * DM) + lane; GAS u32x2* hb = (GAS u32x2*)(HB + (size_t)row * DM) + lane; float ss = 0.f;
#pragma unroll
        for (int j = 0; j < 8; ++j) { const f32x4 v = xr[64 * j]; ss += (v.x * v.x + v.y * v.y) + (v.z * v.z + v.w * v.w); u32x2 o; o.x = cvtpk(v.x, v.y); o.y = cvtpk(v.z, v.w); hb[64 * j] = o; }
        ss = wave_sum(ss);
        if (lane == 0) RS[row] = 1.0f / sqrtf(ss * (1.0f / DM) + RMS_EPS);
    }
}

DI void thin_phase(Frame& F, const float* hsrc, float* hdst, const float* wpost, const float* pconv) {
    const int tid = fresh_tid(), lane = tid & 63, wave = __builtin_amdgcn_readfirstlane(tid >> 6);
    const int gw = blockIdx.x * NWAVES + wave, NGW = F.G * NWAVES;
    const bf16* Y = (const bf16*)(F.ws + WS_Y); const float* SS = (const float*)(F.ws + WS_SS); bf16* HB = (bf16*)(F.ws + WS_HB); float* RS = (float*)(F.ws + WS_RS);
    bf16* PB = (bf16*)(F.ws + WS_BIG + BO_PB);
    f32x4 w[8];
#pragma unroll
    for (int j = 0; j < 8; ++j) w[j] = *((const GAS f32x4*)wpost + lane + 64 * j);
    for (int row = gw; row < M; row += NGW) {
        float q = (lane < 32) ? SS[(size_t)row * 32 + lane] : 0.f; q = wave_sum(q);
        const float rstd = 1.0f / sqrtf(q * (1.0f / DM) + RMS_EPS);
        const GAS f32x4* hr = (const GAS f32x4*)(hsrc + (size_t)row * DM) + lane; GAS f32x4* ho = (GAS f32x4*)(hdst + (size_t)row * DM) + lane;
        const GAS u32x2* yr = (const GAS u32x2*)(Y + (size_t)row * DM) + lane; GAS u32x2* hb = (GAS u32x2*)(HB + (size_t)row * DM) + lane; float ss = 0.f;
#pragma unroll
        for (int j = 0; j < 8; ++j) { f32x4 h = hr[64 * j]; const u32x2 y = yr[64 * j];
            h.x += bflo(y.x) * rstd * w[j].x; h.y += bfhi(y.x) * rstd * w[j].y; h.z += bflo(y.y) * rstd * w[j].z; h.w += bfhi(y.y) * rstd * w[j].w;
            ss += (h.x * h.x + h.y * h.y) + (h.z * h.z + h.w * h.w); ho[64 * j] = h; u32x2 o; o.x = cvtpk(h.x, h.y); o.y = cvtpk(h.z, h.w); hb[64 * j] = o; }
        ss = wave_sum(ss);
        if (lane == 0) RS[row] = 1.0f / sqrtf(ss * (1.0f / DM) + RMS_EPS);
        if (pconv) { const f32x4 pv = *((const GAS f32x4*)(pconv + (size_t)row * PLE) + lane); u32x2 o; o.x = cvtpk(pv.x, pv.y); o.y = cvtpk(pv.z, pv.w); *((GAS u32x2*)(PB + (size_t)row * PLE) + lane) = o; }
    }
}

constexpr int ATT_WL = 9728;
constexpr int ATT_VSTRIDE = 288, ATT_IDX = 9216;
constexpr int RET_KST = 144, RET_VST = 288, RET_K = 0, RET_V = 128 * RET_KST, RET_R = RET_V + 128 * RET_VST, RET_BYTES = RET_R + 128 * RET_KST;
static_assert(NWAVES * ATT_WL <= RING_BYTES && RET_BYTES <= RING_BYTES, "mixer LDS");
constexpr int N_RET_ITEMS = BATCH * 8, N_ATT_ITEMS = BATCH * (SEQ / NWAVES), N_MIX_ITEMS = N_RET_ITEMS + N_ATT_ITEMS;

DI void attn_query(LAS unsigned char* wl, unsigned char* ws, int b, int t, int lane) {
    const int g = lane >> 4, c = lane & 15;
    const bf16* AQ = (const bf16*)(ws + WS_BIG + BO_AQ); const bf16* AKV = (const bf16*)(ws + WS_BIG + BO_AKV); const bf16* IQ = (const bf16*)(ws + WS_BIG + BO_IQ);
    const bf16* IK = (const bf16*)(ws + WS_BIG + BO_IK); const float* IW = (const float*)(ws + WS_BIG + BO_IW); bf16* MIX = (bf16*)(ws + WS_BIG + BO_MIX);
    const size_t m = (size_t)b * SEQ + t; const size_t brow = (size_t)b * SEQ;
    LAS float* sc = (LAS float*)wl; LAS unsigned short* idx = (LAS unsigned short*)(wl + ATT_IDX);
    const int nk = t + 1; int nsel;
    if (nk > 256) {
        const bf16* iqp = IQ + m * 1024 + c * 64 + 8 * g;
        const bf16x8 a0 = *(const bf16x8*)iqp, a1 = *(const bf16x8*)(iqp + 32);
        const f32x4 w4 = *(const f32x4*)(IW + m * 16 + 4 * g);
        const bf16* ikp = IK + (brow + c) * 64 + 8 * g;
        const int ngrp = (t >> 6) + 1;
        bf16x8 kb[4][2];
#pragma unroll
        for (int j = 0; j < 4; ++j) { kb[j][0] = *(const bf16x8*)(ikp + j * 1024); kb[j][1] = *(const bf16x8*)(ikp + j * 1024 + 32); }
        for (int gi = 0; gi < ngrp; ++gi) {
            bf16x8 kn[4][2];
            const bf16* nx = ikp + (size_t)((gi + 1 < ngrp) ? gi + 1 : gi) * 4096;
#pragma unroll
            for (int j = 0; j < 4; ++j) { kn[j][0] = *(const bf16x8*)(nx + j * 1024); kn[j][1] = *(const bf16x8*)(nx + j * 1024 + 32); }
#pragma unroll
            for (int j = 0; j < 4; ++j) {
                f32x4 d = {0.f, 0.f, 0.f, 0.f};
                d = MFMA16(a0, kb[j][0], d); d = MFMA16(a1, kb[j][1], d);
                float part = w4.x * fmaxf(d.x, 0.f) + w4.y * fmaxf(d.y, 0.f) + w4.z * fmaxf(d.z, 0.f) + w4.w * fmaxf(d.w, 0.f);
                part += __shfl_xor(part, 16); part += __shfl_xor(part, 32);
                const int key = gi * 64 + j * 16 + c;
                if (key > t) part = -INFINITY;
                if (g == 0) sc[key] = part;
            }
#pragma unroll
            for (int j = 0; j < 4; ++j) { kb[j][0] = kn[j][0]; kb[j][1] = kn[j][1]; }
        }
        LDS_WAIT(); __builtin_amdgcn_wave_barrier();
        const int nblk = (nk + 63) >> 6;
        unsigned u[32];
#pragma unroll
        for (int i = 0; i < 32; ++i) { const int k = i * 64 + lane; const unsigned bb = __float_as_uint(sc[k]); const unsigned key = (bb & 0x80000000u) ? ~bb : (bb | 0x80000000u); u[i] = (k < nk) ? key : 0u; }
        unsigned T = 0u;
        for (int bit = 31; bit >= 0; --bit) {
            const unsigned cand = T | (1u << bit); int cnt = 0;
#pragma unroll
            for (int i = 0; i < 32; ++i) if (i < nblk) cnt += __popcll(__ballot(u[i] >= cand));
            if (cnt >= 256) T = cand;
        }
        int cgt = 0;
#pragma unroll
        for (int i = 0; i < 32; ++i) if (i < nblk) cgt += __popcll(__ballot(u[i] > T));
        const int quota = 256 - cgt;
        LDS_WAIT(); __builtin_amdgcn_wave_barrier();
        const unsigned long long lt = (1ull << lane) - 1ull;
        int base = 0, eqrun = 0;
#pragma unroll
        for (int i = 0; i < 32; ++i) if (i < nblk) {
            const bool gt = u[i] > T, eq = u[i] == T;
            const unsigned long long meq = __ballot(eq);
            const int eqrank = eqrun + __popcll(meq & lt);
            const bool sel = gt || (eq && eqrank < quota);
            const unsigned long long ms = __ballot(sel);
            if (sel) idx[base + __popcll(ms & lt)] = (unsigned short)(i * 64 + lane);
            base += __popcll(ms); eqrun += __popcll(meq);
        }
        nsel = 256;
    } else {
#pragma unroll
        for (int r = 0; r < 4; ++r) { const int j = lane + 64 * r; idx[j] = (unsigned short)(j < nk ? j : 0); }
        nsel = nk;
    }
    LDS_WAIT(); __builtin_amdgcn_wave_barrier();
    bf16x8 qf[4];
#pragma unroll
    for (int ks = 0; ks < 4; ++ks) { qf[ks] = (bf16x8){0, 0, 0, 0, 0, 0, 0, 0}; if (c < 8) qf[ks] = *(const bf16x8*)(AQ + m * 1024 + c * 128 + 32 * ks + 8 * g); }
    f32x4 s[16];
#pragma unroll
    for (int kt = 0; kt < 16; ++kt) {
        s[kt] = (f32x4){-INFINITY, -INFINITY, -INFINITY, -INFINITY};
        if (16 * kt < nsel) {
            const int key = idx[16 * kt + c];
            const bf16* kr = AKV + (brow + key) * 256 + 8 * g;
            bf16x8 ka[4];
#pragma unroll
            for (int ks = 0; ks < 4; ++ks) ka[ks] = *(const bf16x8*)(kr + 32 * ks);
            f32x4 d = {0.f, 0.f, 0.f, 0.f};
#pragma unroll
            for (int ks = 0; ks < 4; ++ks) d = MFMA16(ka[ks], qf[ks], d);
#pragma unroll
            for (int r = 0; r < 4; ++r) s[kt][r] = (16 * kt + 4 * g + r < nsel) ? d[r] : -INFINITY;
        }
    }
    float mx = -INFINITY;
#pragma unroll
    for (int kt = 0; kt < 16; ++kt) mx = fmaxf(fmaxf(mx, fmaxf(s[kt][0], s[kt][1])), fmaxf(s[kt][2], s[kt][3]));
    mx = fmaxf(mx, __shfl_xor(mx, 16)); mx = fmaxf(mx, __shfl_xor(mx, 32));
    float l = 0.f;
#pragma unroll
    for (int kt = 0; kt < 16; ++kt)
#pragma unroll
        for (int r = 0; r < 4; ++r) { const float p = __builtin_amdgcn_exp2f(s[kt][r] - mx); s[kt][r] = p; l += p; }
    l += __shfl_xor(l, 16); l += __shfl_xor(l, 32);
    const float inv = 1.0f / l;
    f32x4 o[8];
#pragma unroll
    for (int dt = 0; dt < 8; ++dt) o[dt] = (f32x4){0.f, 0.f, 0.f, 0.f};
    const int q4 = c >> 2, p4 = c & 3;
#pragma unroll
    for (int st = 0; st < 8; ++st) {
        if (32 * st < nsel) {
#pragma unroll
            for (int i = 0; i < 8; ++i) { const int row = 4 * i + g; const int key = idx[32 * st + row];
                const u32x4 v = *(const u32x4*)(AKV + (brow + key) * 256 + 128 + 8 * c); *(LAS u32x4*)(wl + row * ATT_VSTRIDE + 16 * c) = v; }
            LDS_WAIT(); __builtin_amdgcn_wave_barrier();
            u32x4 pw; pw.x = cvtpk(s[2 * st][0], s[2 * st][1]); pw.y = cvtpk(s[2 * st][2], s[2 * st][3]); pw.z = cvtpk(s[2 * st + 1][0], s[2 * st + 1][1]); pw.w = cvtpk(s[2 * st + 1][2], s[2 * st + 1][3]);
            const bf16x8 pb = __builtin_bit_cast(bf16x8, pw);
            LAS unsigned char* vb = wl + (4 * g + q4) * ATT_VSTRIDE + 8 * p4;
#pragma unroll
            for (int dt = 0; dt < 8; ++dt) {
                const s16x4 lo = tr_read(vb + 32 * dt), hi = tr_read(vb + 16 * ATT_VSTRIDE + 32 * dt);
                o[dt] = MFMA16(cat8(lo, hi), pb, o[dt]);
            }
            LDS_WAIT(); __builtin_amdgcn_wave_barrier();
        }
    }
    if (c < 8) {
        bf16* op = MIX + m * 2048 + c * 128 + 4 * g;
#pragma unroll
        for (int dt = 0; dt < 8; ++dt) { u32x2 w; w.x = cvtpk(o[dt][0] * inv, o[dt][1] * inv); w.y = cvtpk(o[dt][2] * inv, o[dt][3] * inv); *(u32x2*)(op + 16 * dt) = w; }
    }
}

DI void ret_chain(Frame& F, int b, int h, const float* gn) {
    LAS unsigned char* lds = F.lds + RING_OFF; unsigned char* ws = F.ws;
    const bf16* RQ = (const bf16*)(ws + WS_BIG + BO_RQ); const bf16* RK = (const bf16*)(ws + WS_BIG + BO_RK); const bf16* RV = (const bf16*)(ws + WS_BIG + BO_RV);
    const bf16* RG = (const bf16*)(ws + WS_BIG + BO_RG); bf16* MIX = (bf16*)(ws + WS_BIG + BO_MIX);
    const int tid = fresh_tid(), lane = tid & 63, w = __builtin_amdgcn_readfirstlane(tid >> 6), g = lane >> 4, c = lane & 15, q4 = c >> 2, p4 = c & 3;
    const float lg = pg8::log2_gamma(h);
    const int i = 16 * w + c;
    const float xi = __builtin_amdgcn_exp2f((float)(i + 1) * lg), fi = __builtin_amdgcn_exp2f((float)(i - 127) * lg), gC = __builtin_amdgcn_exp2f(128.0f * lg);
    f32x4 RT[4];
#pragma unroll
    for (int dt = 0; dt < 4; ++dt) RT[dt] = (f32x4){0.f, 0.f, 0.f, 0.f};
    for (int ch = 0; ch < 16; ++ch) {
        const size_t row0 = (size_t)b * SEQ + 128 * ch;
        __syncthreads();
#pragma unroll
        for (int r = 0; r < 2; ++r) { const int row = (tid >> 3) + 64 * r, ck = tid & 7; *(LAS u32x4*)(lds + RET_K + row * RET_KST + 16 * ck) = *(const u32x4*)(RK + (row0 + row) * 512 + h * 64 + 8 * ck); }
#pragma unroll
        for (int r = 0; r < 4; ++r) { const int row = (tid >> 4) + 32 * r, ck = tid & 15; *(LAS u32x4*)(lds + RET_V + row * RET_VST + 16 * ck) = *(const u32x4*)(RV + (row0 + row) * 1024 + h * 128 + 8 * ck); }
#pragma unroll
        for (int dt = 0; dt < 4; ++dt)
#pragma unroll
            for (int r = 0; r < 4; ++r) *(LAS unsigned short*)(lds + RET_R + (16 * w + 4 * g + r) * RET_KST + 2 * (16 * dt + c)) = (unsigned short)f2bf(RT[dt][r]);
        __syncthreads();
        const bf16* qp = RQ + (row0 + i) * 512 + h * 64 + 8 * g;
        const bf16x8 qb0 = *(const bf16x8*)qp, qb1 = *(const bf16x8*)(qp + 32);
        f32x4 o[8];
#pragma unroll
        for (int vt = 0; vt < 8; ++vt) o[vt] = (f32x4){0.f, 0.f, 0.f, 0.f};
        if (ch > 0) {
#pragma unroll
            for (int vt = 0; vt < 8; ++vt) {
                const LAS unsigned char* rp = lds + RET_R + (16 * vt + c) * RET_KST + 16 * g;
                o[vt] = MFMA16(*(const LAS bf16x8*)rp, qb0, o[vt]); o[vt] = MFMA16(*(const LAS bf16x8*)(rp + 64), qb1, o[vt]);
            }
#pragma unroll
            for (int vt = 0; vt < 8; ++vt) o[vt] = o[vt] * xi;
        }
#pragma unroll
        for (int st = 0; st < 4; ++st) {
            if (2 * st <= w) {
                f32x4 d0 = {0.f, 0.f, 0.f, 0.f}, d1 = {0.f, 0.f, 0.f, 0.f};
                { const LAS unsigned char* kp = lds + RET_K + (32 * st + c) * RET_KST + 16 * g;
                  d0 = MFMA16(*(const LAS bf16x8*)kp, qb0, d0); d0 = MFMA16(*(const LAS bf16x8*)(kp + 64), qb1, d0);
                  d1 = MFMA16(*(const LAS bf16x8*)(kp + 16 * RET_KST), qb0, d1); d1 = MFMA16(*(const LAS bf16x8*)(kp + 16 * RET_KST + 64), qb1, d1); }
#pragma unroll
                for (int r = 0; r < 4; ++r) { const int j0 = 32 * st + 4 * g + r; d0[r] = (j0 <= i) ? d0[r] * fi : 0.f; d1[r] = (j0 + 16 <= i) ? d1[r] * fi : 0.f; }
                u32x4 pw; pw.x = cvtpk(d0[0], d0[1]); pw.y = cvtpk(d0[2], d0[3]); pw.z = cvtpk(d1[0], d1[1]); pw.w = cvtpk(d1[2], d1[3]);
                const bf16x8 pb = __builtin_bit_cast(bf16x8, pw);
                LAS unsigned char* vb = lds + RET_V + (32 * st + 4 * g + q4) * RET_VST + 8 * p4;
#pragma unroll
                for (int vt = 0; vt < 8; ++vt) {
                    const s16x4 lo = tr_read(vb + 32 * vt), hi = tr_read(vb + 16 * RET_VST + 32 * vt);
                    o[vt] = MFMA16(cat8(lo, hi), pb, o[vt]);
                }
            }
        }
        {
            float sm = 0.f;
#pragma unroll
            for (int vt = 0; vt < 8; ++vt) sm += (o[vt][0] + o[vt][1]) + (o[vt][2] + o[vt][3]);
            sm += __shfl_xor(sm, 16); sm += __shfl_xor(sm, 32);
            const float mu = sm * (1.0f / 128.0f); float vq = 0.f;
#pragma unroll
            for (int vt = 0; vt < 8; ++vt) { const f32x4 dd = o[vt] - mu; vq += (dd[0] * dd[0] + dd[1] * dd[1]) + (dd[2] * dd[2] + dd[3] * dd[3]); }
            vq += __shfl_xor(vq, 16); vq += __shfl_xor(vq, 32);
            const float rstd = 1.0f / sqrtf(vq * (1.0f / 128.0f) + GN_EPS);
            const size_t mrow = row0 + i;
#pragma unroll
            for (int vt = 0; vt < 8; ++vt) {
                const int v0 = h * 128 + 16 * vt + 4 * g;
                const f32x4 gw = *(const f32x4*)(gn + v0); const u32x2 gt = *(const u32x2*)(RG + mrow * 1024 + v0);
                const float y0 = (o[vt][0] - mu) * rstd * gw[0] * bflo(gt.x), y1 = (o[vt][1] - mu) * rstd * gw[1] * bfhi(gt.x), y2 = (o[vt][2] - mu) * rstd * gw[2] * bflo(gt.y), y3 = (o[vt][3] - mu) * rstd * gw[3] * bfhi(gt.y);
                u32x2 ow; ow.x = cvtpk(y0, y1); ow.y = cvtpk(y2, y3); *(u32x2*)(MIX + mrow * 2048 + 1024 + v0) = ow;
            }
        }
#pragma unroll
        for (int dt = 0; dt < 4; ++dt) RT[dt] = RT[dt] * gC;
#pragma unroll
        for (int st = 0; st < 4; ++st) {
            LAS unsigned char* vb = lds + RET_V + (32 * st + 8 * g + q4) * RET_VST + 32 * w + 8 * p4;
            const bf16x8 va = cat8(tr_read(vb), tr_read(vb + 4 * RET_VST));
            LAS unsigned char* kp = lds + RET_K + (32 * st + 8 * g + q4) * RET_KST + 8 * p4;
#pragma unroll
            for (int dt = 0; dt < 4; ++dt) { const bf16x8 kbf = cat8(tr_read(kp + 32 * dt), tr_read(kp + 4 * RET_KST + 32 * dt)); RT[dt] = MFMA16(va, kbf, RT[dt]); }
        }
    }
    __syncthreads();
}

DI void mixer_phase(Frame& F, int l, const float* gn) {
    gu32* qctr = F.ctl + CW_Q + 64 * l;
    const int tid = fresh_tid(), lane = tid & 63, wave = __builtin_amdgcn_readfirstlane(tid >> 6);
    for (;;) {
        if (tid == 0) F.MISC[0] = __hip_atomic_fetch_add(qctr, 1u, __ATOMIC_RELAXED, __HIP_MEMORY_SCOPE_AGENT);
        __syncthreads();
        const int item = (int)F.MISC[0];
        __syncthreads();
        if (item >= N_MIX_ITEMS) break;
        if (item < N_RET_ITEMS) ret_chain(F, item >> 3, item & 7, gn);
        else { const int ia = item - N_RET_ITEMS; const int tb = (SEQ / NWAVES - 1) - (ia >> 4), b = ia & 15;
            attn_query(F.lds + RING_OFF + wave * ATT_WL, F.ws, b, tb * NWAVES + wave, lane); }
    }
}

#ifndef MK_N_LAUNCHES
#define MK_N_LAUNCHES 1
#endif
constexpr int NPH = 1 + 10 * DEPTH;
constexpr int N_LAUNCHES = MK_N_LAUNCHES;
static_assert(N_LAUNCHES == 1 || N_LAUNCHES == NPH, "MK_N_LAUNCHES must be 1 or NPH");
struct Args { const void* in[15]; float* out; unsigned char* ws; int ph_lo, ph_hi, li, pad; };

__global__ void __launch_bounds__(NWAVES * 64, 2) hyb_fwd(Args args) {
    extern __shared__ __attribute__((aligned(16))) unsigned char lds[];
    Frame F;
    F.lds = (LAS unsigned char*)lds;
    F.MISC = (volatile LAS unsigned*)(F.lds + MISC_OFF);
    F.G = gridDim.x; F.ws = args.ws; F.ctl = (gu32*)(args.ws + WS_CTL); F.in = nullptr;
    for (int u = threadIdx.x; u < (LDS_BYTES - LDSCTL_OFF) / 4; u += NWAVES * 64) ((LAS unsigned*)(F.lds + LDSCTL_OFF))[u] = 0u;
    __syncthreads();
    XcdBarrier bar; bar.bar = (unsigned*)(F.ctl + CW_BAR); bar.x = 0; bar.st = nullptr;
    if (N_LAUNCHES == 1) bar = xcd_barrier_post((unsigned*)(F.ctl + CW_BAR), F.MISC + 8);
    const int lo = args.ph_lo, hi = args.ph_hi;
#ifndef PHASE_MASK
#define PHASE_MASK 0x7ff
#endif
#define PON(j) (((PHASE_MASK) >> (j)) & 1)
#define IN(k) (lo <= (k) && (k) < hi)
#define SEAM(k) do { if (N_LAUNCHES == 1 && IN(k) && IN((k) + 1)) xcd_barrier(bar); } while (0)
    const float* x = (const float*)args.in[0]; const float* pin = (const float*)args.in[1]; const int* positions = (const int*)args.in[2];
    const float* w_in = (const float*)args.in[3]; const float* w_out = (const float*)args.in[4]; const float* w_ff1 = (const float*)args.in[5]; const float* w_ff2 = (const float*)args.in[6];
    const float* w_ple = (const float*)args.in[7]; const float* w_gate = (const float*)args.in[8]; const float* pre_mix = (const float*)args.in[9]; const float* post_mix = (const float*)args.in[10];
    const float* pre_ff = (const float*)args.in[11]; const float* post_ff = (const float*)args.in[12]; const float* ple_norm = (const float*)args.in[13]; const float* ret_gn = (const float*)args.in[14];
    float* out = args.out; unsigned char* ws = args.ws; unsigned char* big = ws + WS_BIG;
    pg8::bf16_t* HB = (pg8::bf16_t*)(ws + WS_HB); pg8::bf16_t* Y = (pg8::bf16_t*)(ws + WS_Y); float* SS = (float*)(ws + WS_SS); float* RS = (float*)(ws + WS_RS);

    if (PON(0) && IN(0)) p0_prologue(F, x, positions, w_in, w_out, w_ff1, w_ff2, w_ple, w_gate, pre_mix, pre_ff);
    SEAM(0);
    for (int l = 0; l < DEPTH; ++l) {
        const int pb = 1 + 10 * l;
        unsigned char* wl = ws + WS_W + (size_t)l * W_LAYER;
        if (PON(1) && IN(pb + 0)) {
            pg8::Gemm g{HB, (const pg8::bf16_t*)(wl + WO_IN), M, NINP, DM}; pg8::StaticOrder S; S.init(M, NINP, F.G, (int)blockIdx.x);
            pg8::EpiIn E{big, RS, (const float*)(ws + WS_ROPE)};
            pg8::gemm_phase<pg8::EpiIn, pg8::StaticOrder, true, true>(F.lds + RING_OFF, g, S, E);
        }
        SEAM(pb + 0);
        if (PON(2) && IN(pb + 1)) mixer_phase(F, l, ret_gn + (size_t)l * 1024);
        SEAM(pb + 1);
        if (PON(3) && IN(pb + 2)) {
            pg8::Gemm g{(const pg8::bf16_t*)(big + BO_MIX), (const pg8::bf16_t*)(wl + WO_OUT), M, DM, DM}; pg8::StaticOrder S; S.init(M, DM, F.G, (int)blockIdx.x);
            pg8::EpiY E{Y, SS, nullptr};
            pg8::gemm_phase<pg8::EpiY, pg8::StaticOrder, true, true>(F.lds + RING_OFF, g, S, E);
        }
        SEAM(pb + 2);
        if (PON(4) && IN(pb + 3)) thin_phase(F, l == 0 ? x : out, out, post_mix + (size_t)l * DM, nullptr);
        SEAM(pb + 3);
        if (PON(5) && IN(pb + 4)) {
            pg8::Gemm g{HB, (const pg8::bf16_t*)(wl + WO_FF1), M, DFF, DM}; pg8::StaticOrder S; S.init(M, DFF, F.G, (int)blockIdx.x);
            pg8::EpiFF1 E{(pg8::bf16_t*)(big + BO_HID), RS};
            pg8::gemm_phase<pg8::EpiFF1, pg8::StaticOrder, true, true>(F.lds + RING_OFF, g, S, E);
        }
        SEAM(pb + 4);
        if (PON(6) && IN(pb + 5)) {
            pg8::Gemm g{(const pg8::bf16_t*)(big + BO_HID), (const pg8::bf16_t*)(wl + WO_FF2), M, DM, DFF}; pg8::StaticOrder S; S.init(M, DM, F.G, (int)blockIdx.x);
            pg8::EpiY E{Y, SS, nullptr};
            pg8::gemm_phase<pg8::EpiY, pg8::StaticOrder, true, true>(F.lds + RING_OFF, g, S, E);
        }
        SEAM(pb + 5);
        if (PON(7) && IN(pb + 6)) thin_phase(F, out, out, post_ff + (size_t)l * DM, pin + (size_t)l * M * PLE);
        SEAM(pb + 6);
        if (PON(8) && IN(pb + 7)) {
            int kple = PLE; asm volatile("" : "+s"(kple));
            pg8::Gemm g{(const pg8::bf16_t*)(big + BO_PB), (const pg8::bf16_t*)(wl + WO_PLE), M, DM, kple}; pg8::StaticOrder S; S.init(M, DM, F.G, (int)blockIdx.x);
            pg8::EpiPlain E{(pg8::bf16_t*)(big + BO_E), DM};
            pg8::gemm_phase<pg8::EpiPlain, pg8::StaticOrder, true, true>(F.lds + RING_OFF, g, S, E);
        }
        SEAM(pb + 7);
        if (PON(9) && IN(pb + 8)) {
            pg8::Gemm g{HB, (const pg8::bf16_t*)(wl + WO_GATE), M, DM, DM}; pg8::StaticOrder S; S.init(M, DM, F.G, (int)blockIdx.x);
            pg8::EpiY E{Y, SS, (const pg8::bf16_t*)(big + BO_E)};
            pg8::gemm_phase<pg8::EpiY, pg8::StaticOrder, true, true>(F.lds + RING_OFF, g, S, E);
        }
        SEAM(pb + 8);
        if (PON(10) && IN(pb + 9)) thin_phase(F, out, out, ple_norm + (size_t)l * DM, nullptr);
        SEAM(pb + 9);
    }
#undef IN
#undef SEAM
}

extern "C" void kernel_launch(void* const* d_in, const int* in_sizes, int n_in, void* d_out, int out_size, void* d_ws, size_t ws_size, hipStream_t stream) {
    static int grid = 0;
    if (grid == 0) {
        if (n_in != 15 || out_size != M * DM || ws_size < WS_END) { fprintf(stderr, "kernel_launch: unexpected shapes (n_in %d, out %d, ws %zu, need %zu)\n", n_in, out_size, ws_size, (size_t)WS_END); grid = -1; return; }
        int dev = 0, cus = 0, per_cu = 0;
        if (hipGetDevice(&dev) != hipSuccess || hipDeviceGetAttribute(&cus, hipDeviceAttributeMultiprocessorCount, dev) != hipSuccess) { grid = -1; return; }
        if (hipFuncSetAttribute((const void*)hyb_fwd, hipFuncAttributeMaxDynamicSharedMemorySize, LDS_BYTES) != hipSuccess) { fprintf(stderr, "kernel_launch: hipFuncSetAttribute failed\n"); grid = -1; return; }
        if (hipOccupancyMaxActiveBlocksPerMultiprocessor(&per_cu, (const void*)hyb_fwd, NWAVES * 64, LDS_BYTES) != hipSuccess || per_cu < 1)
            fprintf(stderr, "kernel_launch: note: occupancy query reports %d workgroups per CU\n", per_cu);
        (void)hipGetLastError();
        grid = cus;
    }
    if (grid < 0) return;
    if (hipMemsetAsync((char*)d_ws + WS_CTL, 0, CTL_ZERO_BYTES, stream) != hipSuccess) return;
    Args a{};
    for (int i = 0; i < 15; ++i) a.in[i] = d_in[i];
    a.out = (float*)d_out; a.ws = (unsigned char*)d_ws;
    for (int li = 0; li < N_LAUNCHES; ++li) {
        a.ph_lo = (N_LAUNCHES == 1) ? 0 : li; a.ph_hi = (N_LAUNCHES == 1) ? NPH : li + 1; a.li = li; a.pad = 0;
        hipLaunchKernelGGL(hyb_fwd, dim3(grid), dim3(NWAVES * 64), LDS_BYTES, stream, a);
        if (hipPeekAtLastError() != hipSuccess) { fprintf(stderr, "kernel_launch: launch %d failed\n", li); break; }
    }
}
```

```cpp
#include <hip/hip_runtime.h>
#include <cstdio>
#include <cstdint>

constexpr int NWAVES = 8;
constexpr int BATCH = 16, SEQ = 2048, DM = 2048, DEPTH = 2, M = BATCH * SEQ;
constexpr int NINL = 5456, NINP = 5632, DFF = 8192, PLE = 256;
constexpr float RMS_EPS = 1e-6f, GN_EPS = 1e-5f;
constexpr float QSCALE = 0.08838834764831845f * 1.4426950408889634f;
constexpr float LOG2_THETA_A = 18.931568569324174f, LOG2_THETA_R = 13.287712379549449f;

constexpr size_t MiB = 1u << 20;
constexpr size_t WS_CTL = 0, CTL_ZERO_BYTES = 65536;
constexpr size_t WS_W = 1 * MiB, W_LAYER = 103 * MiB;
constexpr size_t WO_IN = 0, WO_OUT = 22 * MiB, WO_FF1 = 30 * MiB, WO_FF2 = 62 * MiB, WO_PLE = 94 * MiB, WO_GATE = 95 * MiB;
constexpr size_t WS_ROPE = 207 * MiB;
constexpr size_t WS_HB = 221 * MiB, WS_Y = 349 * MiB, WS_SS = 477 * MiB, WS_RS = 481 * MiB, WS_BIG = 482 * MiB;
constexpr size_t BO_AQ = 0, BO_AKV = 64 * MiB, BO_IQ = 80 * MiB, BO_IK = 144 * MiB, BO_IW = 148 * MiB, BO_RQ = 150 * MiB, BO_RK = 182 * MiB,
                 BO_RV = 214 * MiB, BO_RG = 278 * MiB, BO_MIX = 342 * MiB;
constexpr size_t BO_HID = 0, BO_E = 0, BO_PB = 128 * MiB;
constexpr size_t WS_END = 994 * MiB;
constexpr int ROPE_W = 112;
constexpr int CW_BAR = 4096, CW_Q = 8192;
constexpr int RING_OFF = 0, RING_BYTES = 139264;
constexpr int LDSCTL_OFF = RING_BYTES, MISC_OFF = LDSCTL_OFF + 320;
constexpr int LDS_BYTES = 147456;
static_assert(MISC_OFF + 128 <= LDS_BYTES, "LDS map");
namespace pg8 {
#define PG8_LAS __attribute__((address_space(3)))
typedef unsigned short bf16_t;
typedef short bf16x8 __attribute__((ext_vector_type(8)));
typedef float f32x4 __attribute__((ext_vector_type(4)));
typedef unsigned u32x4 __attribute__((ext_vector_type(4)));
constexpr int BM = 256, BK = 64, HALF = 128, HTB = HALF * BK * 2  , STAGE_BYTES = 8 * HTB, NXCD = 8, WGM = 8;

__host__ __device__ __forceinline__ int lds_byte(int r, int c) { const int st = (r >> 4) * 2 + (c >> 5), rr = r & 15, cc = c & 31, ob = rr * 64 + cc * 2; return st * 1024 + (ob ^ (((ob >> 9) & 1) << 5)); }
__host__ __device__ __forceinline__ void stage_rc(int b, int& R, int& C) { const int st = b / 1024, sb = b % 1024, swz = sb ^ (((sb >> 9) & 1) << 5); R = (st >> 1) * 16 + swz / 64; C = (st & 1) * 32 + (swz % 64) / 2; }
__host__ __device__ __forceinline__ int perm32(int rho) { const int n = rho >> 4, i = rho & 15; return 8 * (i >> 2) + 4 * n + (i & 3); }

struct Unit { int pm, pn; };
struct Gemm { const bf16_t* A; const bf16_t* Bt; int M, N, K; };

struct StaticOrder {
    int nM, nN, nwg, G, c;
    __host__ __device__ void init(int M, int N, int G_, int c_) { nM = M / BM; nN = N / BM; nwg = nM * nN; G = G_; c = c_; }
    __host__ __device__ bool next(int i, Unit& u) const {
        const long L = (long)i * G + c; if (L >= nwg) return false;
        int wgid = (int)L; { const int q = nwg / NXCD, r = nwg % NXCD, xcd = wgid % NXCD, off = wgid / NXCD; wgid = (xcd < r ? xcd * (q + 1) : r * (q + 1) + (xcd - r) * q) + off; }
        const int nig = WGM * nN, gid = wgid / nig, fm = gid * WGM, gsz = (nM - fm) < WGM ? (nM - fm) : WGM;
        u.pm = fm + ((wgid % nig) % gsz); u.pn = (wgid % nig) / gsz; return true;
    }
    __device__ __forceinline__ void a_ready(const Unit&) const {}
    __device__ __forceinline__ void done(const Unit&) const {}
};
__device__ __forceinline__ unsigned cvt_pk_bf16(float lo, float hi) { unsigned r; asm volatile("v_cvt_pk_bf16_f32 %0, %1, %2" : "=v"(r) : "v"(lo), "v"(hi)); return r; }
typedef float f32x2 __attribute__((ext_vector_type(2)));

__device__ __forceinline__ u32x4 pack8(const f32x4& v0, const f32x4& v1) { u32x4 w; w.x = cvt_pk_bf16(v0[0], v0[1]); w.y = cvt_pk_bf16(v0[2], v0[3]); w.z = cvt_pk_bf16(v1[0], v1[1]); w.w = cvt_pk_bf16(v1[2], v1[3]); return w; }
__device__ __forceinline__ float bf_lo(unsigned w) { return __uint_as_float(w << 16); }
__device__ __forceinline__ float bf_hi(unsigned w) { return __uint_as_float(w & 0xffff0000u); }
__device__ __forceinline__ float fast_sigmoid(float x) { return __builtin_amdgcn_rcpf(1.0f + __builtin_amdgcn_exp2f(-1.4426950408889634f * x)); }
__device__ __forceinline__ float log2_gamma(int h) { const float e = __builtin_amdgcn_exp2f(-5.0f - (float)h); return -(e * (1.0f + e * (0.5f + e * (0.33333333f + e * (0.25f + e * 0.2f))))) * 1.4426950408889634f; }

struct EpiIn {
    static constexpr bool PERM = true, AFTER_DRAIN = false;
    unsigned char* big; const float* RS; const float* ROPE;
    struct Col { size_t dofs; int ldc, dcol, mode; bool has, rot; float scale, lg; };
    __device__ __forceinline__ void operator()(const f32x4 (&acc)[2][2][4][2], const Unit& u, int wr, int wc, int fr_, int fq_) const {
        int fr = fr_, fq = fq_; asm volatile("" : "+v"(fr), "+v"(fq));
        const int pn = u.pn;
        Col cl[2]; int coff = 0, soff = 0;
#pragma unroll
        for (int bj = 0; bj < 2; ++bj) {
            const int c256 = 128 * bj + 32 * wc + 8 * fq;
            Col k; k.dofs = 0; k.ldc = 0; k.dcol = 0; k.mode = 0; k.has = false; k.rot = false; k.scale = 1.f; k.lg = 0.f;
            if (pn < 4)       { k.dofs = BO_AQ;  k.has = true; k.ldc = 1024; k.dcol = pn * 256 + c256;        k.rot = (wc == 0); coff = 4 * fq; soff = 16 + 4 * fq; k.scale = QSCALE; }
            else if (pn == 4) { k.dofs = BO_AKV; k.has = true; k.ldc = 256;  k.dcol = c256;                   k.rot = (bj == 0 && wc == 0); coff = 4 * fq; soff = 16 + 4 * fq; }
            else if (pn < 9)  { k.dofs = BO_IQ;  k.has = true; k.ldc = 1024; k.dcol = (pn - 5) * 256 + c256;  k.rot = ((wc & 1) == 0 && fq < 2); coff = 32 + 4 * fq; soff = 40 + 4 * fq; }
            else if (pn == 9) { if (bj == 0 && wc < 2) { k.dofs = BO_IK; k.has = true; k.ldc = 64; k.dcol = c256; k.rot = (wc == 0 && fq < 2); coff = 32 + 4 * fq; soff = 40 + 4 * fq; }
                                else if (bj == 0 && wc == 2 && fq < 2) { k.mode = 3; } }
            else if (pn < 12) { k.dofs = BO_RQ;  k.has = true; k.ldc = 512;  k.dcol = (pn - 10) * 256 + c256; k.rot = true; coff = 48 + 16 * (wc & 1) + 4 * fq; soff = 80 + 16 * (wc & 1) + 4 * fq; }
            else if (pn < 14) { k.dofs = BO_RK;  k.has = true; k.ldc = 512;  k.dcol = (pn - 12) * 256 + c256; k.rot = true; coff = 48 + 16 * (wc & 1) + 4 * fq; soff = 80 + 16 * (wc & 1) + 4 * fq; k.scale = 0.125f; k.mode = 2;
                                k.lg = log2_gamma(4 * (pn - 12) + 2 * bj + (wc >> 1)); }
            else if (pn < 18) { k.dofs = BO_RV;  k.has = true; k.ldc = 1024; k.dcol = (pn - 14) * 256 + c256; }
            else              { k.dofs = BO_RG;  k.has = true; k.ldc = 1024; k.dcol = (pn - 18) * 256 + c256; k.mode = 1; }
            cl[bj] = k;
        }
        const bool anyrot = cl[0].rot || cl[1].rot;
        float* IW = (float*)(big + BO_IW);
#pragma unroll
        for (int ai = 0; ai < 2; ++ai) {
            float rsv[4]; f32x4 cs[4], sn[4];
#pragma unroll
            for (int m = 0; m < 4; ++m) { const int row = u.pm * BM + ai * HALF + wr * 64 + m * 16 + fr; rsv[m] = RS[row];
                cs[m] = (f32x4){1.f, 1.f, 1.f, 1.f}; sn[m] = (f32x4){0.f, 0.f, 0.f, 0.f};
                if (anyrot) { const float* rp = ROPE + (size_t)row * ROPE_W; cs[m] = *(const f32x4*)(rp + coff); sn[m] = *(const f32x4*)(rp + soff); } }
#pragma unroll
            for (int m = 0; m < 4; ++m) {
                const int row = u.pm * BM + ai * HALF + wr * 64 + m * 16 + fr;
#pragma unroll
                for (int bj = 0; bj < 2; ++bj) {
                    const Col& k = cl[bj];
                    if (!k.has && k.mode != 3) continue;
                    float sc = rsv[m] * k.scale;
                    if (k.mode == 2) sc *= __builtin_amdgcn_exp2f((float)(127 - (row & 127)) * k.lg);
                    f32x4 v0 = acc[ai][bj][m][0], v1 = acc[ai][bj][m][1];
                    if (k.rot) { const f32x4 a = v0 * cs[m] - v1 * sn[m], b = v1 * cs[m] + v0 * sn[m]; v0 = a; v1 = b; }
                    v0 = v0 * sc; v1 = v1 * sc;
                    if (k.mode == 1) {
#pragma unroll
                        for (int j = 0; j < 4; ++j) { v0[j] = v0[j] * fast_sigmoid(v0[j]); v1[j] = v1[j] * fast_sigmoid(v1[j]); } }
                    if (k.mode == 3) { float* p = IW + (size_t)row * 16 + 8 * fq; *(f32x4*)p = v0; *(f32x4*)(p + 4) = v1; }
                    else *(u32x4*)((bf16_t*)(big + k.dofs) + (size_t)row * k.ldc + k.dcol) = pack8(v0, v1);
                }
            }
            asm volatile("" ::: "memory");
        }
    }
};
struct EpiY {
    static constexpr bool PERM = true, AFTER_DRAIN = false;
    bf16_t* Y; float* SS; const bf16_t* E;
    __device__ __forceinline__ void operator()(const f32x4 (&acc)[2][2][4][2], const Unit& u, int wr, int wc, int fr_, int fq_) const {
        int fr = fr_, fq = fq_; asm volatile("" : "+v"(fr), "+v"(fq));
        const int col0 = u.pn * BM + wc * 32 + 8 * fq;
#pragma unroll
        for (int ai = 0; ai < 2; ++ai) {
            u32x4 ev[4][2];
            if (E) {
#pragma unroll
                for (int m = 0; m < 4; ++m)
#pragma unroll
                    for (int bj = 0; bj < 2; ++bj) ev[m][bj] = *(const u32x4*)(E + (size_t)(u.pm * BM + ai * HALF + wr * 64 + m * 16 + fr) * DM + col0 + bj * HALF);
            }
#pragma unroll
            for (int m = 0; m < 4; ++m) {
                const int row = u.pm * BM + ai * HALF + wr * 64 + m * 16 + fr; float q = 0.f;
#pragma unroll
                for (int bj = 0; bj < 2; ++bj) {
                    f32x4 v0 = acc[ai][bj][m][0], v1 = acc[ai][bj][m][1];
                    if (E) { const u32x4 e = ev[m][bj];
                        v0[0] = fast_sigmoid(v0[0]) * bf_lo(e.x); v0[1] = fast_sigmoid(v0[1]) * bf_hi(e.x); v0[2] = fast_sigmoid(v0[2]) * bf_lo(e.y); v0[3] = fast_sigmoid(v0[3]) * bf_hi(e.y);
                        v1[0] = fast_sigmoid(v1[0]) * bf_lo(e.z); v1[1] = fast_sigmoid(v1[1]) * bf_hi(e.z); v1[2] = fast_sigmoid(v1[2]) * bf_lo(e.w); v1[3] = fast_sigmoid(v1[3]) * bf_hi(e.w); }
                    q += (v0[0] * v0[0] + v0[1] * v0[1]) + (v0[2] * v0[2] + v0[3] * v0[3]) + (v1[0] * v1[0] + v1[1] * v1[1]) + (v1[2] * v1[2] + v1[3] * v1[3]);
                    *(u32x4*)(Y + (size_t)row * DM + col0 + bj * HALF) = pack8(v0, v1);
                }
                q += __shfl_xor(q, 16); q += __shfl_xor(q, 32);
                if (fq == 0) SS[(size_t)row * 32 + u.pn * 4 + wc] = q;
            }
            asm volatile("" ::: "memory");
        }
    }
};
struct EpiFF1 {
    static constexpr bool PERM = true, AFTER_DRAIN = false;
    bf16_t* H; const float* RS;
    __device__ __forceinline__ void operator()(const f32x4 (&acc)[2][2][4][2], const Unit& u, int wr, int wc, int fr_, int fq_) const {
        int fr = fr_, fq = fq_; asm volatile("" : "+v"(fr), "+v"(fq));
        const int col0 = u.pn * BM + wc * 32 + 8 * fq;
        float rsv[2][4];
#pragma unroll
        for (int ai = 0; ai < 2; ++ai)
#pragma unroll
            for (int m = 0; m < 4; ++m) rsv[ai][m] = RS[u.pm * BM + ai * HALF + wr * 64 + m * 16 + fr];
#pragma unroll
        for (int ai = 0; ai < 2; ++ai)
#pragma unroll
            for (int m = 0; m < 4; ++m) {
                const int row = u.pm * BM + ai * HALF + wr * 64 + m * 16 + fr; const float rs = rsv[ai][m];
#pragma unroll
                for (int bj = 0; bj < 2; ++bj) {
                    f32x4 v0 = acc[ai][bj][m][0] * rs, v1 = acc[ai][bj][m][1] * rs;
#pragma unroll
                    for (int j = 0; j < 4; ++j) { const float a = fmaxf(v0[j], 0.f), b = fmaxf(v1[j], 0.f); v0[j] = a * a; v1[j] = b * b; }
                    *(u32x4*)(H + (size_t)row * DFF + col0 + bj * HALF) = pack8(v0, v1);
                }
            }
    }
};
struct EpiPlain {
    static constexpr bool PERM = true, AFTER_DRAIN = false;
    bf16_t* O; int ldc;
    __device__ __forceinline__ void operator()(const f32x4 (&acc)[2][2][4][2], const Unit& u, int wr, int wc, int fr_, int fq_) const {
        int fr = fr_, fq = fq_; asm volatile("" : "+v"(fr), "+v"(fq));
        const int col0 = u.pn * BM + wc * 32 + 8 * fq;
#pragma unroll
        for (int ai = 0; ai < 2; ++ai)
#pragma unroll
            for (int m = 0; m < 4; ++m) {
                const int row = u.pm * BM + ai * HALF + wr * 64 + m * 16 + fr;
#pragma unroll
                for (int bj = 0; bj < 2; ++bj) *(u32x4*)(O + (size_t)row * ldc + col0 + bj * HALF) = pack8(acc[ai][bj][m][0], acc[ai][bj][m][1]);
            }
    }
};
template <class Epi, class Sched, bool ALIGN_EPI = false, bool SP2 = false>
__device__ __forceinline__ void gemm_phase(PG8_LAS unsigned char* lds, const Gemm g, const Sched& S, const Epi& E) {
    int tid_ = threadIdx.x; asm volatile("" : "+v"(tid_));
    const int tid = tid_, wid = __builtin_amdgcn_readfirstlane(tid >> 6), lane = tid & 63, wr = wid >> 2, wc = wid & 3, fr = lane & 15, fq = lane >> 4;
    const int K = g.K, nt = K / BK;
    unsigned voffA[2], voffB[2];
#pragma unroll
    for (int i = 0; i < 2; ++i) { int R, C; stage_rc(tid * 16 + i * 8192, R, C); const int Rb = Epi::PERM ? ((R & ~31) + perm32(R & 31)) : R;
        voffA[i] = (unsigned)(R * K + C) * 2u; voffB[i] = (unsigned)(Rb * K + C) * 2u; }
    const size_t kstep = (size_t)(BK * 2);
    const size_t hstep = (size_t)HALF * K * 2;
    const size_t tstep = 2 * hstep;
    const unsigned ldsw = (unsigned)wid * 1024u;
    const int aoff = lds_byte(wr * 64 + fr, fq * 8), boff = lds_byte(wc * 32 + fr, fq * 8);
#define PG8_SA(b, h) (((b) * 2 + (h)) * HTB)
#define PG8_SB(b, h) ((4 + (b) * 2 + (h)) * HTB)
#define PG8_STAGE(bufoff, gbase, voff) do { _Pragma("unroll") for (int _i = 0; _i < 2; ++_i) \
        __builtin_amdgcn_global_load_lds((const unsigned*)((const char*)(gbase) + (voff)[_i]), (PG8_LAS unsigned*)(lds + (bufoff) + ldsw + _i * 8192), 16, 0, 0); } while (0)
#define PG8_LDA(dst, b, h) do { _Pragma("unroll") for (int m = 0; m < 4; ++m) _Pragma("unroll") for (int k = 0; k < 2; ++k) dst[m][k] = *(const PG8_LAS bf16x8*)(lds + PG8_SA(b, h) + aoff + m * 2048 + k * 1024); } while (0)
#define PG8_LDB(dst, b, h) do { _Pragma("unroll") for (int n = 0; n < 2; ++n) _Pragma("unroll") for (int k = 0; k < 2; ++k) dst[n][k] = *(const PG8_LAS bf16x8*)(lds + PG8_SB(b, h) + boff + n * 2048 + k * 1024); } while (0)
#define PG8_MMA(ai, bj, At, Bt) do { __builtin_amdgcn_s_setprio(1); _Pragma("unroll") for (int m = 0; m < 4; ++m) _Pragma("unroll") for (int n = 0; n < 2; ++n) _Pragma("unroll") for (int k = 0; k < 2; ++k) \
        acc[ai][bj][m][n] = __builtin_amdgcn_mfma_f32_16x16x32_bf16(Bt[n][k], At[m][k], acc[ai][bj][m][n], 0, 0, 0); __builtin_amdgcn_s_setprio(0); } while (0)
#define PG8_WAIT_V(n) asm volatile("s_waitcnt vmcnt(" #n ")" ::: "memory")
#define PG8_WAIT_L(n) asm volatile("s_waitcnt lgkmcnt(" #n ")" ::: "memory")
#define PG8_BAR __builtin_amdgcn_s_barrier()
#define PG8_SCHED __builtin_amdgcn_sched_barrier(0)
    Unit cur, nxt; int ui = 0;
    if (!S.next(0, cur)) return;
    f32x4 acc[2][2][4][2];
#pragma unroll
    for (int a = 0; a < 2; ++a)
#pragma unroll
        for (int b = 0; b < 2; ++b)
#pragma unroll
            for (int m = 0; m < 4; ++m)
#pragma unroll
                for (int n = 0; n < 2; ++n) acc[a][b][m][n] = (f32x4){0.f, 0.f, 0.f, 0.f};
    bf16x8 At[4][2], B0[2][2], B1[2][2];
    const char* cA = (const char*)g.A + (size_t)cur.pm * tstep; const char* cB = (const char*)g.Bt + (size_t)cur.pn * tstep;
    S.a_ready(cur);
    if constexpr (SP2) {
        PG8_STAGE(PG8_SB(0, 0), cB, voffB); PG8_STAGE(PG8_SB(0, 1), cB + hstep, voffB); PG8_STAGE(PG8_SA(0, 0), cA, voffA); PG8_STAGE(PG8_SA(0, 1), cA + hstep, voffA);
        if (wr == 1) PG8_BAR;
        PG8_WAIT_V(2); PG8_BAR;
        PG8_STAGE(PG8_SB(1, 0), cB + kstep, voffB); PG8_STAGE(PG8_SA(1, 0), cA + kstep, voffA); PG8_STAGE(PG8_SB(1, 1), cB + hstep + kstep, voffB);
        PG8_WAIT_V(6); PG8_BAR;
    } else {
        PG8_STAGE(PG8_SB(0, 0), cB, voffB); PG8_STAGE(PG8_SA(0, 0), cA, voffA); PG8_STAGE(PG8_SB(0, 1), cB + hstep, voffB); PG8_STAGE(PG8_SA(0, 1), cA + hstep, voffA);
        if (wr == 1) PG8_BAR;
        PG8_WAIT_V(4); PG8_BAR;
        PG8_STAGE(PG8_SB(1, 0), cB + kstep, voffB); PG8_STAGE(PG8_SA(1, 0), cA + kstep, voffA); PG8_STAGE(PG8_SB(1, 1), cB + hstep + kstep, voffB);
        PG8_WAIT_V(6); PG8_BAR;
    }
    for (;;) {
        const bool has_next = S.next(ui + 1, nxt);
        const char* nA = has_next ? (const char*)g.A + (size_t)nxt.pm * tstep : cA; const char* nB = has_next ? (const char*)g.Bt + (size_t)nxt.pn * tstep : cB;
        for (int t = 0; t < nt; t += 2) {
            const bool last = (t == nt - 2);
            const char* a1 = cA + (size_t)(t + 1) * kstep;
            const char* a2 = last ? nA : cA + (size_t)(t + 2) * kstep; const char* b2 = last ? nB : cB + (size_t)(t + 2) * kstep;
            const char* a3 = a2 + kstep; const char* b3 = b2 + kstep;
            if (last && has_next) S.a_ready(nxt);
            if constexpr (SP2) {
            PG8_LDB(B0, 0, 0); PG8_LDB(B1, 0, 1); PG8_SCHED; PG8_LDA(At, 0, 0); PG8_STAGE(PG8_SA(1, 1), a1 + hstep, voffA);
            PG8_WAIT_V(8); PG8_WAIT_L(0); PG8_BAR; PG8_MMA(0, 0, At, B0); PG8_MMA(0, 1, At, B1); PG8_BAR; PG8_SCHED;
            PG8_LDA(At, 0, 1); PG8_STAGE(PG8_SB(0, 0), b2, voffB); PG8_STAGE(PG8_SB(0, 1), b2 + hstep, voffB); PG8_STAGE(PG8_SA(0, 0), a2, voffA);
            PG8_WAIT_V(8); PG8_WAIT_L(0); PG8_BAR; PG8_MMA(1, 0, At, B0); PG8_MMA(1, 1, At, B1); PG8_BAR; PG8_SCHED;
            PG8_LDB(B0, 1, 0); PG8_LDB(B1, 1, 1); PG8_SCHED; PG8_LDA(At, 1, 0); PG8_STAGE(PG8_SA(0, 1), a2 + hstep, voffA);
            PG8_WAIT_V(8); PG8_WAIT_L(0); PG8_BAR; PG8_MMA(0, 0, At, B0); PG8_MMA(0, 1, At, B1); PG8_BAR; PG8_SCHED;
            PG8_LDA(At, 1, 1); PG8_STAGE(PG8_SB(1, 0), b3, voffB); PG8_STAGE(PG8_SB(1, 1), b3 + hstep, voffB); PG8_STAGE(PG8_SA(1, 0), a3, voffA);
            PG8_WAIT_V(8); PG8_WAIT_L(0); PG8_BAR; PG8_MMA(1, 0, At, B0); PG8_MMA(1, 1, At, B1); PG8_BAR; PG8_SCHED;
            } else {
            PG8_LDB(B0, 0, 0); PG8_SCHED; PG8_LDA(At, 0, 0); PG8_STAGE(PG8_SA(1, 1), a1 + hstep, voffA);
            PG8_WAIT_L(8); PG8_BAR; PG8_WAIT_L(0); PG8_MMA(0, 0, At, B0); PG8_BAR; PG8_SCHED;
            PG8_LDB(B1, 0, 1); PG8_STAGE(PG8_SB(0, 0), b2, voffB);
            PG8_BAR; PG8_WAIT_L(0); PG8_MMA(0, 1, At, B1); PG8_BAR;
            PG8_LDA(At, 0, 1); PG8_STAGE(PG8_SA(0, 0), a2, voffA);
            PG8_BAR; PG8_WAIT_L(0); PG8_MMA(1, 0, At, B0); PG8_BAR; PG8_SCHED;
            PG8_STAGE(PG8_SB(0, 1), b2 + hstep, voffB);
            PG8_WAIT_V(6); PG8_BAR; PG8_MMA(1, 1, At, B1); PG8_BAR;
            PG8_LDB(B0, 1, 0); PG8_SCHED; PG8_LDA(At, 1, 0); PG8_STAGE(PG8_SA(0, 1), a2 + hstep, voffA);
            PG8_WAIT_L(8); PG8_BAR; PG8_WAIT_L(0); PG8_MMA(0, 0, At, B0); PG8_BAR; PG8_SCHED;
            PG8_LDB(B1, 1, 1); PG8_STAGE(PG8_SB(1, 0), b3, voffB);
            PG8_BAR; PG8_WAIT_L(0); PG8_MMA(0, 1, At, B1); PG8_BAR;
            PG8_LDA(At, 1, 1); PG8_STAGE(PG8_SA(1, 0), a3, voffA);
            PG8_BAR; PG8_WAIT_L(0); PG8_MMA(1, 0, At, B0); PG8_BAR; PG8_SCHED;
            PG8_STAGE(PG8_SB(1, 1), b3 + hstep, voffB);
            PG8_WAIT_V(6); PG8_BAR; PG8_MMA(1, 1, At, B1); PG8_BAR;
            }
        }
        if constexpr (ALIGN_EPI) { if (wr == 0) PG8_BAR; }
        if constexpr (!Epi::AFTER_DRAIN) { E(acc, cur, wr, wc, fr, fq); S.done(cur); }
        if (!has_next) break;
#pragma unroll
        for (int a = 0; a < 2; ++a)
#pragma unroll
            for (int b = 0; b < 2; ++b)
#pragma unroll
                for (int m = 0; m < 4; ++m)
#pragma unroll
                    for (int n = 0; n < 2; ++n) acc[a][b][m][n] = (f32x4){0.f, 0.f, 0.f, 0.f};
        cur = nxt; cA = nA; cB = nB; ++ui;
        if constexpr (ALIGN_EPI) { if (wr == 1) PG8_BAR; }
    }
    PG8_WAIT_V(0);
    if constexpr (!ALIGN_EPI) { if (wr == 0) PG8_BAR; }
    PG8_BAR;
    if constexpr (Epi::AFTER_DRAIN) { E.fused(acc, cur, wr, wc, fr, fq, lds, wid, lane); S.done(cur); }
#undef PG8_SA
#undef PG8_SB
#undef PG8_STAGE
#undef PG8_LDA
#undef PG8_LDB
#undef PG8_MMA
#undef PG8_WAIT_V
#undef PG8_WAIT_L
#undef PG8_BAR
#undef PG8_SCHED
}
}
#define GAS __attribute__((address_space(1)))
#define LAS __attribute__((address_space(3)))
typedef unsigned short bf16;
typedef unsigned v4u __attribute__((ext_vector_type(4)));
typedef float f32x4 __attribute__((ext_vector_type(4)));
typedef short bf16x8 __attribute__((ext_vector_type(8)));
typedef GAS unsigned gu32;
typedef GAS unsigned long long gu64;
#define RLX_AGENT __ATOMIC_RELAXED, __HIP_MEMORY_SCOPE_AGENT
#define LDS_WAIT() asm volatile("s_waitcnt lgkmcnt(0)" ::: "memory")
#define VM_WAIT() asm volatile("s_waitcnt vmcnt(0)" ::: "memory")
__device__ __forceinline__ unsigned long long rt() { return __builtin_amdgcn_s_memrealtime(); }
__device__ __forceinline__ unsigned f2bf(float f) { unsigned u = __builtin_bit_cast(unsigned, f); return (u + 0x7fffu + ((u >> 16) & 1u)) >> 16; }
__device__ __forceinline__ unsigned pk2(float lo, float hi) { return f2bf(lo) | (f2bf(hi) << 16); }

#define XB_TMO      128
#define XB_XCNT(j)  (256  + 64 * (j))
#define XB_XSUB(j)  (1280 + 64 * (j))
#define XB_XGEN(j)  (2304 + 64 * (j))
#define XB_TOP      3328
#define XB_TOPGEN   3392
#define XCD_BAR_WORDS 3456
#define XB_SPIN_CAP (1u << 22)

__device__ __forceinline__ unsigned xb_ld(unsigned* p)              { return __hip_atomic_load(p, __ATOMIC_RELAXED, __HIP_MEMORY_SCOPE_AGENT); }
__device__ __forceinline__ unsigned xb_add(unsigned* p, unsigned v) { return __hip_atomic_fetch_add(p, v, __ATOMIC_RELAXED, __HIP_MEMORY_SCOPE_AGENT); }
__device__ __forceinline__ unsigned xb_xcc_id() { return (unsigned)__builtin_amdgcn_s_getreg((3 << 11) | 20) & 0xFu; }
#define XB_SPIN(cond, bar) do { unsigned _sp = 0; while (cond) { __builtin_amdgcn_s_sleep(1); \
    if ((++_sp & 255u) == 0u) { if (xb_ld(&(bar)[XB_TMO])) break; if (_sp > XB_SPIN_CAP) { atomicAdd(&(bar)[XB_TMO], 1u); break; } } } } while (0)

struct XcdBarrier {
    unsigned* bar; unsigned x;
    volatile LAS unsigned* st;
};

__device__ __forceinline__ XcdBarrier xcd_barrier_post(unsigned* bar, volatile LAS unsigned* st) {
    XcdBarrier b; b.bar = bar; b.x = xb_xcc_id(); b.st = st;
    if (threadIdx.x == 0) (void)xb_add(&bar[XB_XCNT(b.x)], 1u);
    return b;
}
__device__ __forceinline__ void xcd_barrier_complete(unsigned* bar, unsigned x, unsigned& nloc, unsigned& nx) {
    const unsigned G = gridDim.x * gridDim.y * gridDim.z;
    unsigned sum, cnt, mine, sp = 0u;
    for (;;) {
        sum = 0u; cnt = 0u; mine = 0u;
#pragma unroll
        for (unsigned j = 0; j < 16; ++j) { const unsigned c = xb_ld(&bar[XB_XCNT(j)]); sum += c; cnt += (c > 0u) ? 1u : 0u; mine = (j == x) ? c : mine; }
        if (sum == G) break;
        __builtin_amdgcn_s_sleep(1);
        if ((++sp & 255u) == 0u) { if (xb_ld(&bar[XB_TMO])) break; if (sp > XB_SPIN_CAP) { atomicAdd(&bar[XB_TMO], 1u); break; } }
    }
    nloc = mine > 0u ? mine : 1u; nx = cnt > 0u ? cnt : 1u;
}

__device__ __forceinline__ void xcd_barrier(const XcdBarrier& b) {
    asm volatile("s_waitcnt vmcnt(0)" ::: "memory");
    __syncthreads();
    if (threadIdx.x == 0) {
        unsigned* bar = b.bar;
        __builtin_amdgcn_s_waitcnt(0);
        unsigned nloc = b.st[0], nx = b.st[1];
        if (nloc == 0u) { xcd_barrier_complete(bar, b.x, nloc, nx); b.st[0] = nloc; b.st[1] = nx; }
        const unsigned old = xb_add(&bar[XB_XSUB(b.x)], 1u);
        const unsigned gen = old / nloc;
        if (old + 1u == (gen + 1u) * nloc) {
            __builtin_amdgcn_fence(__ATOMIC_RELEASE, "agent");
            asm volatile("s_waitcnt vmcnt(0)" ::: "memory");
            const unsigned og = xb_add(&bar[XB_TOP], 1u);
            const unsigned tg = og / nx;
            if (og + 1u == (tg + 1u) * nx) xb_add(&bar[XB_TOPGEN], 1u);
            else XB_SPIN(xb_ld(&bar[XB_TOPGEN]) == tg, bar);
            __builtin_amdgcn_fence(__ATOMIC_ACQUIRE, "agent");
            xb_add(&bar[XB_XGEN(b.x)], 1u);
            asm volatile("s_waitcnt vmcnt(0)" ::: "memory");
        } else {
            XB_SPIN(xb_ld(&bar[XB_XGEN(b.x)]) == gen, bar);
            __builtin_amdgcn_fence(__ATOMIC_ACQUIRE, "agent");
            asm volatile("s_waitcnt vmcnt(0)" ::: "memory");
        }
    }
    __syncthreads();
}

typedef unsigned u32x4 __attribute__((ext_vector_type(4)));
typedef unsigned u32x2 __attribute__((ext_vector_type(2)));
typedef short s16x4 __attribute__((ext_vector_type(4)));
typedef float f32x2t __attribute__((ext_vector_type(2)));
typedef __bf16 bf16x2t __attribute__((ext_vector_type(2)));
#define DI __device__ __forceinline__
DI unsigned cvtpk(float lo, float hi) { f32x2t v = {lo, hi}; bf16x2t b = __builtin_convertvector(v, bf16x2t); return __builtin_bit_cast(unsigned, b); }
DI float bflo(unsigned w) { return __uint_as_float(w << 16); }
DI float bfhi(unsigned w) { return __uint_as_float(w & 0xffff0000u); }
DI s16x4 tr_read(LAS unsigned char* p) { return __builtin_bit_cast(s16x4, __builtin_amdgcn_ds_read_tr16_b64_v4i16((LAS s16x4*)p)); }
DI bf16x8 cat8(s16x4 lo, s16x4 hi) { return (bf16x8){lo[0], lo[1], lo[2], lo[3], hi[0], hi[1], hi[2], hi[3]}; }
DI int fresh_tid() { int t = threadIdx.x; asm volatile("" : "+v"(t)); return t; }
#define MFMA16(a, b, c) __builtin_amdgcn_mfma_f32_16x16x32_bf16((a), (b), (c), 0, 0, 0)
DI float wave_sum(float v) {
#pragma unroll
    for (int o = 1; o < 64; o <<= 1) v += __shfl_xor(v, o);
    return v;
}

struct Frame {
    LAS unsigned char* lds;
    volatile LAS unsigned* MISC;
    gu32* ctl;
    int G;
    unsigned char* ws;
    const float* const* in;
};

DI int perm_pairs(int p, int half) {
    const int g = p >> 3, r = p & 7; return (r < 4) ? 4 * g + r : half + 4 * g + (r - 4);
}
DI int inmap(int np) {
    if (np < 1024) { const int head = np >> 7, p = np & 127; return head * 128 + (p < 32 ? perm_pairs(p, 16) : p); }
    if (np < 1280) { const int c = np - 1024; if (c < 128) return 1024 + (c < 32 ? perm_pairs(c, 16) : c); return 1152 + (c - 128); }
    if (np < 2304) { const int q = np - 1280, head = q >> 6, p = q & 63; return 1280 + head * 64 + (p < 16 ? perm_pairs(p, 8) : p); }
    if (np < 2560) { const int c = np - 2304; if (c < 64) return 2304 + (c < 16 ? perm_pairs(c, 8) : c); if (c < 80) return 2368 + (c - 64); return -1; }
    if (np < 3584) { const int q = np - 2560, which = q >> 9, qq = q & 511, head = qq >> 6, p = qq & 63; return (which ? 2896 : 2384) + head * 64 + perm_pairs(p, 32); }
    if (np < 4608) return 3408 + (np - 3584);
    return 4432 + (np - 4608);
}
template <bool INMAP>
DI void transpose_item(const float* W, int K, int N, int NP, bf16* WT, const float* gain, LAS float* scr, int item, int lane) {
    const int nblk = NP / 32, kb = item / nblk, nb = item % nblk, k0 = 64 * kb, n0 = 32 * nb;
    const int np = n0 + (lane & 31); const int L = INMAP ? inmap(np) : np;
#pragma unroll 8
    for (int i = 0; i < 32; ++i) { const int kk = 2 * i + (lane >> 5); float v = 0.f; if (L >= 0) { v = W[(size_t)(k0 + kk) * N + L]; if (gain) v *= gain[k0 + kk]; } scr[kk * 33 + (lane & 31)] = v; }
    LDS_WAIT(); asm volatile("" ::: "memory");
    const int c = lane & 7;
#pragma unroll
    for (int j = 0; j < 4; ++j) { const int n = (lane >> 3) + 8 * j; const LAS float* s = scr + (8 * c) * 33 + n;
        v4u o; o.x = pk2(s[0 * 33], s[1 * 33]); o.y = pk2(s[2 * 33], s[3 * 33]); o.z = pk2(s[4 * 33], s[5 * 33]); o.w = pk2(s[6 * 33], s[7 * 33]);
        *(GAS v4u*)(WT + (size_t)(n0 + n) * K + k0 + 8 * c) = o; }
    LDS_WAIT(); asm volatile("" ::: "memory");
}
DI void sincos_rr(float x, float& s, float& c) {
    const float k = rintf(x * 0.15915494309189535f);
    float r = fmaf(-k, 6.28318548202514648f, x); r = fmaf(-k, -1.74845553e-7f, r);
    const float f = r * 0.15915494309189535f;
    s = __builtin_amdgcn_sinf(f); c = __builtin_amdgcn_cosf(f);
}

DI void p0_prologue(Frame& F, const float* x, const int* positions, const float* w_in, const float* w_out, const float* w_ff1, const float* w_ff2, const float* w_ple, const float* w_gate,
                    const float* pre_mix, const float* pre_ff) {
    const int tid = fresh_tid(), lane = tid & 63, wave = __builtin_amdgcn_readfirstlane(tid >> 6);
    LAS float* scr = (LAS float*)(F.lds + RING_OFF + wave * 16384);
    const int gw = blockIdx.x * NWAVES + wave, NGW = F.G * NWAVES;
    constexpr int I_IN = (DM / 64) * (NINP / 32), I_OUT = (DM / 64) * (DM / 32), I_FF1 = (DM / 64) * (DFF / 32), I_FF2 = (DFF / 64) * (DM / 32), I_PLE = (PLE / 64) * (DM / 32), I_GATE = I_OUT;
    constexpr int PER_LAYER = I_IN + I_OUT + I_FF1 + I_FF2 + I_PLE + I_GATE;
    for (int it = gw; it < DEPTH * PER_LAYER; it += NGW) {
        const int l = it / PER_LAYER; int r = it % PER_LAYER;
        unsigned char* wl = F.ws + WS_W + (size_t)l * W_LAYER;
        if (r < I_IN)  { transpose_item<true >(w_in  + (size_t)l * DM * NINL, DM, NINL, NINP, (bf16*)(wl + WO_IN),  pre_mix + l * DM, scr, r, lane); continue; } r -= I_IN;
        if (r < I_OUT) { transpose_item<false>(w_out + (size_t)l * DM * DM,   DM, DM,  DM,    (bf16*)(wl + WO_OUT), nullptr,          scr, r, lane); continue; } r -= I_OUT;
        if (r < I_FF1) { transpose_item<false>(w_ff1 + (size_t)l * DM * DFF,  DM, DFF, DFF,   (bf16*)(wl + WO_FF1), pre_ff + l * DM,  scr, r, lane); continue; } r -= I_FF1;
        if (r < I_FF2) { transpose_item<false>(w_ff2 + (size_t)l * DFF * DM,  DFF, DM, DM,    (bf16*)(wl + WO_FF2), nullptr,          scr, r, lane); continue; } r -= I_FF2;
        if (r < I_PLE) { transpose_item<false>(w_ple + (size_t)l * PLE * DM,  PLE, DM, DM,    (bf16*)(wl + WO_PLE), nullptr,          scr, r, lane); continue; } r -= I_PLE;
        transpose_item<false>(w_gate + (size_t)l * DM * DM, DM, DM, DM, (bf16*)(wl + WO_GATE), nullptr, scr, r, lane);
    }
    float* rope = (float*)(F.ws + WS_ROPE);
    for (int e = blockIdx.x * (NWAVES * 64) + tid; e < M * 56; e += F.G * NWAVES * 64) {
        const int m = e / 56, i = e % 56; const float pos = (float)positions[m];
        float inv; int co, so;
        if (i < 16)      { inv = __builtin_amdgcn_exp2f(-(float)i * (1.0f / 16.0f) * LOG2_THETA_A);        co = i;             so = 16 + i; }
        else if (i < 24) { inv = __builtin_amdgcn_exp2f(-(float)(i - 16) * (1.0f / 8.0f) * LOG2_THETA_A);  co = 32 + (i - 16); so = 40 + (i - 16); }
        else             { inv = __builtin_amdgcn_exp2f(-(float)(i - 24) * (1.0f / 32.0f) * LOG2_THETA_R); co = 48 + (i - 24); so = 80 + (i - 24); }
        float s, c; sincos_rr(pos * inv, s, c);
        rope[(size_t)m * ROPE_W + co] = c; rope[(size_t)m * ROPE_W + so] = s;
    }
    bf16* HB = (bf16*)(F.ws + WS_HB); float* RS = (float*)(F.ws + WS_RS);
    for (int row = gw; row < M; row += NGW) {
        const GAS f32x4* xr = (const GAS f32x4*)(x + (size_t)row * DM) + lane; GAS u32x2* hb = (GAS u32x2*)(HB + (size_t)row * DM) + lane; float ss = 0.f;
#pragma unroll
        for (int j = 0; j < 8; ++j) { const f32x4 v = xr[64 * j]; ss += (v.x * v.x + v.y * v.y) + (v.z * v.z + v.w * v.w); u32x2 o; o.x = cvtpk(v.x, v.y); o.y = cvtpk(v.z, v.w); hb[64 * j] = o; }
        ss = wave_sum(ss);
        if (lane == 0) RS[row] = 1.0f / sqrtf(ss * (1.0f / DM) + RMS_EPS);
    }
}

DI void thin_phase(Frame& F, const float* hsrc, float* hdst, const float* wpost, const float* pconv) {
    const int tid = fresh_tid(), lane = tid & 63, wave = __builtin_amdgcn_readfirstlane(tid >> 6);
    const int gw = blockIdx.x * NWAVES + wave, NGW = F.G * NWAVES;
    const bf16* Y = (const bf16*)(F.ws + WS_Y); const float* SS = (const float*)(F.ws + WS_SS); bf16* HB = (bf16*)(F.ws + WS_HB); float* RS = (float*)(F.ws + WS_RS);
    bf16* PB = (bf16*)(F.ws + WS_BIG + BO_PB);
    f32x4 w[8];
#pragma unroll
    for (int j = 0; j < 8; ++j) w[j] = *((const GAS f32x4*)wpost + lane + 64 * j);
    for (int row = gw; row < M; row += NGW) {
        float q = (lane < 32) ? SS[(size_t)row * 32 + lane] : 0.f; q = wave_sum(q);
        const float rstd = 1.0f / sqrtf(q * (1.0f / DM) + RMS_EPS);
        const GAS f32x4* hr = (const GAS f32x4*)(hsrc + (size_t)row * DM) + lane; GAS f32x4* ho = (GAS f32x4*)(hdst + (size_t)row * DM) + lane;
        const GAS u32x2* yr = (const GAS u32x2*)(Y + (size_t)row * DM) + lane; GAS u32x2* hb = (GAS u32x2*)(HB + (size_t)row * DM) + lane; float ss = 0.f;
#pragma unroll
        for (int j = 0; j < 8; ++j) { f32x4 h = hr[64 * j]; const u32x2 y = yr[64 * j];
            h.x += bflo(y.x) * rstd * w[j].x; h.y += bfhi(y.x) * rstd * w[j].y; h.z += bflo(y.y) * rstd * w[j].z; h.w += bfhi(y.y) * rstd * w[j].w;
            ss += (h.x * h.x + h.y * h.y) + (h.z * h.z + h.w * h.w); ho[64 * j] = h; u32x2 o; o.x = cvtpk(h.x, h.y); o.y = cvtpk(h.z, h.w); hb[64 * j] = o; }
        ss = wave_sum(ss);
        if (lane == 0) RS[row] = 1.0f / sqrtf(ss * (1.0f / DM) + RMS_EPS);
        if (pconv) { const f32x4 pv = *((const GAS f32x4*)(pconv + (size_t)row * PLE) + lane); u32x2 o; o.x = cvtpk(pv.x, pv.y); o.y = cvtpk(pv.z, pv.w); *((GAS u32x2*)(PB + (size_t)row * PLE) + lane) = o; }
    }
}

constexpr int ATT_WL = 16384 + 512;
constexpr int RET_KST = 144, RET_VST = 288, RET_K = 0, RET_V = 128 * RET_KST, RET_R = RET_V + 128 * RET_VST, RET_BYTES = RET_R + 128 * RET_KST;
static_assert(NWAVES * ATT_WL <= RING_BYTES && RET_BYTES <= RING_BYTES, "mixer LDS");
constexpr int N_RET_ITEMS = BATCH * 8, N_ATT_ITEMS = BATCH * (SEQ / NWAVES), N_MIX_ITEMS = N_RET_ITEMS + N_ATT_ITEMS;

DI void dma16(const void* g, LAS unsigned char* l) { __builtin_amdgcn_global_load_lds((const unsigned*)g, (LAS unsigned*)l, 16, 0, 0); }
#define VMW(n) asm volatile("s_waitcnt vmcnt(" #n ")" ::: "memory")
#ifndef PROF_SEC
#define PROF_SEC 0
#endif
#define PROF_T() ((unsigned)__builtin_amdgcn_s_memrealtime())
#define PROF_BEGIN(k) unsigned pt_##k = 0; if (PROF_SEC == (k)) pt_##k = PROF_T();
#define PROF_END(k) if (PROF_SEC == (k)) pacc += PROF_T() - pt_##k;
DI void attn_item(LAS unsigned char* ring, unsigned char* ws, int b, int t0, int lane, int wave, unsigned& pacc) {
    const int g = lane >> 4, c = lane & 15;
    const int t = t0 + wave;
    LAS unsigned char* wl = ring + wave * 16384;
    const bf16* AQ = (const bf16*)(ws + WS_BIG + BO_AQ); const bf16* AKV = (const bf16*)(ws + WS_BIG + BO_AKV); const bf16* IQ = (const bf16*)(ws + WS_BIG + BO_IQ);
    const bf16* IK = (const bf16*)(ws + WS_BIG + BO_IK); const float* IW = (const float*)(ws + WS_BIG + BO_IW); bf16* MIX = (bf16*)(ws + WS_BIG + BO_MIX);
    const size_t m = (size_t)b * SEQ + t; const size_t brow = (size_t)b * SEQ;
    LAS unsigned short* idx = (LAS unsigned short*)(ring + 131072 + 512 * wave);
    const int nk = t + 1; int nsel;
    if (t0 >= 256) {
        PROF_BEGIN(1)
        const bf16* iqp = IQ + m * 1024 + c * 64 + 8 * g;
        const bf16x8 a0 = *(const bf16x8*)iqp, a1 = *(const bf16x8*)(iqp + 32);
        const f32x4 w4 = *(const f32x4*)(IW + m * 16 + 4 * g);
        u32x4 wfu; wfu.x = cvtpk(w4.x, w4.y); wfu.y = cvtpk(w4.z, w4.w); wfu.z = 0u; wfu.w = 0u;
        const bf16x8 wfrag = __builtin_bit_cast(bf16x8, wfu); const bf16x8 zfrag = (bf16x8){0, 0, 0, 0, 0, 0, 0, 0};
        asm volatile("s_waitcnt vmcnt(0)" :: "v"(a0), "v"(a1), "v"(wfrag) : "memory");
        const int nchunk = (t0 + 8 + 255) >> 8;
        const int r8 = lane >> 3, s8 = lane & 7;
#define ISSUE_IK(k) do { _Pragma("unroll") for (int i_ = 0; i_ < 4; ++i_) { const int row_ = 32 * wave + 8 * i_; \
            dma16(IK + (brow + 256 * (k) + row_ + r8) * 64 + 8 * (s8 ^ r8), ring + ((k) & 3) * 32768 + 128 * row_); } } while (0)
#pragma unroll
        for (int k = 0; k < 3; ++k) if (k < nchunk) ISSUE_IK(k);
        unsigned u[32];
#pragma unroll
        for (int k = 0; k < 8; ++k) {
            f32x4 d2 = {0.f, 0.f, 0.f, 0.f};
            if (k < nchunk) {
                const int ahead = nchunk - 1 - k;
                if (ahead >= 2) VMW(8); else if (ahead == 1) VMW(4); else VMW(0);
                __builtin_amdgcn_s_barrier();
                asm volatile("" ::: "memory");
                if (k + 3 < nchunk) ISSUE_IK(k + 3);
                int cc = c; asm volatile("" : "+v"(cc));
                const LAS unsigned char* kbase = ring + (k & 3) * 32768 + 128 * cc;
#pragma unroll
                for (int j = 0; j < 16; ++j) {
                    if (256 * k + 16 * j <= t0 + 7) {
                        const LAS unsigned char* kp = kbase + 2048 * j;
                        const bf16x8 kb0 = *(const LAS bf16x8*)(kp + 16 * (g ^ (cc & 7))), kb1 = *(const LAS bf16x8*)(kp + 16 * ((4 + g) ^ (cc & 7)));
                        f32x4 d = {0.f, 0.f, 0.f, 0.f};
                        d = MFMA16(a0, kb0, d); d = MFMA16(a1, kb1, d);
                        u32x4 ru; ru.x = cvtpk(fmaxf(d.x, 0.f), fmaxf(d.y, 0.f)); ru.y = cvtpk(fmaxf(d.z, 0.f), fmaxf(d.w, 0.f)); ru.z = 0u; ru.w = 0u;
                        d2 = MFMA16((cc == j) ? wfrag : zfrag, __builtin_bit_cast(bf16x8, ru), d2);
                    }
                }
            }
#pragma unroll
            for (int r = 0; r < 4; ++r) { const int key = 256 * k + 16 * (4 * g + r) + c; const unsigned bb = __float_as_uint(d2[r]); const unsigned ok = (bb & 0x80000000u) ? ~bb : (bb | 0x80000000u); u[4 * k + r] = (key < nk) ? ok : 0u; }
        }
        asm volatile("s_waitcnt lgkmcnt(0)" ::: "memory");
        __builtin_amdgcn_s_barrier();
        asm volatile("" ::: "memory");
#undef ISSUE_IK
        PROF_END(1)
        PROF_BEGIN(2)
        unsigned T = 0u;
        for (int bit = 31; bit >= 0; --bit) {
            const unsigned cand = T | (1u << bit); int cnt = 0;
#pragma unroll
            for (int i = 0; i < 32; ++i) cnt += __popcll(__ballot(u[i] >= cand));
            if (cnt >= 256) T = cand;
            if (cnt == 256) break;
        }
        int cgt = 0;
#pragma unroll
        for (int i = 0; i < 32; ++i) cgt += __popcll(__ballot(u[i] > T));
        const int quota = 256 - cgt;
        const unsigned long long lt = (1ull << lane) - 1ull;
        int base = 0, eqrun = 0;
#pragma unroll
        for (int i = 0; i < 32; ++i) {
            const bool gt = u[i] > T, eq = u[i] == T;
            const unsigned long long meq = __ballot(eq);
            const int eqrank = eqrun + __popcll(meq & lt);
            const bool sel = gt || (eq && eqrank < quota);
            const unsigned long long ms = __ballot(sel);
            if (sel) idx[base + __popcll(ms & lt)] = (unsigned short)(256 * (i >> 2) + 16 * (4 * g + (i & 3)) + c);
            base += __popcll(ms); eqrun += __popcll(meq);
        }
        PROF_END(2)
        nsel = 256;
    } else {
#pragma unroll
        for (int r = 0; r < 4; ++r) { const int j = lane + 64 * r; idx[j] = (unsigned short)(j < nk ? j : 0); }
        nsel = nk;
    }
    LDS_WAIT(); __builtin_amdgcn_wave_barrier();
    PROF_BEGIN(3)
    int lane3 = lane; asm volatile("" : "+v"(lane3));
    const int G3 = lane3 >> 4, C3 = lane3 & 15;
    bf16x8 qf[4];
#pragma unroll
    for (int ks = 0; ks < 4; ++ks) { qf[ks] = (bf16x8){0, 0, 0, 0, 0, 0, 0, 0}; if (C3 < 8) qf[ks] = *(const bf16x8*)(AQ + m * 1024 + C3 * 128 + 32 * ks + 8 * G3); }
    asm volatile("s_waitcnt vmcnt(0)" :: "v"(qf[0]), "v"(qf[1]), "v"(qf[2]), "v"(qf[3]) : "memory");
    const int ntile = (nsel + 15) >> 4;
#define ISSUE_K(kt) do { const u32x2 iw_ = *(const LAS u32x2*)(idx + 16 * (kt) + 4 * G3); \
        _Pragma("unroll") for (int i_ = 0; i_ < 4; ++i_) { const int r_ = 4 * i_ + G3; const int key_ = (int)(((i_ & 2) ? iw_.y : iw_.x) >> (16 * (i_ & 1))) & 0xffff; \
        dma16(AKV + (brow + key_) * 256 + 8 * (C3 ^ r_), wl + ((kt) & 3) * 4096 + 1024 * i_); } } while (0)
#pragma unroll
    for (int kt = 0; kt < 4; ++kt) if (kt < ntile) ISSUE_K(kt);
    f32x4 s[16];
#pragma unroll
    for (int kt = 0; kt < 16; ++kt) {
        s[kt] = (f32x4){-INFINITY, -INFINITY, -INFINITY, -INFINITY};
        if (kt < ntile) {
            const int ahead = ntile - 1 - kt;
            if (ahead >= 3) VMW(12); else if (ahead == 2) VMW(8); else if (ahead == 1) VMW(4); else VMW(0);
            const LAS unsigned char* kp = wl + (kt & 3) * 4096 + 256 * C3;
            bf16x8 ka[4];
#pragma unroll
            for (int ks = 0; ks < 4; ++ks) ka[ks] = *(const LAS bf16x8*)(kp + 16 * ((4 * ks + G3) ^ C3));
            f32x4 d = {0.f, 0.f, 0.f, 0.f};
#pragma unroll
            for (int ks = 0; ks < 4; ++ks) d = MFMA16(ka[ks], qf[ks], d);
#pragma unroll
            for (int r = 0; r < 4; ++r) s[kt][r] = (16 * kt + 4 * r + G3 < nsel) ? d[r] : -INFINITY;
            asm volatile("" :: "v"(d) : "memory");
            if (kt + 4 < ntile) ISSUE_K(kt + 4);
        }
    }
    const int nstep = (nsel + 31) >> 5;
#define ISSUE_V(st) do { const u32x2 ia_ = *(const LAS u32x2*)(idx + 32 * (st) + 4 * G3), ib_ = *(const LAS u32x2*)(idx + 32 * (st) + 16 + 4 * G3); \
        _Pragma("unroll") for (int i_ = 0; i_ < 8; ++i_) { const int r_ = 4 * i_ + G3; const u32x2 iw_ = (i_ & 4) ? ib_ : ia_; const int key_ = (int)(((i_ & 2) ? iw_.y : iw_.x) >> (16 * (i_ & 1))) & 0xffff; \
        dma16(AKV + (brow + key_) * 256 + 128 + 8 * (C3 ^ (2 * (r_ & 7))), wl + ((st) & 1) * 8192 + 1024 * i_); } } while (0)
    ISSUE_V(0);
    if (nstep > 1) ISSUE_V(1);
    float mx = -INFINITY;
#pragma unroll
    for (int kt = 0; kt < 16; ++kt) mx = fmaxf(fmaxf(mx, fmaxf(s[kt][0], s[kt][1])), fmaxf(s[kt][2], s[kt][3]));
    mx = fmaxf(mx, __shfl_xor(mx, 16)); mx = fmaxf(mx, __shfl_xor(mx, 32));
    float l = 0.f;
#pragma unroll
    for (int kt = 0; kt < 16; ++kt)
#pragma unroll
        for (int r = 0; r < 4; ++r) { const float p = __builtin_amdgcn_exp2f(s[kt][r] - mx); s[kt][r] = p; l += p; }
    l += __shfl_xor(l, 16); l += __shfl_xor(l, 32);
    const float inv = 1.0f / l;
    f32x4 o[8];
#pragma unroll
    for (int dt = 0; dt < 8; ++dt) o[dt] = (f32x4){0.f, 0.f, 0.f, 0.f};
    const int q4 = C3 >> 2, p4 = C3 & 3, r0 = 4 * G3 + q4;
#pragma unroll
    for (int st = 0; st < 8; ++st) {
        if (st < nstep) {
            if (st + 1 < nstep) VMW(8); else VMW(0);
            u32x4 pw; pw.x = cvtpk(s[2 * st][0], s[2 * st][1]); pw.y = cvtpk(s[2 * st][2], s[2 * st][3]); pw.z = cvtpk(s[2 * st + 1][0], s[2 * st + 1][1]); pw.w = cvtpk(s[2 * st + 1][2], s[2 * st + 1][3]);
            const bf16x8 pb = __builtin_bit_cast(bf16x8, pw);
            const unsigned vb = (unsigned)(uintptr_t)(wl + (st & 1) * 8192 + 256 * r0 + 8 * (p4 & 1));
            s16x4 lo[8], hi[8];
#pragma unroll
            for (int dt = 0; dt < 8; ++dt) {
                const unsigned pos = vb + 16 * ((2 * dt + (p4 >> 1)) ^ (2 * (r0 & 7)));
                asm volatile("ds_read_b64_tr_b16 %0, %1" : "=&v"(lo[dt]) : "v"(pos) : "memory");
                asm volatile("ds_read_b64_tr_b16 %0, %1 offset:4096" : "=&v"(hi[dt]) : "v"(pos) : "memory");
            }
            asm volatile("s_waitcnt lgkmcnt(0)" : "+v"(lo[0]), "+v"(lo[1]), "+v"(lo[2]), "+v"(lo[3]), "+v"(lo[4]), "+v"(lo[5]), "+v"(lo[6]), "+v"(lo[7]),
                                                  "+v"(hi[0]), "+v"(hi[1]), "+v"(hi[2]), "+v"(hi[3]), "+v"(hi[4]), "+v"(hi[5]), "+v"(hi[6]), "+v"(hi[7]) :: "memory");
#pragma unroll
            for (int dt = 0; dt < 8; ++dt) o[dt] = MFMA16(cat8(lo[dt], hi[dt]), pb, o[dt]);
            asm volatile("" :: "v"(o[7]) : "memory");
            if (st + 2 < nstep) ISSUE_V(st + 2);
        }
    }
    if (C3 < 8) {
        bf16* op = MIX + m * 2048 + C3 * 128 + 4 * G3;
#pragma unroll
        for (int dt = 0; dt < 8; ++dt) { u32x2 w; w.x = cvtpk(o[dt][0] * inv, o[dt][1] * inv); w.y = cvtpk(o[dt][2] * inv, o[dt][3] * inv); *(u32x2*)(op + 16 * dt) = w; }
    }
    PROF_END(3)
#undef ISSUE_K
#undef ISSUE_V
}

DI void ret_chain(Frame& F, int b, int h, const float* gn) {
    LAS unsigned char* lds = F.lds + RING_OFF; unsigned char* ws = F.ws;
    const bf16* RQ = (const bf16*)(ws + WS_BIG + BO_RQ); const bf16* RK = (const bf16*)(ws + WS_BIG + BO_RK); const bf16* RV = (const bf16*)(ws + WS_BIG + BO_RV);
    const bf16* RG = (const bf16*)(ws + WS_BIG + BO_RG); bf16* MIX = (bf16*)(ws + WS_BIG + BO_MIX);
    const int tid = fresh_tid(), lane = tid & 63, w = __builtin_amdgcn_readfirstlane(tid >> 6), g = lane >> 4, c = lane & 15, q4 = c >> 2, p4 = c & 3;
    const float lg = pg8::log2_gamma(h);
    const int i = 16 * w + c;
    const float xi = __builtin_amdgcn_exp2f((float)(i + 1) * lg), fi = __builtin_amdgcn_exp2f((float)(i - 127) * lg), gC = __builtin_amdgcn_exp2f(128.0f * lg);
    f32x4 RT[4];
#pragma unroll
    for (int dt = 0; dt < 4; ++dt) RT[dt] = (f32x4){0.f, 0.f, 0.f, 0.f};
    for (int ch = 0; ch < 16; ++ch) {
        const size_t row0 = (size_t)b * SEQ + 128 * ch;
        __syncthreads();
#pragma unroll
        for (int r = 0; r < 2; ++r) { const int row = (tid >> 3) + 64 * r, ck = tid & 7; *(LAS u32x4*)(lds + RET_K + row * RET_KST + 16 * ck) = *(const u32x4*)(RK + (row0 + row) * 512 + h * 64 + 8 * ck); }
#pragma unroll
        for (int r = 0; r < 4; ++r) { const int row = (tid >> 4) + 32 * r, ck = tid & 15; *(LAS u32x4*)(lds + RET_V + row * RET_VST + 16 * ck) = *(const u32x4*)(RV + (row0 + row) * 1024 + h * 128 + 8 * ck); }
#pragma unroll
        for (int dt = 0; dt < 4; ++dt)
#pragma unroll
            for (int r = 0; r < 4; ++r) *(LAS unsigned short*)(lds + RET_R + (16 * w + 4 * g + r) * RET_KST + 2 * (16 * dt + c)) = (unsigned short)f2bf(RT[dt][r]);
        __syncthreads();
        const bf16* qp = RQ + (row0 + i) * 512 + h * 64 + 8 * g;
        const bf16x8 qb0 = *(const bf16x8*)qp, qb1 = *(const bf16x8*)(qp + 32);
        f32x4 o[8];
#pragma unroll
        for (int vt = 0; vt < 8; ++vt) o[vt] = (f32x4){0.f, 0.f, 0.f, 0.f};
        if (ch > 0) {
#pragma unroll
            for (int vt = 0; vt < 8; ++vt) {
                const LAS unsigned char* rp = lds + RET_R + (16 * vt + c) * RET_KST + 16 * g;
                o[vt] = MFMA16(*(const LAS bf16x8*)rp, qb0, o[vt]); o[vt] = MFMA16(*(const LAS bf16x8*)(rp + 64), qb1, o[vt]);
            }
#pragma unroll
            for (int vt = 0; vt < 8; ++vt) o[vt] = o[vt] * xi;
        }
#pragma unroll
        for (int st = 0; st < 4; ++st) {
            if (2 * st <= w) {
                f32x4 d0 = {0.f, 0.f, 0.f, 0.f}, d1 = {0.f, 0.f, 0.f, 0.f};
                { const LAS unsigned char* kp = lds + RET_K + (32 * st + c) * RET_KST + 16 * g;
                  d0 = MFMA16(*(const LAS bf16x8*)kp, qb0, d0); d0 = MFMA16(*(const LAS bf16x8*)(kp + 64), qb1, d0);
                  d1 = MFMA16(*(const LAS bf16x8*)(kp + 16 * RET_KST), qb0, d1); d1 = MFMA16(*(const LAS bf16x8*)(kp + 16 * RET_KST + 64), qb1, d1); }
#pragma unroll
                for (int r = 0; r < 4; ++r) { const int j0 = 32 * st + 4 * g + r; d0[r] = (j0 <= i) ? d0[r] * fi : 0.f; d1[r] = (j0 + 16 <= i) ? d1[r] * fi : 0.f; }
                u32x4 pw; pw.x = cvtpk(d0[0], d0[1]); pw.y = cvtpk(d0[2], d0[3]); pw.z = cvtpk(d1[0], d1[1]); pw.w = cvtpk(d1[2], d1[3]);
                const bf16x8 pb = __builtin_bit_cast(bf16x8, pw);
                LAS unsigned char* vb = lds + RET_V + (32 * st + 4 * g + q4) * RET_VST + 8 * p4;
#pragma unroll
                for (int vt = 0; vt < 8; ++vt) {
                    const s16x4 lo = tr_read(vb + 32 * vt), hi = tr_read(vb + 16 * RET_VST + 32 * vt);
                    o[vt] = MFMA16(cat8(lo, hi), pb, o[vt]);
                }
            }
        }
        {
            float sm = 0.f;
#pragma unroll
            for (int vt = 0; vt < 8; ++vt) sm += (o[vt][0] + o[vt][1]) + (o[vt][2] + o[vt][3]);
            sm += __shfl_xor(sm, 16); sm += __shfl_xor(sm, 32);
            const float mu = sm * (1.0f / 128.0f); float vq = 0.f;
#pragma unroll
            for (int vt = 0; vt < 8; ++vt) { const f32x4 dd = o[vt] - mu; vq += (dd[0] * dd[0] + dd[1] * dd[1]) + (dd[2] * dd[2] + dd[3] * dd[3]); }
            vq += __shfl_xor(vq, 16); vq += __shfl_xor(vq, 32);
            const float rstd = 1.0f / sqrtf(vq * (1.0f / 128.0f) + GN_EPS);
            const size_t mrow = row0 + i;
#pragma unroll
            for (int vt = 0; vt < 8; ++vt) {
                const int v0 = h * 128 + 16 * vt + 4 * g;
                const f32x4 gw = *(const f32x4*)(gn + v0); const u32x2 gt = *(const u32x2*)(RG + mrow * 1024 + v0);
                const float y0 = (o[vt][0] - mu) * rstd * gw[0] * bflo(gt.x), y1 = (o[vt][1] - mu) * rstd * gw[1] * bfhi(gt.x), y2 = (o[vt][2] - mu) * rstd * gw[2] * bflo(gt.y), y3 = (o[vt][3] - mu) * rstd * gw[3] * bfhi(gt.y);
                u32x2 ow; ow.x = cvtpk(y0, y1); ow.y = cvtpk(y2, y3); *(u32x2*)(MIX + mrow * 2048 + 1024 + v0) = ow;
            }
        }
#pragma unroll
        for (int dt = 0; dt < 4; ++dt) RT[dt] = RT[dt] * gC;
#pragma unroll
        for (int st = 0; st < 4; ++st) {
            LAS unsigned char* vb = lds + RET_V + (32 * st + 8 * g + q4) * RET_VST + 32 * w + 8 * p4;
            const bf16x8 va = cat8(tr_read(vb), tr_read(vb + 4 * RET_VST));
            LAS unsigned char* kp = lds + RET_K + (32 * st + 8 * g + q4) * RET_KST + 8 * p4;
#pragma unroll
            for (int dt = 0; dt < 4; ++dt) { const bf16x8 kbf = cat8(tr_read(kp + 32 * dt), tr_read(kp + 4 * RET_KST + 32 * dt)); RT[dt] = MFMA16(va, kbf, RT[dt]); }
        }
    }
    __syncthreads();
}

constexpr int N_Q_ITEMS = 16 + 2 * (SEQ / NWAVES);
DI void mixer_phase(Frame& F, int lq, const float* gn) {
    const int tid = fresh_tid(), lane = tid & 63, wave = __builtin_amdgcn_readfirstlane(tid >> 6);
    const int x0 = (int)(xb_xcc_id() & 7u);
    unsigned pacc = 0;
    for (int k = 0; k < 8; ++k) {
        const int q = (x0 + k) & 7;
        gu32* qctr = F.ctl + CW_Q + 64 * (8 * lq + q);
        for (;;) {
            if (tid == 0) F.MISC[0] = __hip_atomic_fetch_add(qctr, 1u, __ATOMIC_RELAXED, __HIP_MEMORY_SCOPE_AGENT);
            __syncthreads();
            const int item = (int)F.MISC[0];
            __syncthreads();
            if (item >= N_Q_ITEMS) break;
            if (item < 16) { PROF_BEGIN(4) ret_chain(F, 2 * q + (item >> 3), item & 7, gn); PROF_END(4) }
            else { const int ia = item - 16; const int tb = (SEQ / NWAVES - 1) - (ia >> 1), b = 2 * q + (ia & 1);
                attn_item(F.lds + RING_OFF, F.ws, b, tb * NWAVES, lane, wave, pacc); }
        }
    }
    if (PROF_SEC != 0) { pacc = __builtin_amdgcn_readfirstlane(pacc); const unsigned t0 = PROF_T(); while (PROF_T() - t0 < pacc && pacc < 400000000u) __builtin_amdgcn_s_sleep(4); }
}

#ifndef MK_N_LAUNCHES
#define MK_N_LAUNCHES 1
#endif
constexpr int NPH = 1 + 10 * DEPTH;
constexpr int N_LAUNCHES = MK_N_LAUNCHES;
static_assert(N_LAUNCHES == 1 || N_LAUNCHES == NPH, "MK_N_LAUNCHES must be 1 or NPH");
struct Args { const void* in[15]; float* out; unsigned char* ws; int ph_lo, ph_hi, li, pad; };

__global__ void __launch_bounds__(NWAVES * 64, 2) hyb_fwd(Args args) {
    extern __shared__ __attribute__((aligned(16))) unsigned char lds[];
    Frame F;
    F.lds = (LAS unsigned char*)lds;
    F.MISC = (volatile LAS unsigned*)(F.lds + MISC_OFF);
    F.G = gridDim.x; F.ws = args.ws; F.ctl = (gu32*)(args.ws + WS_CTL); F.in = nullptr;
    for (int u = threadIdx.x; u < (LDS_BYTES - LDSCTL_OFF) / 4; u += NWAVES * 64) ((LAS unsigned*)(F.lds + LDSCTL_OFF))[u] = 0u;
    __syncthreads();
    XcdBarrier bar; bar.bar = (unsigned*)(F.ctl + CW_BAR); bar.x = 0; bar.st = nullptr;
    if (N_LAUNCHES == 1) bar = xcd_barrier_post((unsigned*)(F.ctl + CW_BAR), F.MISC + 8);
    const int lo = args.ph_lo, hi = args.ph_hi;
#ifndef PHASE_MASK
#define PHASE_MASK 0x7ff
#endif
#define PON(j) (((PHASE_MASK) >> (j)) & 1)
#ifndef PROBE_DUP
#define PROBE_DUP 0
#endif
#define DUPN(j) (1 + (((PROBE_DUP) >> (j)) & 1))
#define IN(k) (lo <= (k) && (k) < hi)
#define SEAM(k) do { if (N_LAUNCHES == 1 && IN(k) && IN((k) + 1)) xcd_barrier(bar); } while (0)
    const float* x = (const float*)args.in[0]; const float* pin = (const float*)args.in[1]; const int* positions = (const int*)args.in[2];
    const float* w_in = (const float*)args.in[3]; const float* w_out = (const float*)args.in[4]; const float* w_ff1 = (const float*)args.in[5]; const float* w_ff2 = (const float*)args.in[6];
    const float* w_ple = (const float*)args.in[7]; const float* w_gate = (const float*)args.in[8]; const float* pre_mix = (const float*)args.in[9]; const float* post_mix = (const float*)args.in[10];
    const float* pre_ff = (const float*)args.in[11]; const float* post_ff = (const float*)args.in[12]; const float* ple_norm = (const float*)args.in[13]; const float* ret_gn = (const float*)args.in[14];
    float* out = args.out; unsigned char* ws = args.ws; unsigned char* big = ws + WS_BIG;
    pg8::bf16_t* HB = (pg8::bf16_t*)(ws + WS_HB); pg8::bf16_t* Y = (pg8::bf16_t*)(ws + WS_Y); float* SS = (float*)(ws + WS_SS); float* RS = (float*)(ws + WS_RS);

    if (PON(0) && IN(0)) for (int rep = 0; rep < DUPN(0); ++rep) p0_prologue(F, x, positions, w_in, w_out, w_ff1, w_ff2, w_ple, w_gate, pre_mix, pre_ff);
    SEAM(0);
    for (int l = 0; l < DEPTH; ++l) {
        const int pb = 1 + 10 * l;
        unsigned char* wl = ws + WS_W + (size_t)l * W_LAYER;
        if (PON(1) && IN(pb + 0)) for (int rep = 0; rep < DUPN(1); ++rep) {
            pg8::Gemm g{HB, (const pg8::bf16_t*)(wl + WO_IN), M, NINP, DM}; pg8::StaticOrder S; S.init(M, NINP, F.G, (int)blockIdx.x);
            pg8::EpiIn E{big, RS, (const float*)(ws + WS_ROPE)};
            pg8::gemm_phase<pg8::EpiIn, pg8::StaticOrder, true, true>(F.lds + RING_OFF, g, S, E);
        }
        SEAM(pb + 0);
        if (PON(2) && IN(pb + 1)) for (int rep = 0; rep < DUPN(2); ++rep) mixer_phase(F, l + 2 * rep, ret_gn + (size_t)l * 1024);
        SEAM(pb + 1);
        if (PON(3) && IN(pb + 2)) for (int rep = 0; rep < DUPN(3); ++rep) {
            pg8::Gemm g{(const pg8::bf16_t*)(big + BO_MIX), (const pg8::bf16_t*)(wl + WO_OUT), M, DM, DM}; pg8::StaticOrder S; S.init(M, DM, F.G, (int)blockIdx.x);
            pg8::EpiY E{Y, SS, nullptr};
            pg8::gemm_phase<pg8::EpiY, pg8::StaticOrder, true, true>(F.lds + RING_OFF, g, S, E);
        }
        SEAM(pb + 2);
        if (PON(4) && IN(pb + 3)) thin_phase(F, l == 0 ? x : out, out, post_mix + (size_t)l * DM, nullptr);
        SEAM(pb + 3);
        if (PON(5) && IN(pb + 4)) for (int rep = 0; rep < DUPN(5); ++rep) {
            pg8::Gemm g{HB, (const pg8::bf16_t*)(wl + WO_FF1), M, DFF, DM}; pg8::StaticOrder S; S.init(M, DFF, F.G, (int)blockIdx.x);
            pg8::EpiFF1 E{(pg8::bf16_t*)(big + BO_HID), RS};
            pg8::gemm_phase<pg8::EpiFF1, pg8::StaticOrder, true, true>(F.lds + RING_OFF, g, S, E);
        }
        SEAM(pb + 4);
        if (PON(6) && IN(pb + 5)) for (int rep = 0; rep < DUPN(6); ++rep) {
            pg8::Gemm g{(const pg8::bf16_t*)(big + BO_HID), (const pg8::bf16_t*)(wl + WO_FF2), M, DM, DFF}; pg8::StaticOrder S; S.init(M, DM, F.G, (int)blockIdx.x);
            pg8::EpiY E{Y, SS, nullptr};
            pg8::gemm_phase<pg8::EpiY, pg8::StaticOrder, true, true>(F.lds + RING_OFF, g, S, E);
        }
        SEAM(pb + 5);
        if (PON(7) && IN(pb + 6)) thin_phase(F, out, out, post_ff + (size_t)l * DM, pin + (size_t)l * M * PLE);
        SEAM(pb + 6);
        if (PON(8) && IN(pb + 7)) for (int rep = 0; rep < DUPN(8); ++rep) {
            int kple = PLE; asm volatile("" : "+s"(kple));
            pg8::Gemm g{(const pg8::bf16_t*)(big + BO_PB), (const pg8::bf16_t*)(wl + WO_PLE), M, DM, kple}; pg8::StaticOrder S; S.init(M, DM, F.G, (int)blockIdx.x);
            pg8::EpiPlain E{(pg8::bf16_t*)(big + BO_E), DM};
            pg8::gemm_phase<pg8::EpiPlain, pg8::StaticOrder, true, true>(F.lds + RING_OFF, g, S, E);
        }
        SEAM(pb + 7);
        if (PON(9) && IN(pb + 8)) for (int rep = 0; rep < DUPN(9); ++rep) {
            pg8::Gemm g{HB, (const pg8::bf16_t*)(wl + WO_GATE), M, DM, DM}; pg8::StaticOrder S; S.init(M, DM, F.G, (int)blockIdx.x);
            pg8::EpiY E{Y, SS, (const pg8::bf16_t*)(big + BO_E)};
            pg8::gemm_phase<pg8::EpiY, pg8::StaticOrder, true, true>(F.lds + RING_OFF, g, S, E);
        }
        SEAM(pb + 8);
        if (PON(10) && IN(pb + 9)) thin_phase(F, out, out, ple_norm + (size_t)l * DM, nullptr);
        SEAM(pb + 9);
    }
#undef IN
#undef SEAM
}

extern "C" void kernel_launch(void* const* d_in, const int* in_sizes, int n_in, void* d_out, int out_size, void* d_ws, size_t ws_size, hipStream_t stream) {
    static int grid = 0;
    if (grid == 0) {
        if (n_in != 15 || out_size != M * DM || ws_size < WS_END) { fprintf(stderr, "kernel_launch: unexpected shapes (n_in %d, out %d, ws %zu, need %zu)\n", n_in, out_size, ws_size, (size_t)WS_END); grid = -1; return; }
        int dev = 0, cus = 0, per_cu = 0;
        if (hipGetDevice(&dev) != hipSuccess || hipDeviceGetAttribute(&cus, hipDeviceAttributeMultiprocessorCount, dev) != hipSuccess) { grid = -1; return; }
        if (hipFuncSetAttribute((const void*)hyb_fwd, hipFuncAttributeMaxDynamicSharedMemorySize, LDS_BYTES) != hipSuccess) { fprintf(stderr, "kernel_launch: hipFuncSetAttribute failed\n"); grid = -1; return; }
        if (hipOccupancyMaxActiveBlocksPerMultiprocessor(&per_cu, (const void*)hyb_fwd, NWAVES * 64, LDS_BYTES) != hipSuccess || per_cu < 1)
            fprintf(stderr, "kernel_launch: note: occupancy query reports %d workgroups per CU\n", per_cu);
        (void)hipGetLastError();
        grid = cus;
    }
    if (grid < 0) return;
    if (hipMemsetAsync((char*)d_ws + WS_CTL, 0, CTL_ZERO_BYTES, stream) != hipSuccess) return;
    Args a{};
    for (int i = 0; i < 15; ++i) a.in[i] = d_in[i];
    a.out = (float*)d_out; a.ws = (unsigned char*)d_ws;
    for (int li = 0; li < N_LAUNCHES; ++li) {
        a.ph_lo = (N_LAUNCHES == 1) ? 0 : li; a.ph_hi = (N_LAUNCHES == 1) ? NPH : li + 1; a.li = li; a.pad = 0;
        hipLaunchKernelGGL(hyb_fwd, dim3(grid), dim3(NWAVES * 64), LDS_BYTES, stream, a);
        if (hipPeekAtLastError() != hipSuccess) { fprintf(stderr, "kernel_launch: launch %d failed\n", li); break; }
    }
}
```

```cpp
#include <hip/hip_runtime.h>
#include <cstdio>
#include <cstdint>

constexpr int NWAVES = 8;
constexpr int BATCH = 16, SEQ = 2048, DM = 2048, DEPTH = 2, M = BATCH * SEQ;
constexpr int NINL = 5456, NINP = 5632, DFF = 8192, PLE = 256;
constexpr float RMS_EPS = 1e-6f, GN_EPS = 1e-5f;
constexpr float QSCALE = 0.08838834764831845f * 1.4426950408889634f;
constexpr float LOG2_THETA_A = 18.931568569324174f, LOG2_THETA_R = 13.287712379549449f;

constexpr size_t MiB = 1u << 20;
constexpr size_t WS_CTL = 0, CTL_ZERO_BYTES = 65536;
constexpr size_t WS_W = 1 * MiB, W_LAYER = 103 * MiB;
constexpr size_t WO_IN = 0, WO_OUT = 22 * MiB, WO_FF1 = 30 * MiB, WO_FF2 = 62 * MiB, WO_PLE = 94 * MiB, WO_GATE = 95 * MiB;
constexpr size_t WS_ROPE = 207 * MiB;
constexpr size_t WS_HB = 221 * MiB, WS_Y = 349 * MiB, WS_SS = 477 * MiB, WS_RS = 481 * MiB, WS_BIG = 482 * MiB;
constexpr size_t BO_AQ = 0, BO_AKV = 64 * MiB, BO_IQ = 80 * MiB, BO_IK = 144 * MiB, BO_IW = 148 * MiB, BO_RQ = 150 * MiB, BO_RK = 182 * MiB,
                 BO_RV = 214 * MiB, BO_RG = 278 * MiB, BO_MIX = 342 * MiB;
constexpr size_t BO_HID = 0, BO_E = 0, BO_PB = 128 * MiB;
constexpr size_t WS_END = 994 * MiB;
constexpr int ROPE_W = 112;
constexpr int CW_BAR = 4096, CW_Q = 8192;
constexpr int RING_OFF = 0, RING_BYTES = 139264;
constexpr int LDSCTL_OFF = RING_BYTES, MISC_OFF = LDSCTL_OFF + 320;
constexpr int LDS_BYTES = 147456;
static_assert(MISC_OFF + 128 <= LDS_BYTES, "LDS map");
namespace pg8 {
#define PG8_LAS __attribute__((address_space(3)))
typedef unsigned short bf16_t;
typedef short bf16x8 __attribute__((ext_vector_type(8)));
typedef float f32x4 __attribute__((ext_vector_type(4)));
typedef unsigned u32x4 __attribute__((ext_vector_type(4)));
constexpr int BM = 256, BK = 64, HALF = 128, HTB = HALF * BK * 2  , STAGE_BYTES = 8 * HTB, NXCD = 8, WGM = 8;

__host__ __device__ __forceinline__ int lds_byte(int r, int c) { const int st = (r >> 4) * 2 + (c >> 5), rr = r & 15, cc = c & 31, ob = rr * 64 + cc * 2; return st * 1024 + (ob ^ (((ob >> 9) & 1) << 5)); }
__host__ __device__ __forceinline__ void stage_rc(int b, int& R, int& C) { const int st = b / 1024, sb = b % 1024, swz = sb ^ (((sb >> 9) & 1) << 5); R = (st >> 1) * 16 + swz / 64; C = (st & 1) * 32 + (swz % 64) / 2; }
__host__ __device__ __forceinline__ int perm32(int rho) { const int n = rho >> 4, i = rho & 15; return 8 * (i >> 2) + 4 * n + (i & 3); }

struct Unit { int pm, pn; };
struct Gemm { const bf16_t* A; const bf16_t* Bt; int M, N, K; };

struct StaticOrder {
    int nM, nN, nwg, G, c;
    __host__ __device__ void init(int M, int N, int G_, int c_) { nM = M / BM; nN = N / BM; nwg = nM * nN; G = G_; c = c_; }
    __host__ __device__ bool next(int i, Unit& u) const {
        const long L = (long)i * G + c; if (L >= nwg) return false;
        int wgid = (int)L; { const int q = nwg / NXCD, r = nwg % NXCD, xcd = wgid % NXCD, off = wgid / NXCD; wgid = (xcd < r ? xcd * (q + 1) : r * (q + 1) + (xcd - r) * q) + off; }
        const int nig = WGM * nN, gid = wgid / nig, fm = gid * WGM, gsz = (nM - fm) < WGM ? (nM - fm) : WGM;
        u.pm = fm + ((wgid % nig) % gsz); u.pn = (wgid % nig) / gsz; return true;
    }
    __device__ __forceinline__ void a_ready(const Unit&) const {}
    __device__ __forceinline__ void done(const Unit&) const {}
};
__device__ __forceinline__ unsigned cvt_pk_bf16(float lo, float hi) { unsigned r; asm volatile("v_cvt_pk_bf16_f32 %0, %1, %2" : "=v"(r) : "v"(lo), "v"(hi)); return r; }
typedef float f32x2 __attribute__((ext_vector_type(2)));

__device__ __forceinline__ u32x4 pack8(const f32x4& v0, const f32x4& v1) { u32x4 w; w.x = cvt_pk_bf16(v0[0], v0[1]); w.y = cvt_pk_bf16(v0[2], v0[3]); w.z = cvt_pk_bf16(v1[0], v1[1]); w.w = cvt_pk_bf16(v1[2], v1[3]); return w; }
__device__ __forceinline__ float bf_lo(unsigned w) { return __uint_as_float(w << 16); }
__device__ __forceinline__ float bf_hi(unsigned w) { return __uint_as_float(w & 0xffff0000u); }
__device__ __forceinline__ float fast_sigmoid(float x) { return __builtin_amdgcn_rcpf(1.0f + __builtin_amdgcn_exp2f(-1.4426950408889634f * x)); }
__device__ __forceinline__ float log2_gamma(int h) { const float e = __builtin_amdgcn_exp2f(-5.0f - (float)h); return -(e * (1.0f + e * (0.5f + e * (0.33333333f + e * (0.25f + e * 0.2f))))) * 1.4426950408889634f; }

struct EpiIn {
    static constexpr bool PERM = true, AFTER_DRAIN = false;
    unsigned char* big; const float* RS; const float* ROPE;
    struct Col { size_t dofs; int ldc, dcol, mode; bool has, rot; float scale, lg; };
    __device__ __forceinline__ void operator()(const f32x4 (&acc)[2][2][4][2], const Unit& u, int wr, int wc, int fr_, int fq_) const {
        int fr = fr_, fq = fq_; asm volatile("" : "+v"(fr), "+v"(fq));
        const int pn = u.pn;
        Col cl[2]; int coff = 0, soff = 0;
#pragma unroll
        for (int bj = 0; bj < 2; ++bj) {
            const int c256 = 128 * bj + 32 * wc + 8 * fq;
            Col k; k.dofs = 0; k.ldc = 0; k.dcol = 0; k.mode = 0; k.has = false; k.rot = false; k.scale = 1.f; k.lg = 0.f;
            if (pn < 4)       { k.dofs = BO_AQ;  k.has = true; k.ldc = 1024; k.dcol = pn * 256 + c256;        k.rot = (wc == 0); coff = 4 * fq; soff = 16 + 4 * fq; k.scale = QSCALE; }
            else if (pn == 4) { k.dofs = BO_AKV; k.has = true; k.ldc = 256;  k.dcol = c256;                   k.rot = (bj == 0 && wc == 0); coff = 4 * fq; soff = 16 + 4 * fq; }
            else if (pn < 9)  { k.dofs = BO_IQ;  k.has = true; k.ldc = 1024; k.dcol = (pn - 5) * 256 + c256;  k.rot = ((wc & 1) == 0 && fq < 2); coff = 32 + 4 * fq; soff = 40 + 4 * fq; }
            else if (pn == 9) { if (bj == 0 && wc < 2) { k.dofs = BO_IK; k.has = true; k.ldc = 64; k.dcol = c256; k.rot = (wc == 0 && fq < 2); coff = 32 + 4 * fq; soff = 40 + 4 * fq; }
                                else if (bj == 0 && wc == 2 && fq < 2) { k.mode = 3; } }
            else if (pn < 12) { k.dofs = BO_RQ;  k.has = true; k.ldc = 512;  k.dcol = (pn - 10) * 256 + c256; k.rot = true; coff = 48 + 16 * (wc & 1) + 4 * fq; soff = 80 + 16 * (wc & 1) + 4 * fq; }
            else if (pn < 14) { k.dofs = BO_RK;  k.has = true; k.ldc = 512;  k.dcol = (pn - 12) * 256 + c256; k.rot = true; coff = 48 + 16 * (wc & 1) + 4 * fq; soff = 80 + 16 * (wc & 1) + 4 * fq; k.scale = 0.125f; k.mode = 2;
                                k.lg = log2_gamma(4 * (pn - 12) + 2 * bj + (wc >> 1)); }
            else if (pn < 18) { k.dofs = BO_RV;  k.has = true; k.ldc = 1024; k.dcol = (pn - 14) * 256 + c256; }
            else              { k.dofs = BO_RG;  k.has = true; k.ldc = 1024; k.dcol = (pn - 18) * 256 + c256; k.mode = 1; }
            cl[bj] = k;
        }
        const bool anyrot = cl[0].rot || cl[1].rot;
        float* IW = (float*)(big + BO_IW);
#pragma unroll
        for (int ai = 0; ai < 2; ++ai) {
            float rsv[4]; f32x4 cs[4], sn[4];
#pragma unroll
            for (int m = 0; m < 4; ++m) { const int row = u.pm * BM + ai * HALF + wr * 64 + m * 16 + fr; rsv[m] = RS[row];
                cs[m] = (f32x4){1.f, 1.f, 1.f, 1.f}; sn[m] = (f32x4){0.f, 0.f, 0.f, 0.f};
                if (anyrot) { const float* rp = ROPE + (size_t)row * ROPE_W; cs[m] = *(const f32x4*)(rp + coff); sn[m] = *(const f32x4*)(rp + soff); } }
#pragma unroll
            for (int m = 0; m < 4; ++m) {
                const int row = u.pm * BM + ai * HALF + wr * 64 + m * 16 + fr;
#pragma unroll
                for (int bj = 0; bj < 2; ++bj) {
                    const Col& k = cl[bj];
                    if (!k.has && k.mode != 3) continue;
                    float sc = rsv[m] * k.scale;
                    if (k.mode == 2) sc *= __builtin_amdgcn_exp2f((float)(127 - (row & 127)) * k.lg);
                    f32x4 v0 = acc[ai][bj][m][0], v1 = acc[ai][bj][m][1];
                    if (k.rot) { const f32x4 a = v0 * cs[m] - v1 * sn[m], b = v1 * cs[m] + v0 * sn[m]; v0 = a; v1 = b; }
                    v0 = v0 * sc; v1 = v1 * sc;
                    if (k.mode == 1) {
#pragma unroll
                        for (int j = 0; j < 4; ++j) { v0[j] = v0[j] * fast_sigmoid(v0[j]); v1[j] = v1[j] * fast_sigmoid(v1[j]); } }
                    if (k.mode == 3) { float* p = IW + (size_t)row * 16 + 8 * fq; *(f32x4*)p = v0; *(f32x4*)(p + 4) = v1; }
                    else *(u32x4*)((bf16_t*)(big + k.dofs) + (size_t)row * k.ldc + k.dcol) = pack8(v0, v1);
                }
            }
            asm volatile("" ::: "memory");
        }
    }
};
struct EpiY {
    static constexpr bool PERM = true, AFTER_DRAIN = false;
    bf16_t* Y; float* SS; const bf16_t* E;
    __device__ __forceinline__ void operator()(const f32x4 (&acc)[2][2][4][2], const Unit& u, int wr, int wc, int fr_, int fq_) const {
        int fr = fr_, fq = fq_; asm volatile("" : "+v"(fr), "+v"(fq));
        const int col0 = u.pn * BM + wc * 32 + 8 * fq;
#pragma unroll
        for (int ai = 0; ai < 2; ++ai) {
            u32x4 ev[4][2];
            if (E) {
#pragma unroll
                for (int m = 0; m < 4; ++m)
#pragma unroll
                    for (int bj = 0; bj < 2; ++bj) ev[m][bj] = *(const u32x4*)(E + (size_t)(u.pm * BM + ai * HALF + wr * 64 + m * 16 + fr) * DM + col0 + bj * HALF);
            }
#pragma unroll
            for (int m = 0; m < 4; ++m) {
                const int row = u.pm * BM + ai * HALF + wr * 64 + m * 16 + fr; float q = 0.f;
#pragma unroll
                for (int bj = 0; bj < 2; ++bj) {
                    f32x4 v0 = acc[ai][bj][m][0], v1 = acc[ai][bj][m][1];
                    if (E) { const u32x4 e = ev[m][bj];
                        v0[0] = fast_sigmoid(v0[0]) * bf_lo(e.x); v0[1] = fast_sigmoid(v0[1]) * bf_hi(e.x); v0[2] = fast_sigmoid(v0[2]) * bf_lo(e.y); v0[3] = fast_sigmoid(v0[3]) * bf_hi(e.y);
                        v1[0] = fast_sigmoid(v1[0]) * bf_lo(e.z); v1[1] = fast_sigmoid(v1[1]) * bf_hi(e.z); v1[2] = fast_sigmoid(v1[2]) * bf_lo(e.w); v1[3] = fast_sigmoid(v1[3]) * bf_hi(e.w); }
                    q += (v0[0] * v0[0] + v0[1] * v0[1]) + (v0[2] * v0[2] + v0[3] * v0[3]) + (v1[0] * v1[0] + v1[1] * v1[1]) + (v1[2] * v1[2] + v1[3] * v1[3]);
                    *(u32x4*)(Y + (size_t)row * DM + col0 + bj * HALF) = pack8(v0, v1);
                }
                q += __shfl_xor(q, 16); q += __shfl_xor(q, 32);
                if (fq == 0) SS[(size_t)row * 32 + u.pn * 4 + wc] = q;
            }
            asm volatile("" ::: "memory");
        }
    }
};
struct EpiFF1 {
    static constexpr bool PERM = true, AFTER_DRAIN = false;
    bf16_t* H; const float* RS;
    __device__ __forceinline__ void operator()(const f32x4 (&acc)[2][2][4][2], const Unit& u, int wr, int wc, int fr_, int fq_) const {
        int fr = fr_, fq = fq_; asm volatile("" : "+v"(fr), "+v"(fq));
        const int col0 = u.pn * BM + wc * 32 + 8 * fq;
        float rsv[2][4];
#pragma unroll
        for (int ai = 0; ai < 2; ++ai)
#pragma unroll
            for (int m = 0; m < 4; ++m) rsv[ai][m] = RS[u.pm * BM + ai * HALF + wr * 64 + m * 16 + fr];
#pragma unroll
        for (int ai = 0; ai < 2; ++ai)
#pragma unroll
            for (int m = 0; m < 4; ++m) {
                const int row = u.pm * BM + ai * HALF + wr * 64 + m * 16 + fr; const float rs = rsv[ai][m];
#pragma unroll
                for (int bj = 0; bj < 2; ++bj) {
                    f32x4 v0 = acc[ai][bj][m][0] * rs, v1 = acc[ai][bj][m][1] * rs;
#pragma unroll
                    for (int j = 0; j < 4; ++j) { const float a = fmaxf(v0[j], 0.f), b = fmaxf(v1[j], 0.f); v0[j] = a * a; v1[j] = b * b; }
                    *(u32x4*)(H + (size_t)row * DFF + col0 + bj * HALF) = pack8(v0, v1);
                }
            }
    }
};
struct EpiPlain {
    static constexpr bool PERM = true, AFTER_DRAIN = false;
    bf16_t* O; int ldc;
    __device__ __forceinline__ void operator()(const f32x4 (&acc)[2][2][4][2], const Unit& u, int wr, int wc, int fr_, int fq_) const {
        int fr = fr_, fq = fq_; asm volatile("" : "+v"(fr), "+v"(fq));
        const int col0 = u.pn * BM + wc * 32 + 8 * fq;
#pragma unroll
        for (int ai = 0; ai < 2; ++ai)
#pragma unroll
            for (int m = 0; m < 4; ++m) {
                const int row = u.pm * BM + ai * HALF + wr * 64 + m * 16 + fr;
#pragma unroll
                for (int bj = 0; bj < 2; ++bj) *(u32x4*)(O + (size_t)row * ldc + col0 + bj * HALF) = pack8(acc[ai][bj][m][0], acc[ai][bj][m][1]);
            }
    }
};
template <class Epi, class Sched, bool ALIGN_EPI = false, bool SP2 = false>
__device__ __forceinline__ void gemm_phase(PG8_LAS unsigned char* lds, const Gemm g, const Sched& S, const Epi& E) {
    int tid_ = threadIdx.x; asm volatile("" : "+v"(tid_));
    const int tid = tid_, wid = __builtin_amdgcn_readfirstlane(tid >> 6), lane = tid & 63, wr = wid >> 2, wc = wid & 3, fr = lane & 15, fq = lane >> 4;
    const int K = g.K, nt = K / BK;
    unsigned voffA[2], voffB[2];
#pragma unroll
    for (int i = 0; i < 2; ++i) { int R, C; stage_rc(tid * 16 + i * 8192, R, C); const int Rb = Epi::PERM ? ((R & ~31) + perm32(R & 31)) : R;
        voffA[i] = (unsigned)(R * K + C) * 2u; voffB[i] = (unsigned)(Rb * K + C) * 2u; }
    const size_t kstep = (size_t)(BK * 2);
    const size_t hstep = (size_t)HALF * K * 2;
    const size_t tstep = 2 * hstep;
    const unsigned ldsw = (unsigned)wid * 1024u;
    const int aoff = lds_byte(wr * 64 + fr, fq * 8), boff = lds_byte(wc * 32 + fr, fq * 8);
#define PG8_SA(b, h) (((b) * 2 + (h)) * HTB)
#define PG8_SB(b, h) ((4 + (b) * 2 + (h)) * HTB)
#define PG8_STAGE(bufoff, gbase, voff) do { _Pragma("unroll") for (int _i = 0; _i < 2; ++_i) \
        __builtin_amdgcn_global_load_lds((const unsigned*)((const char*)(gbase) + (voff)[_i]), (PG8_LAS unsigned*)(lds + (bufoff) + ldsw + _i * 8192), 16, 0, 0); } while (0)
#define PG8_LDA(dst, b, h) do { _Pragma("unroll") for (int m = 0; m < 4; ++m) _Pragma("unroll") for (int k = 0; k < 2; ++k) dst[m][k] = *(const PG8_LAS bf16x8*)(lds + PG8_SA(b, h) + aoff + m * 2048 + k * 1024); } while (0)
#define PG8_LDB(dst, b, h) do { _Pragma("unroll") for (int n = 0; n < 2; ++n) _Pragma("unroll") for (int k = 0; k < 2; ++k) dst[n][k] = *(const PG8_LAS bf16x8*)(lds + PG8_SB(b, h) + boff + n * 2048 + k * 1024); } while (0)
#define PG8_MMA(ai, bj, At, Bt) do { __builtin_amdgcn_s_setprio(1); _Pragma("unroll") for (int m = 0; m < 4; ++m) _Pragma("unroll") for (int n = 0; n < 2; ++n) _Pragma("unroll") for (int k = 0; k < 2; ++k) \
        acc[ai][bj][m][n] = __builtin_amdgcn_mfma_f32_16x16x32_bf16(Bt[n][k], At[m][k], acc[ai][bj][m][n], 0, 0, 0); __builtin_amdgcn_s_setprio(0); } while (0)
#define PG8_WAIT_V(n) asm volatile("s_waitcnt vmcnt(" #n ")" ::: "memory")
#define PG8_WAIT_L(n) asm volatile("s_waitcnt lgkmcnt(" #n ")" ::: "memory")
#define PG8_BAR __builtin_amdgcn_s_barrier()
#define PG8_SCHED __builtin_amdgcn_sched_barrier(0)
    Unit cur, nxt; int ui = 0;
    if (!S.next(0, cur)) return;
    f32x4 acc[2][2][4][2];
#pragma unroll
    for (int a = 0; a < 2; ++a)
#pragma unroll
        for (int b = 0; b < 2; ++b)
#pragma unroll
            for (int m = 0; m < 4; ++m)
#pragma unroll
                for (int n = 0; n < 2; ++n) acc[a][b][m][n] = (f32x4){0.f, 0.f, 0.f, 0.f};
    bf16x8 At[4][2], B0[2][2], B1[2][2];
    const char* cA = (const char*)g.A + (size_t)cur.pm * tstep; const char* cB = (const char*)g.Bt + (size_t)cur.pn * tstep;
    S.a_ready(cur);
    if constexpr (SP2) {
        PG8_STAGE(PG8_SB(0, 0), cB, voffB); PG8_STAGE(PG8_SB(0, 1), cB + hstep, voffB); PG8_STAGE(PG8_SA(0, 0), cA, voffA); PG8_STAGE(PG8_SA(0, 1), cA + hstep, voffA);
        if (wr == 1) PG8_BAR;
        PG8_WAIT_V(2); PG8_BAR;
        PG8_STAGE(PG8_SB(1, 0), cB + kstep, voffB); PG8_STAGE(PG8_SA(1, 0), cA + kstep, voffA); PG8_STAGE(PG8_SB(1, 1), cB + hstep + kstep, voffB);
        PG8_WAIT_V(6); PG8_BAR;
    } else {
        PG8_STAGE(PG8_SB(0, 0), cB, voffB); PG8_STAGE(PG8_SA(0, 0), cA, voffA); PG8_STAGE(PG8_SB(0, 1), cB + hstep, voffB); PG8_STAGE(PG8_SA(0, 1), cA + hstep, voffA);
        if (wr == 1) PG8_BAR;
        PG8_WAIT_V(4); PG8_BAR;
        PG8_STAGE(PG8_SB(1, 0), cB + kstep, voffB); PG8_STAGE(PG8_SA(1, 0), cA + kstep, voffA); PG8_STAGE(PG8_SB(1, 1), cB + hstep + kstep, voffB);
        PG8_WAIT_V(6); PG8_BAR;
    }
    for (;;) {
        const bool has_next = S.next(ui + 1, nxt);
        const char* nA = has_next ? (const char*)g.A + (size_t)nxt.pm * tstep : cA; const char* nB = has_next ? (const char*)g.Bt + (size_t)nxt.pn * tstep : cB;
        for (int t = 0; t < nt; t += 2) {
            const bool last = (t == nt - 2);
            const char* a1 = cA + (size_t)(t + 1) * kstep;
            const char* a2 = last ? nA : cA + (size_t)(t + 2) * kstep; const char* b2 = last ? nB : cB + (size_t)(t + 2) * kstep;
            const char* a3 = a2 + kstep; const char* b3 = b2 + kstep;
            if (last && has_next) S.a_ready(nxt);
            if constexpr (SP2) {
            PG8_LDB(B0, 0, 0); PG8_LDB(B1, 0, 1); PG8_SCHED; PG8_LDA(At, 0, 0); PG8_STAGE(PG8_SA(1, 1), a1 + hstep, voffA);
            PG8_WAIT_V(8); PG8_WAIT_L(0); PG8_BAR; PG8_MMA(0, 0, At, B0); PG8_MMA(0, 1, At, B1); PG8_BAR; PG8_SCHED;
            PG8_LDA(At, 0, 1); PG8_STAGE(PG8_SB(0, 0), b2, voffB); PG8_STAGE(PG8_SB(0, 1), b2 + hstep, voffB); PG8_STAGE(PG8_SA(0, 0), a2, voffA);
            PG8_WAIT_V(8); PG8_WAIT_L(0); PG8_BAR; PG8_MMA(1, 0, At, B0); PG8_MMA(1, 1, At, B1); PG8_BAR; PG8_SCHED;
            PG8_LDB(B0, 1, 0); PG8_LDB(B1, 1, 1); PG8_SCHED; PG8_LDA(At, 1, 0); PG8_STAGE(PG8_SA(0, 1), a2 + hstep, voffA);
            PG8_WAIT_V(8); PG8_WAIT_L(0); PG8_BAR; PG8_MMA(0, 0, At, B0); PG8_MMA(0, 1, At, B1); PG8_BAR; PG8_SCHED;
            PG8_LDA(At, 1, 1); PG8_STAGE(PG8_SB(1, 0), b3, voffB); PG8_STAGE(PG8_SB(1, 1), b3 + hstep, voffB); PG8_STAGE(PG8_SA(1, 0), a3, voffA);
            PG8_WAIT_V(8); PG8_WAIT_L(0); PG8_BAR; PG8_MMA(1, 0, At, B0); PG8_MMA(1, 1, At, B1); PG8_BAR; PG8_SCHED;
            } else {
            PG8_LDB(B0, 0, 0); PG8_SCHED; PG8_LDA(At, 0, 0); PG8_STAGE(PG8_SA(1, 1), a1 + hstep, voffA);
            PG8_WAIT_L(8); PG8_BAR; PG8_WAIT_L(0); PG8_MMA(0, 0, At, B0); PG8_BAR; PG8_SCHED;
            PG8_LDB(B1, 0, 1); PG8_STAGE(PG8_SB(0, 0), b2, voffB);
            PG8_BAR; PG8_WAIT_L(0); PG8_MMA(0, 1, At, B1); PG8_BAR;
            PG8_LDA(At, 0, 1); PG8_STAGE(PG8_SA(0, 0), a2, voffA);
            PG8_BAR; PG8_WAIT_L(0); PG8_MMA(1, 0, At, B0); PG8_BAR; PG8_SCHED;
            PG8_STAGE(PG8_SB(0, 1), b2 + hstep, voffB);
            PG8_WAIT_V(6); PG8_BAR; PG8_MMA(1, 1, At, B1); PG8_BAR;
            PG8_LDB(B0, 1, 0); PG8_SCHED; PG8_LDA(At, 1, 0); PG8_STAGE(PG8_SA(0, 1), a2 + hstep, voffA);
            PG8_WAIT_L(8); PG8_BAR; PG8_WAIT_L(0); PG8_MMA(0, 0, At, B0); PG8_BAR; PG8_SCHED;
            PG8_LDB(B1, 1, 1); PG8_STAGE(PG8_SB(1, 0), b3, voffB);
            PG8_BAR; PG8_WAIT_L(0); PG8_MMA(0, 1, At, B1); PG8_BAR;
            PG8_LDA(At, 1, 1); PG8_STAGE(PG8_SA(1, 0), a3, voffA);
            PG8_BAR; PG8_WAIT_L(0); PG8_MMA(1, 0, At, B0); PG8_BAR; PG8_SCHED;
            PG8_STAGE(PG8_SB(1, 1), b3 + hstep, voffB);
            PG8_WAIT_V(6); PG8_BAR; PG8_MMA(1, 1, At, B1); PG8_BAR;
            }
        }
        if constexpr (ALIGN_EPI) { if (wr == 0) PG8_BAR; }
        if constexpr (!Epi::AFTER_DRAIN) { E(acc, cur, wr, wc, fr, fq); S.done(cur); }
        if (!has_next) break;
#pragma unroll
        for (int a = 0; a < 2; ++a)
#pragma unroll
            for (int b = 0; b < 2; ++b)
#pragma unroll
                for (int m = 0; m < 4; ++m)
#pragma unroll
                    for (int n = 0; n < 2; ++n) acc[a][b][m][n] = (f32x4){0.f, 0.f, 0.f, 0.f};
        cur = nxt; cA = nA; cB = nB; ++ui;
        if constexpr (ALIGN_EPI) { if (wr == 1) PG8_BAR; }
    }
    PG8_WAIT_V(0);
    if constexpr (!ALIGN_EPI) { if (wr == 0) PG8_BAR; }
    PG8_BAR;
    if constexpr (Epi::AFTER_DRAIN) { E.fused(acc, cur, wr, wc, fr, fq, lds, wid, lane); S.done(cur); }
#undef PG8_SA
#undef PG8_SB
#undef PG8_STAGE
#undef PG8_LDA
#undef PG8_LDB
#undef PG8_MMA
#undef PG8_WAIT_V
#undef PG8_WAIT_L
#undef PG8_BAR
#undef PG8_SCHED
}
}
#define GAS __attribute__((address_space(1)))
#define LAS __attribute__((address_space(3)))
typedef unsigned short bf16;
typedef unsigned v4u __attribute__((ext_vector_type(4)));
typedef float f32x4 __attribute__((ext_vector_type(4)));
typedef short bf16x8 __attribute__((ext_vector_type(8)));
typedef GAS unsigned gu32;
typedef GAS unsigned long long gu64;
#define RLX_AGENT __ATOMIC_RELAXED, __HIP_MEMORY_SCOPE_AGENT
#define LDS_WAIT() asm volatile("s_waitcnt lgkmcnt(0)" ::: "memory")
#define VM_WAIT() asm volatile("s_waitcnt vmcnt(0)" ::: "memory")
__device__ __forceinline__ unsigned long long rt() { return __builtin_amdgcn_s_memrealtime(); }
__device__ __forceinline__ unsigned f2bf(float f) { unsigned u = __builtin_bit_cast(unsigned, f); return (u + 0x7fffu + ((u >> 16) & 1u)) >> 16; }
__device__ __forceinline__ unsigned pk2(float lo, float hi) { return f2bf(lo) | (f2bf(hi) << 16); }

#define XB_TMO      128
#define XB_XCNT(j)  (256  + 64 * (j))
#define XB_XSUB(j)  (1280 + 64 * (j))
#define XB_XGEN(j)  (2304 + 64 * (j))
#define XB_TOP      3328
#define XB_TOPGEN   3392
#define XCD_BAR_WORDS 3456
#define XB_SPIN_CAP (1u << 22)

__device__ __forceinline__ unsigned xb_ld(unsigned* p)              { return __hip_atomic_load(p, __ATOMIC_RELAXED, __HIP_MEMORY_SCOPE_AGENT); }
__device__ __forceinline__ unsigned xb_add(unsigned* p, unsigned v) { return __hip_atomic_fetch_add(p, v, __ATOMIC_RELAXED, __HIP_MEMORY_SCOPE_AGENT); }
__device__ __forceinline__ unsigned xb_xcc_id() { return (unsigned)__builtin_amdgcn_s_getreg((3 << 11) | 20) & 0xFu; }
#define XB_SPIN(cond, bar) do { unsigned _sp = 0; while (cond) { __builtin_amdgcn_s_sleep(1); \
    if ((++_sp & 255u) == 0u) { if (xb_ld(&(bar)[XB_TMO])) break; if (_sp > XB_SPIN_CAP) { atomicAdd(&(bar)[XB_TMO], 1u); break; } } } } while (0)

struct XcdBarrier {
    unsigned* bar; unsigned x;
    volatile LAS unsigned* st;
};

__device__ __forceinline__ XcdBarrier xcd_barrier_post(unsigned* bar, volatile LAS unsigned* st) {
    XcdBarrier b; b.bar = bar; b.x = xb_xcc_id(); b.st = st;
    if (threadIdx.x == 0) (void)xb_add(&bar[XB_XCNT(b.x)], 1u);
    return b;
}
__device__ __forceinline__ void xcd_barrier_complete(unsigned* bar, unsigned x, unsigned& nloc, unsigned& nx) {
    const unsigned G = gridDim.x * gridDim.y * gridDim.z;
    unsigned sum, cnt, mine, sp = 0u;
    for (;;) {
        sum = 0u; cnt = 0u; mine = 0u;
#pragma unroll
        for (unsigned j = 0; j < 16; ++j) { const unsigned c = xb_ld(&bar[XB_XCNT(j)]); sum += c; cnt += (c > 0u) ? 1u : 0u; mine = (j == x) ? c : mine; }
        if (sum == G) break;
        __builtin_amdgcn_s_sleep(1);
        if ((++sp & 255u) == 0u) { if (xb_ld(&bar[XB_TMO])) break; if (sp > XB_SPIN_CAP) { atomicAdd(&bar[XB_TMO], 1u); break; } }
    }
    nloc = mine > 0u ? mine : 1u; nx = cnt > 0u ? cnt : 1u;
}

__device__ __forceinline__ void xcd_barrier(const XcdBarrier& b) {
    asm volatile("s_waitcnt vmcnt(0)" ::: "memory");
    __syncthreads();
    if (threadIdx.x == 0) {
        unsigned* bar = b.bar;
        __builtin_amdgcn_s_waitcnt(0);
        unsigned nloc = b.st[0], nx = b.st[1];
        if (nloc == 0u) { xcd_barrier_complete(bar, b.x, nloc, nx); b.st[0] = nloc; b.st[1] = nx; }
        const unsigned old = xb_add(&bar[XB_XSUB(b.x)], 1u);
        const unsigned gen = old / nloc;
        if (old + 1u == (gen + 1u) * nloc) {
            __builtin_amdgcn_fence(__ATOMIC_RELEASE, "agent");
            asm volatile("s_waitcnt vmcnt(0)" ::: "memory");
            const unsigned og = xb_add(&bar[XB_TOP], 1u);
            const unsigned tg = og / nx;
            if (og + 1u == (tg + 1u) * nx) xb_add(&bar[XB_TOPGEN], 1u);
            else XB_SPIN(xb_ld(&bar[XB_TOPGEN]) == tg, bar);
            __builtin_amdgcn_fence(__ATOMIC_ACQUIRE, "agent");
            xb_add(&bar[XB_XGEN(b.x)], 1u);
            asm volatile("s_waitcnt vmcnt(0)" ::: "memory");
        } else {
            XB_SPIN(xb_ld(&bar[XB_XGEN(b.x)]) == gen, bar);
            __builtin_amdgcn_fence(__ATOMIC_ACQUIRE, "agent");
            asm volatile("s_waitcnt vmcnt(0)" ::: "memory");
        }
    }
    __syncthreads();
}

typedef unsigned u32x4 __attribute__((ext_vector_type(4)));
typedef unsigned u32x2 __attribute__((ext_vector_type(2)));
typedef short s16x4 __attribute__((ext_vector_type(4)));
typedef float f32x2t __attribute__((ext_vector_type(2)));
typedef __bf16 bf16x2t __attribute__((ext_vector_type(2)));
#define DI __device__ __forceinline__
DI unsigned cvtpk(float lo, float hi) { f32x2t v = {lo, hi}; bf16x2t b = __builtin_convertvector(v, bf16x2t); return __builtin_bit_cast(unsigned, b); }
DI float bflo(unsigned w) { return __uint_as_float(w << 16); }
DI float bfhi(unsigned w) { return __uint_as_float(w & 0xffff0000u); }
DI s16x4 tr_read(LAS unsigned char* p) { return __builtin_bit_cast(s16x4, __builtin_amdgcn_ds_read_tr16_b64_v4i16((LAS s16x4*)p)); }
DI bf16x8 cat8(s16x4 lo, s16x4 hi) { return (bf16x8){lo[0], lo[1], lo[2], lo[3], hi[0], hi[1], hi[2], hi[3]}; }
DI int fresh_tid() { int t = threadIdx.x; asm volatile("" : "+v"(t)); return t; }
#define MFMA16(a, b, c) __builtin_amdgcn_mfma_f32_16x16x32_bf16((a), (b), (c), 0, 0, 0)
DI float wave_sum(float v) {
#pragma unroll
    for (int o = 1; o < 64; o <<= 1) v += __shfl_xor(v, o);
    return v;
}

struct Frame {
    LAS unsigned char* lds;
    volatile LAS unsigned* MISC;
    gu32* ctl;
    int G;
    unsigned char* ws;
    const float* const* in;
};

DI int perm_pairs(int p, int half) {
    const int g = p >> 3, r = p & 7; return (r < 4) ? 4 * g + r : half + 4 * g + (r - 4);
}
DI int inmap(int np) {
    if (np < 1024) { const int head = np >> 7, p = np & 127; return head * 128 + (p < 32 ? perm_pairs(p, 16) : p); }
    if (np < 1280) { const int c = np - 1024; if (c < 128) return 1024 + (c < 32 ? perm_pairs(c, 16) : c); return 1152 + (c - 128); }
    if (np < 2304) { const int q = np - 1280, head = q >> 6, p = q & 63; return 1280 + head * 64 + (p < 16 ? perm_pairs(p, 8) : p); }
    if (np < 2560) { const int c = np - 2304; if (c < 64) return 2304 + (c < 16 ? perm_pairs(c, 8) : c); if (c < 80) return 2368 + (c - 64); return -1; }
    if (np < 3584) { const int q = np - 2560, which = q >> 9, qq = q & 511, head = qq >> 6, p = qq & 63; return (which ? 2896 : 2384) + head * 64 + perm_pairs(p, 32); }
    if (np < 4608) return 3408 + (np - 3584);
    return 4432 + (np - 4608);
}
template <bool INMAP>
DI void transpose_item(const float* W, int K, int N, int NP, bf16* WT, const float* gain, LAS float* scr, int item, int lane) {
    const int nblk = NP / 32, kb = item / nblk, nb = item % nblk, k0 = 64 * kb, n0 = 32 * nb;
    const int np = n0 + (lane & 31); const int L = INMAP ? inmap(np) : np;
#pragma unroll 8
    for (int i = 0; i < 32; ++i) { const int kk = 2 * i + (lane >> 5); float v = 0.f; if (L >= 0) { v = W[(size_t)(k0 + kk) * N + L]; if (gain) v *= gain[k0 + kk]; } scr[kk * 33 + (lane & 31)] = v; }
    LDS_WAIT(); asm volatile("" ::: "memory");
    const int c = lane & 7;
#pragma unroll
    for (int j = 0; j < 4; ++j) { const int n = (lane >> 3) + 8 * j; const LAS float* s = scr + (8 * c) * 33 + n;
        v4u o; o.x = pk2(s[0 * 33], s[1 * 33]); o.y = pk2(s[2 * 33], s[3 * 33]); o.z = pk2(s[4 * 33], s[5 * 33]); o.w = pk2(s[6 * 33], s[7 * 33]);
        *(GAS v4u*)(WT + (size_t)(n0 + n) * K + k0 + 8 * c) = o; }
    LDS_WAIT(); asm volatile("" ::: "memory");
}
DI void sincos_rr(float x, float& s, float& c) {
    const float k = rintf(x * 0.15915494309189535f);
    float r = fmaf(-k, 6.28318548202514648f, x); r = fmaf(-k, -1.74845553e-7f, r);
    const float f = r * 0.15915494309189535f;
    s = __builtin_amdgcn_sinf(f); c = __builtin_amdgcn_cosf(f);
}

DI void p0_prologue(Frame& F, const float* x, const int* positions, const float* w_in, const float* w_out, const float* w_ff1, const float* w_ff2, const float* w_ple, const float* w_gate,
                    const float* pre_mix, const float* pre_ff) {
    const int tid = fresh_tid(), lane = tid & 63, wave = __builtin_amdgcn_readfirstlane(tid >> 6);
    LAS float* scr = (LAS float*)(F.lds + RING_OFF + wave * 16384);
    const int gw = blockIdx.x * NWAVES + wave, NGW = F.G * NWAVES;
    constexpr int I_IN = (DM / 64) * (NINP / 32), I_OUT = (DM / 64) * (DM / 32), I_FF1 = (DM / 64) * (DFF / 32), I_FF2 = (DFF / 64) * (DM / 32), I_PLE = (PLE / 64) * (DM / 32), I_GATE = I_OUT;
    constexpr int PER_LAYER = I_IN + I_OUT + I_FF1 + I_FF2 + I_PLE + I_GATE;
    for (int it = gw; it < DEPTH * PER_LAYER; it += NGW) {
        const int l = it / PER_LAYER; int r = it % PER_LAYER;
        unsigned char* wl = F.ws + WS_W + (size_t)l * W_LAYER;
        if (r < I_IN)  { transpose_item<true >(w_in  + (size_t)l * DM * NINL, DM, NINL, NINP, (bf16*)(wl + WO_IN),  pre_mix + l * DM, scr, r, lane); continue; } r -= I_IN;
        if (r < I_OUT) { transpose_item<false>(w_out + (size_t)l * DM * DM,   DM, DM,  DM,    (bf16*)(wl + WO_OUT), nullptr,          scr, r, lane); continue; } r -= I_OUT;
        if (r < I_FF1) { transpose_item<false>(w_ff1 + (size_t)l * DM * DFF,  DM, DFF, DFF,   (bf16*)(wl + WO_FF1), pre_ff + l * DM,  scr, r, lane); continue; } r -= I_FF1;
        if (r < I_FF2) { transpose_item<false>(w_ff2 + (size_t)l * DFF * DM,  DFF, DM, DM,    (bf16*)(wl + WO_FF2), nullptr,          scr, r, lane); continue; } r -= I_FF2;
        if (r < I_PLE) { transpose_item<false>(w_ple + (size_t)l * PLE * DM,  PLE, DM, DM,    (bf16*)(wl + WO_PLE), nullptr,          scr, r, lane); continue; } r -= I_PLE;
        transpose_item<false>(w_gate + (size_t)l * DM * DM, DM, DM, DM, (bf16*)(wl + WO_GATE), nullptr, scr, r, lane);
    }
    float* rope = (float*)(F.ws + WS_ROPE);
    for (int e = blockIdx.x * (NWAVES * 64) + tid; e < M * 56; e += F.G * NWAVES * 64) {
        const int m = e / 56, i = e % 56; const float pos = (float)positions[m];
        float inv; int co, so;
        if (i < 16)      { inv = __builtin_amdgcn_exp2f(-(float)i * (1.0f / 16.0f) * LOG2_THETA_A);        co = i;             so = 16 + i; }
        else if (i < 24) { inv = __builtin_amdgcn_exp2f(-(float)(i - 16) * (1.0f / 8.0f) * LOG2_THETA_A);  co = 32 + (i - 16); so = 40 + (i - 16); }
        else             { inv = __builtin_amdgcn_exp2f(-(float)(i - 24) * (1.0f / 32.0f) * LOG2_THETA_R); co = 48 + (i - 24); so = 80 + (i - 24); }
        float s, c; sincos_rr(pos * inv, s, c);
        rope[(size_t)m * ROPE_W + co] = c; rope[(size_t)m * ROPE_W + so] = s;
    }
    bf16* HB = (bf16*)(F.ws + WS_HB); float* RS = (float*)(F.ws + WS_RS);
    for (int row = gw; row < M; row += NGW) {
        const GAS f32x4* xr = (const GAS f32x4*)(x + (size_t)row * DM) + lane; GAS u32x2* hb = (GAS u32x2*)(HB + (size_t)row * DM) + lane; float ss = 0.f;
#pragma unroll
        for (int j = 0; j < 8; ++j) { const f32x4 v = xr[64 * j]; ss += (v.x * v.x + v.y * v.y) + (v.z * v.z + v.w * v.w); u32x2 o; o.x = cvtpk(v.x, v.y); o.y = cvtpk(v.z, v.w); hb[64 * j] = o; }
        ss = wave_sum(ss);
        if (lane == 0) RS[row] = 1.0f / sqrtf(ss * (1.0f / DM) + RMS_EPS);
    }
}

DI void thin_phase(Frame& F, float* fout, const float* wpost, const float* pconv) {
    const int tid = fresh_tid(), lane = tid & 63, wave = __builtin_amdgcn_readfirstlane(tid >> 6);
    const int gw = blockIdx.x * NWAVES + wave, NGW = F.G * NWAVES;
    const bf16* Y = (const bf16*)(F.ws + WS_Y); const float* SS = (const float*)(F.ws + WS_SS); bf16* HB = (bf16*)(F.ws + WS_HB); float* RS = (float*)(F.ws + WS_RS);
    bf16* PB = (bf16*)(F.ws + WS_BIG + BO_PB);
    f32x4 w[8];
#pragma unroll
    for (int j = 0; j < 8; ++j) w[j] = *((const GAS f32x4*)wpost + lane + 64 * j);
    for (int row = gw; row < M; row += NGW) {
        float q = (lane < 32) ? SS[(size_t)row * 32 + lane] : 0.f; q = wave_sum(q);
        const float rstd = 1.0f / sqrtf(q * (1.0f / DM) + RMS_EPS);
        const GAS u32x2* yr = (const GAS u32x2*)(Y + (size_t)row * DM) + lane; GAS u32x2* hb = (GAS u32x2*)(HB + (size_t)row * DM) + lane; float ss = 0.f;
        u32x2 hv[8], yv[8];
#pragma unroll
        for (int j = 0; j < 8; ++j) { hv[j] = hb[64 * j]; yv[j] = yr[64 * j]; }
#pragma unroll
        for (int j = 0; j < 8; ++j) { f32x4 h;
            h.x = bflo(hv[j].x) + bflo(yv[j].x) * rstd * w[j].x; h.y = bfhi(hv[j].x) + bfhi(yv[j].x) * rstd * w[j].y; h.z = bflo(hv[j].y) + bflo(yv[j].y) * rstd * w[j].z; h.w = bfhi(hv[j].y) + bfhi(yv[j].y) * rstd * w[j].w;
            if (fout) { *((GAS f32x4*)(fout + (size_t)row * DM) + lane + 64 * j) = h; }
            else { u32x2 o; o.x = cvtpk(h.x, h.y); o.y = cvtpk(h.z, h.w); hb[64 * j] = o;
                   const float rx = bflo(o.x), ry = bfhi(o.x), rz = bflo(o.y), rw = bfhi(o.y); ss += (rx * rx + ry * ry) + (rz * rz + rw * rw); } }
        if (!fout) { ss = wave_sum(ss); if (lane == 0) RS[row] = 1.0f / sqrtf(ss * (1.0f / DM) + RMS_EPS); }
        if (pconv) { const f32x4 pv = *((const GAS f32x4*)(pconv + (size_t)row * PLE) + lane); u32x2 o; o.x = cvtpk(pv.x, pv.y); o.y = cvtpk(pv.z, pv.w); *((GAS u32x2*)(PB + (size_t)row * PLE) + lane) = o; }
    }
}

constexpr int ATT_WL = 16384 + 512;
constexpr int RET_KST = 144, RET_VST = 288, RET_K = 0, RET_V = 128 * RET_KST, RET_R = RET_V + 128 * RET_VST, RET_BYTES = RET_R + 128 * RET_KST;
static_assert(NWAVES * ATT_WL <= RING_BYTES && RET_BYTES <= RING_BYTES, "mixer LDS");
constexpr int N_RET_ITEMS = BATCH * 8, N_ATT_ITEMS = BATCH * (SEQ / NWAVES), N_MIX_ITEMS = N_RET_ITEMS + N_ATT_ITEMS;

DI void dma16(const void* g, LAS unsigned char* l) { __builtin_amdgcn_global_load_lds((const unsigned*)g, (LAS unsigned*)l, 16, 0, 0); }
#define VMW(n) asm volatile("s_waitcnt vmcnt(" #n ")" ::: "memory")
#ifndef PROF_SEC
#define PROF_SEC 0
#endif
#define PROF_T() ((unsigned)__builtin_amdgcn_s_memrealtime())
#define PROF_BEGIN(k) unsigned pt_##k = 0; if (PROF_SEC == (k)) pt_##k = PROF_T();
#define PROF_END(k) if (PROF_SEC == (k)) pacc += PROF_T() - pt_##k;
DI void attn_item(LAS unsigned char* ring, unsigned char* ws, int b, int t0, int lane, int wave, unsigned& pacc) {
    const int g = lane >> 4, c = lane & 15;
    const int t = t0 + wave;
    LAS unsigned char* wl = ring + wave * 16384;
    const bf16* AQ = (const bf16*)(ws + WS_BIG + BO_AQ); const bf16* AKV = (const bf16*)(ws + WS_BIG + BO_AKV); const bf16* IQ = (const bf16*)(ws + WS_BIG + BO_IQ);
    const bf16* IK = (const bf16*)(ws + WS_BIG + BO_IK); const float* IW = (const float*)(ws + WS_BIG + BO_IW); bf16* MIX = (bf16*)(ws + WS_BIG + BO_MIX);
    const size_t m = (size_t)b * SEQ + t; const size_t brow = (size_t)b * SEQ;
    LAS unsigned short* idx = (LAS unsigned short*)(ring + 131072 + 512 * wave);
    const int nk = t + 1; int nsel;
    if (t0 >= 256) {
        PROF_BEGIN(1)
        const bf16* iqp = IQ + m * 1024 + c * 64 + 8 * g;
        const bf16x8 a0 = *(const bf16x8*)iqp, a1 = *(const bf16x8*)(iqp + 32);
        const f32x4 w4 = *(const f32x4*)(IW + m * 16 + 4 * g);
        u32x4 wfu; wfu.x = cvtpk(w4.x, w4.y); wfu.y = cvtpk(w4.z, w4.w); wfu.z = 0u; wfu.w = 0u;
        const bf16x8 wfrag = __builtin_bit_cast(bf16x8, wfu); const bf16x8 zfrag = (bf16x8){0, 0, 0, 0, 0, 0, 0, 0};
        asm volatile("s_waitcnt vmcnt(0)" :: "v"(a0), "v"(a1), "v"(wfrag) : "memory");
        const int nchunk = (t0 + 8 + 255) >> 8;
        const int r8 = lane >> 3, s8 = lane & 7;
#define ISSUE_IK(k) do { _Pragma("unroll") for (int i_ = 0; i_ < 4; ++i_) { const int row_ = 32 * wave + 8 * i_; \
            dma16(IK + (brow + 256 * (k) + row_ + r8) * 64 + 8 * (s8 ^ (((row_ + r8) >> 1) & 7)), ring + ((k) & 3) * 32768 + 128 * row_); } } while (0)
#pragma unroll
        for (int k = 0; k < 3; ++k) if (k < nchunk) ISSUE_IK(k);
        unsigned u[32];
#pragma unroll
        for (int k = 0; k < 8; ++k) {
            f32x4 d2 = {0.f, 0.f, 0.f, 0.f};
            if (k < nchunk) {
                const int ahead = nchunk - 1 - k;
                if (ahead >= 2) VMW(8); else if (ahead == 1) VMW(4); else VMW(0);
                __builtin_amdgcn_s_barrier();
                asm volatile("" ::: "memory");
                if (k + 3 < nchunk) ISSUE_IK(k + 3);
                int cc = c; asm volatile("" : "+v"(cc));
                const LAS unsigned char* kbase = ring + (k & 3) * 32768 + 128 * cc;
#pragma unroll
                for (int j = 0; j < 16; ++j) {
                    if (256 * k + 16 * j <= t0 + 7) {
                        const LAS unsigned char* kp = kbase + 2048 * j;
                        const int sw = ((16 * j + cc) >> 1) & 7;
                        const bf16x8 kb0 = *(const LAS bf16x8*)(kp + 16 * (g ^ sw)), kb1 = *(const LAS bf16x8*)(kp + 16 * ((4 + g) ^ sw));
                        f32x4 d = {0.f, 0.f, 0.f, 0.f};
                        d = MFMA16(a0, kb0, d); d = MFMA16(a1, kb1, d);
                        u32x4 ru; ru.x = cvtpk(fmaxf(d.x, 0.f), fmaxf(d.y, 0.f)); ru.y = cvtpk(fmaxf(d.z, 0.f), fmaxf(d.w, 0.f)); ru.z = 0u; ru.w = 0u;
                        d2 = MFMA16((cc == j) ? wfrag : zfrag, __builtin_bit_cast(bf16x8, ru), d2);
                    }
                }
            }
#pragma unroll
            for (int r = 0; r < 4; ++r) { const int key = 256 * k + 16 * (4 * g + r) + c; const unsigned bb = __float_as_uint(d2[r]); const unsigned ok = (bb & 0x80000000u) ? ~bb : (bb | 0x80000000u); u[4 * k + r] = (key < nk) ? ok : 0u; }
        }
        asm volatile("s_waitcnt lgkmcnt(0)" ::: "memory");
        __builtin_amdgcn_s_barrier();
        asm volatile("" ::: "memory");
#undef ISSUE_IK
        PROF_END(1)
        PROF_BEGIN(2)
        unsigned T = 0u;
        for (int bit = 31; bit >= 0; --bit) {
            const unsigned cand = T | (1u << bit); int cnt = 0;
#pragma unroll
            for (int i = 0; i < 32; ++i) cnt += __popcll(__ballot(u[i] >= cand));
            if (cnt >= 256) T = cand;
            if (cnt == 256) break;
        }
        int cgt = 0;
#pragma unroll
        for (int i = 0; i < 32; ++i) cgt += __popcll(__ballot(u[i] > T));
        const int quota = 256 - cgt;
        const unsigned long long lt = (1ull << lane) - 1ull;
        int base = 0, eqrun = 0;
#pragma unroll
        for (int i = 0; i < 32; ++i) {
            const bool gt = u[i] > T, eq = u[i] == T;
            const unsigned long long meq = __ballot(eq);
            const int eqrank = eqrun + __popcll(meq & lt);
            const bool sel = gt || (eq && eqrank < quota);
            const unsigned long long ms = __ballot(sel);
            if (sel) idx[base + __popcll(ms & lt)] = (unsigned short)(256 * (i >> 2) + 16 * (4 * g + (i & 3)) + c);
            base += __popcll(ms); eqrun += __popcll(meq);
        }
        PROF_END(2)
        nsel = 256;
    } else {
#pragma unroll
        for (int r = 0; r < 4; ++r) { const int j = lane + 64 * r; idx[j] = (unsigned short)(j < nk ? j : 0); }
        nsel = nk;
    }
    LDS_WAIT(); __builtin_amdgcn_wave_barrier();
    PROF_BEGIN(3)
    int lane3 = lane; asm volatile("" : "+v"(lane3));
    const int G3 = lane3 >> 4, C3 = lane3 & 15;
    bf16x8 qf[4];
#pragma unroll
    for (int ks = 0; ks < 4; ++ks) { qf[ks] = (bf16x8){0, 0, 0, 0, 0, 0, 0, 0}; if (C3 < 8) qf[ks] = *(const bf16x8*)(AQ + m * 1024 + C3 * 128 + 32 * ks + 8 * G3); }
    asm volatile("s_waitcnt vmcnt(0)" :: "v"(qf[0]), "v"(qf[1]), "v"(qf[2]), "v"(qf[3]) : "memory");
    const int ntile = (nsel + 15) >> 4;
#define ISSUE_K(kt) do { const u32x2 iw_ = *(const LAS u32x2*)(idx + 16 * (kt) + 4 * G3); \
        _Pragma("unroll") for (int i_ = 0; i_ < 4; ++i_) { const int r_ = 4 * i_ + G3; const int key_ = (int)(((i_ & 2) ? iw_.y : iw_.x) >> (16 * (i_ & 1))) & 0xffff; \
        dma16(AKV + (brow + key_) * 256 + 8 * (C3 ^ r_), wl + ((kt) & 3) * 4096 + 1024 * i_); } } while (0)
#pragma unroll
    for (int kt = 0; kt < 4; ++kt) if (kt < ntile) ISSUE_K(kt);
    f32x4 s[16];
#pragma unroll
    for (int kt = 0; kt < 16; ++kt) {
        s[kt] = (f32x4){-INFINITY, -INFINITY, -INFINITY, -INFINITY};
        if (kt < ntile) {
            const int ahead = ntile - 1 - kt;
            if (ahead >= 3) VMW(12); else if (ahead == 2) VMW(8); else if (ahead == 1) VMW(4); else VMW(0);
            const LAS unsigned char* kp = wl + (kt & 3) * 4096 + 256 * C3;
            bf16x8 ka[4];
#pragma unroll
            for (int ks = 0; ks < 4; ++ks) ka[ks] = *(const LAS bf16x8*)(kp + 16 * ((4 * ks + G3) ^ C3));
            f32x4 d = {0.f, 0.f, 0.f, 0.f};
#pragma unroll
            for (int ks = 0; ks < 4; ++ks) d = MFMA16(ka[ks], qf[ks], d);
#pragma unroll
            for (int r = 0; r < 4; ++r) s[kt][r] = (16 * kt + 4 * r + G3 < nsel) ? d[r] : -INFINITY;
            asm volatile("" :: "v"(d) : "memory");
            if (kt + 4 < ntile) ISSUE_K(kt + 4);
        }
    }
    const int nstep = (nsel + 31) >> 5;
#define ISSUE_V(st) do { const u32x2 ia_ = *(const LAS u32x2*)(idx + 32 * (st) + 4 * G3), ib_ = *(const LAS u32x2*)(idx + 32 * (st) + 16 + 4 * G3); \
        _Pragma("unroll") for (int i_ = 0; i_ < 8; ++i_) { const int r_ = 4 * i_ + G3; const u32x2 iw_ = (i_ & 4) ? ib_ : ia_; const int key_ = (int)(((i_ & 2) ? iw_.y : iw_.x) >> (16 * (i_ & 1))) & 0xffff; \
        dma16(AKV + (brow + key_) * 256 + 128 + 8 * (C3 ^ (2 * (r_ & 7))), wl + ((st) & 1) * 8192 + 1024 * i_); } } while (0)
    ISSUE_V(0);
    if (nstep > 1) ISSUE_V(1);
    float mx = -INFINITY;
#pragma unroll
    for (int kt = 0; kt < 16; ++kt) mx = fmaxf(fmaxf(mx, fmaxf(s[kt][0], s[kt][1])), fmaxf(s[kt][2], s[kt][3]));
    mx = fmaxf(mx, __shfl_xor(mx, 16)); mx = fmaxf(mx, __shfl_xor(mx, 32));
    float l = 0.f;
#pragma unroll
    for (int kt = 0; kt < 16; ++kt)
#pragma unroll
        for (int r = 0; r < 4; ++r) { const float p = __builtin_amdgcn_exp2f(s[kt][r] - mx); s[kt][r] = p; l += p; }
    l += __shfl_xor(l, 16); l += __shfl_xor(l, 32);
    const float inv = 1.0f / l;
    f32x4 o[8];
#pragma unroll
    for (int dt = 0; dt < 8; ++dt) o[dt] = (f32x4){0.f, 0.f, 0.f, 0.f};
    const int q4 = C3 >> 2, p4 = C3 & 3, r0 = 4 * G3 + q4;
#pragma unroll
    for (int st = 0; st < 8; ++st) {
        if (st < nstep) {
            if (st + 1 < nstep) VMW(8); else VMW(0);
            u32x4 pw; pw.x = cvtpk(s[2 * st][0], s[2 * st][1]); pw.y = cvtpk(s[2 * st][2], s[2 * st][3]); pw.z = cvtpk(s[2 * st + 1][0], s[2 * st + 1][1]); pw.w = cvtpk(s[2 * st + 1][2], s[2 * st + 1][3]);
            const bf16x8 pb = __builtin_bit_cast(bf16x8, pw);
            const unsigned vb = (unsigned)(uintptr_t)(wl + (st & 1) * 8192 + 256 * r0 + 8 * (p4 & 1));
            s16x4 lo[8], hi[8];
#pragma unroll
            for (int dt = 0; dt < 8; ++dt) {
                const unsigned pos = vb + 16 * ((2 * dt + (p4 >> 1)) ^ (2 * (r0 & 7)));
                asm volatile("ds_read_b64_tr_b16 %0, %1" : "=&v"(lo[dt]) : "v"(pos) : "memory");
                asm volatile("ds_read_b64_tr_b16 %0, %1 offset:4096" : "=&v"(hi[dt]) : "v"(pos) : "memory");
            }
            asm volatile("s_waitcnt lgkmcnt(0)" : "+v"(lo[0]), "+v"(lo[1]), "+v"(lo[2]), "+v"(lo[3]), "+v"(lo[4]), "+v"(lo[5]), "+v"(lo[6]), "+v"(lo[7]),
                                                  "+v"(hi[0]), "+v"(hi[1]), "+v"(hi[2]), "+v"(hi[3]), "+v"(hi[4]), "+v"(hi[5]), "+v"(hi[6]), "+v"(hi[7]) :: "memory");
#pragma unroll
            for (int dt = 0; dt < 8; ++dt) o[dt] = MFMA16(cat8(lo[dt], hi[dt]), pb, o[dt]);
            asm volatile("" :: "v"(o[7]) : "memory");
            if (st + 2 < nstep) ISSUE_V(st + 2);
        }
    }
    if (C3 < 8) {
        bf16* op = MIX + m * 2048 + C3 * 128 + 4 * G3;
#pragma unroll
        for (int dt = 0; dt < 8; ++dt) { u32x2 w; w.x = cvtpk(o[dt][0] * inv, o[dt][1] * inv); w.y = cvtpk(o[dt][2] * inv, o[dt][3] * inv); *(u32x2*)(op + 16 * dt) = w; }
    }
    PROF_END(3)
#undef ISSUE_K
#undef ISSUE_V
}

DI void ret_chain(Frame& F, int b, int h, const float* gn) {
    LAS unsigned char* lds = F.lds + RING_OFF; unsigned char* ws = F.ws;
    const bf16* RQ = (const bf16*)(ws + WS_BIG + BO_RQ); const bf16* RK = (const bf16*)(ws + WS_BIG + BO_RK); const bf16* RV = (const bf16*)(ws + WS_BIG + BO_RV);
    const bf16* RG = (const bf16*)(ws + WS_BIG + BO_RG); bf16* MIX = (bf16*)(ws + WS_BIG + BO_MIX);
    const int tid = fresh_tid(), lane = tid & 63, w = __builtin_amdgcn_readfirstlane(tid >> 6), g = lane >> 4, c = lane & 15, q4 = c >> 2, p4 = c & 3;
    const float lg = pg8::log2_gamma(h);
    const int i = 16 * w + c;
    const float xi = __builtin_amdgcn_exp2f((float)(i + 1) * lg), fi = __builtin_amdgcn_exp2f((float)(i - 127) * lg), gC = __builtin_amdgcn_exp2f(128.0f * lg);
    f32x4 RT[4];
#pragma unroll
    for (int dt = 0; dt < 4; ++dt) RT[dt] = (f32x4){0.f, 0.f, 0.f, 0.f};
    for (int ch = 0; ch < 16; ++ch) {
        const size_t row0 = (size_t)b * SEQ + 128 * ch;
        __syncthreads();
#pragma unroll
        for (int r = 0; r < 2; ++r) { const int row = (tid >> 3) + 64 * r, ck = tid & 7; *(LAS u32x4*)(lds + RET_K + row * RET_KST + 16 * ck) = *(const u32x4*)(RK + (row0 + row) * 512 + h * 64 + 8 * ck); }
#pragma unroll
        for (int r = 0; r < 4; ++r) { const int row = (tid >> 4) + 32 * r, ck = tid & 15; *(LAS u32x4*)(lds + RET_V + row * RET_VST + 16 * ck) = *(const u32x4*)(RV + (row0 + row) * 1024 + h * 128 + 8 * ck); }
#pragma unroll
        for (int dt = 0; dt < 4; ++dt)
#pragma unroll
            for (int r = 0; r < 4; ++r) *(LAS unsigned short*)(lds + RET_R + (16 * w + 4 * g + r) * RET_KST + 2 * (16 * dt + c)) = (unsigned short)f2bf(RT[dt][r]);
        __syncthreads();
        const bf16* qp = RQ + (row0 + i) * 512 + h * 64 + 8 * g;
        const bf16x8 qb0 = *(const bf16x8*)qp, qb1 = *(const bf16x8*)(qp + 32);
        f32x4 o[8];
#pragma unroll
        for (int vt = 0; vt < 8; ++vt) o[vt] = (f32x4){0.f, 0.f, 0.f, 0.f};
        if (ch > 0) {
#pragma unroll
            for (int vt = 0; vt < 8; ++vt) {
                const LAS unsigned char* rp = lds + RET_R + (16 * vt + c) * RET_KST + 16 * g;
                o[vt] = MFMA16(*(const LAS bf16x8*)rp, qb0, o[vt]); o[vt] = MFMA16(*(const LAS bf16x8*)(rp + 64), qb1, o[vt]);
            }
#pragma unroll
            for (int vt = 0; vt < 8; ++vt) o[vt] = o[vt] * xi;
        }
#pragma unroll
        for (int st = 0; st < 4; ++st) {
            if (2 * st <= w) {
                f32x4 d0 = {0.f, 0.f, 0.f, 0.f}, d1 = {0.f, 0.f, 0.f, 0.f};
                { const LAS unsigned char* kp = lds + RET_K + (32 * st + c) * RET_KST + 16 * g;
                  d0 = MFMA16(*(const LAS bf16x8*)kp, qb0, d0); d0 = MFMA16(*(const LAS bf16x8*)(kp + 64), qb1, d0);
                  d1 = MFMA16(*(const LAS bf16x8*)(kp + 16 * RET_KST), qb0, d1); d1 = MFMA16(*(const LAS bf16x8*)(kp + 16 * RET_KST + 64), qb1, d1); }
#pragma unroll
                for (int r = 0; r < 4; ++r) { const int j0 = 32 * st + 4 * g + r; d0[r] = (j0 <= i) ? d0[r] * fi : 0.f; d1[r] = (j0 + 16 <= i) ? d1[r] * fi : 0.f; }
                u32x4 pw; pw.x = cvtpk(d0[0], d0[1]); pw.y = cvtpk(d0[2], d0[3]); pw.z = cvtpk(d1[0], d1[1]); pw.w = cvtpk(d1[2], d1[3]);
                const bf16x8 pb = __builtin_bit_cast(bf16x8, pw);
                LAS unsigned char* vb = lds + RET_V + (32 * st + 4 * g + q4) * RET_VST + 8 * p4;
#pragma unroll
                for (int vt = 0; vt < 8; ++vt) {
                    const s16x4 lo = tr_read(vb + 32 * vt), hi = tr_read(vb + 16 * RET_VST + 32 * vt);
                    o[vt] = MFMA16(cat8(lo, hi), pb, o[vt]);
                }
            }
        }
        {
            float sm = 0.f;
#pragma unroll
            for (int vt = 0; vt < 8; ++vt) sm += (o[vt][0] + o[vt][1]) + (o[vt][2] + o[vt][3]);
            sm += __shfl_xor(sm, 16); sm += __shfl_xor(sm, 32);
            const float mu = sm * (1.0f / 128.0f); float vq = 0.f;
#pragma unroll
            for (int vt = 0; vt < 8; ++vt) { const f32x4 dd = o[vt] - mu; vq += (dd[0] * dd[0] + dd[1] * dd[1]) + (dd[2] * dd[2] + dd[3] * dd[3]); }
            vq += __shfl_xor(vq, 16); vq += __shfl_xor(vq, 32);
            const float rstd = 1.0f / sqrtf(vq * (1.0f / 128.0f) + GN_EPS);
            const size_t mrow = row0 + i;
#pragma unroll
            for (int vt = 0; vt < 8; ++vt) {
                const int v0 = h * 128 + 16 * vt + 4 * g;
                const f32x4 gw = *(const f32x4*)(gn + v0); const u32x2 gt = *(const u32x2*)(RG + mrow * 1024 + v0);
                const float y0 = (o[vt][0] - mu) * rstd * gw[0] * bflo(gt.x), y1 = (o[vt][1] - mu) * rstd * gw[1] * bfhi(gt.x), y2 = (o[vt][2] - mu) * rstd * gw[2] * bflo(gt.y), y3 = (o[vt][3] - mu) * rstd * gw[3] * bfhi(gt.y);
                u32x2 ow; ow.x = cvtpk(y0, y1); ow.y = cvtpk(y2, y3); *(u32x2*)(MIX + mrow * 2048 + 1024 + v0) = ow;
            }
        }
#pragma unroll
        for (int dt = 0; dt < 4; ++dt) RT[dt] = RT[dt] * gC;
#pragma unroll
        for (int st = 0; st < 4; ++st) {
            LAS unsigned char* vb = lds + RET_V + (32 * st + 8 * g + q4) * RET_VST + 32 * w + 8 * p4;
            const bf16x8 va = cat8(tr_read(vb), tr_read(vb + 4 * RET_VST));
            LAS unsigned char* kp = lds + RET_K + (32 * st + 8 * g + q4) * RET_KST + 8 * p4;
#pragma unroll
            for (int dt = 0; dt < 4; ++dt) { const bf16x8 kbf = cat8(tr_read(kp + 32 * dt), tr_read(kp + 4 * RET_KST + 32 * dt)); RT[dt] = MFMA16(va, kbf, RT[dt]); }
        }
    }
    __syncthreads();
}

constexpr int N_Q_ITEMS = 16 + 2 * (SEQ / NWAVES);
DI void mixer_phase(Frame& F, int lq, const float* gn) {
    const int tid = fresh_tid(), lane = tid & 63, wave = __builtin_amdgcn_readfirstlane(tid >> 6);
    const int x0 = (int)(xb_xcc_id() & 7u);
    unsigned pacc = 0;
    for (int k = 0; k < 8; ++k) {
        const int q = (x0 + k) & 7;
        gu32* qctr = F.ctl + CW_Q + 64 * (8 * lq + q);
        for (;;) {
            if (tid == 0) F.MISC[0] = __hip_atomic_fetch_add(qctr, 1u, __ATOMIC_RELAXED, __HIP_MEMORY_SCOPE_AGENT);
            __syncthreads();
            const int item = (int)F.MISC[0];
            __syncthreads();
            if (item >= N_Q_ITEMS) break;
            if (item < 16) { PROF_BEGIN(4) ret_chain(F, 2 * q + (item >> 3), item & 7, gn); PROF_END(4) }
            else { const int ia = item - 16; const int tb = (SEQ / NWAVES - 1) - (ia >> 1), b = 2 * q + (ia & 1);
                attn_item(F.lds + RING_OFF, F.ws, b, tb * NWAVES, lane, wave, pacc); }
        }
    }
    if (PROF_SEC != 0) { pacc = __builtin_amdgcn_readfirstlane(pacc); const unsigned t0 = PROF_T(); while (PROF_T() - t0 < pacc && pacc < 400000000u) __builtin_amdgcn_s_sleep(4); }
}

#ifndef MK_N_LAUNCHES
#define MK_N_LAUNCHES 1
#endif
constexpr int NPH = 1 + 10 * DEPTH;
constexpr int N_LAUNCHES = MK_N_LAUNCHES;
static_assert(N_LAUNCHES == 1 || N_LAUNCHES == NPH, "MK_N_LAUNCHES must be 1 or NPH");
struct Args { const void* in[15]; float* out; unsigned char* ws; int ph_lo, ph_hi, li, pad; };

__global__ void __launch_bounds__(NWAVES * 64, 2) hyb_fwd(Args args) {
    extern __shared__ __attribute__((aligned(16))) unsigned char lds[];
    Frame F;
    F.lds = (LAS unsigned char*)lds;
    F.MISC = (volatile LAS unsigned*)(F.lds + MISC_OFF);
    F.G = gridDim.x; F.ws = args.ws; F.ctl = (gu32*)(args.ws + WS_CTL); F.in = nullptr;
    for (int u = threadIdx.x; u < (LDS_BYTES - LDSCTL_OFF) / 4; u += NWAVES * 64) ((LAS unsigned*)(F.lds + LDSCTL_OFF))[u] = 0u;
    __syncthreads();
    XcdBarrier bar; bar.bar = (unsigned*)(F.ctl + CW_BAR); bar.x = 0; bar.st = nullptr;
    if (N_LAUNCHES == 1) bar = xcd_barrier_post((unsigned*)(F.ctl + CW_BAR), F.MISC + 8);
    const int lo = args.ph_lo, hi = args.ph_hi;
#ifndef PHASE_MASK
#define PHASE_MASK 0x7ff
#endif
#define PON(j) (((PHASE_MASK) >> (j)) & 1)
#ifndef PROBE_DUP
#define PROBE_DUP 0
#endif
#define DUPN(j) (1 + (((PROBE_DUP) >> (j)) & 1))
#define IN(k) (lo <= (k) && (k) < hi)
#define SEAM(k) do { if (N_LAUNCHES == 1 && IN(k) && IN((k) + 1)) xcd_barrier(bar); } while (0)
    const float* x = (const float*)args.in[0]; const float* pin = (const float*)args.in[1]; const int* positions = (const int*)args.in[2];
    const float* w_in = (const float*)args.in[3]; const float* w_out = (const float*)args.in[4]; const float* w_ff1 = (const float*)args.in[5]; const float* w_ff2 = (const float*)args.in[6];
    const float* w_ple = (const float*)args.in[7]; const float* w_gate = (const float*)args.in[8]; const float* pre_mix = (const float*)args.in[9]; const float* post_mix = (const float*)args.in[10];
    const float* pre_ff = (const float*)args.in[11]; const float* post_ff = (const float*)args.in[12]; const float* ple_norm = (const float*)args.in[13]; const float* ret_gn = (const float*)args.in[14];
    float* out = args.out; unsigned char* ws = args.ws; unsigned char* big = ws + WS_BIG;
    pg8::bf16_t* HB = (pg8::bf16_t*)(ws + WS_HB); pg8::bf16_t* Y = (pg8::bf16_t*)(ws + WS_Y); float* SS = (float*)(ws + WS_SS); float* RS = (float*)(ws + WS_RS);

    if (PON(0) && IN(0)) for (int rep = 0; rep < DUPN(0); ++rep) p0_prologue(F, x, positions, w_in, w_out, w_ff1, w_ff2, w_ple, w_gate, pre_mix, pre_ff);
    SEAM(0);
    for (int l = 0; l < DEPTH; ++l) {
        const int pb = 1 + 10 * l;
        unsigned char* wl = ws + WS_W + (size_t)l * W_LAYER;
        if (PON(1) && IN(pb + 0)) for (int rep = 0; rep < DUPN(1); ++rep) {
            pg8::Gemm g{HB, (const pg8::bf16_t*)(wl + WO_IN), M, NINP, DM}; pg8::StaticOrder S; S.init(M, NINP, F.G, (int)blockIdx.x);
            pg8::EpiIn E{big, RS, (const float*)(ws + WS_ROPE)};
            pg8::gemm_phase<pg8::EpiIn, pg8::StaticOrder, true, true>(F.lds + RING_OFF, g, S, E);
        }
        SEAM(pb + 0);
        if (PON(2) && IN(pb + 1)) for (int rep = 0; rep < DUPN(2); ++rep) mixer_phase(F, l + 2 * rep, ret_gn + (size_t)l * 1024);
        SEAM(pb + 1);
        if (PON(3) && IN(pb + 2)) for (int rep = 0; rep < DUPN(3); ++rep) {
            pg8::Gemm g{(const pg8::bf16_t*)(big + BO_MIX), (const pg8::bf16_t*)(wl + WO_OUT), M, DM, DM}; pg8::StaticOrder S; S.init(M, DM, F.G, (int)blockIdx.x);
            pg8::EpiY E{Y, SS, nullptr};
            pg8::gemm_phase<pg8::EpiY, pg8::StaticOrder, true, true>(F.lds + RING_OFF, g, S, E);
        }
        SEAM(pb + 2);
        if (PON(4) && IN(pb + 3)) thin_phase(F, nullptr, post_mix + (size_t)l * DM, nullptr);
        SEAM(pb + 3);
        if (PON(5) && IN(pb + 4)) for (int rep = 0; rep < DUPN(5); ++rep) {
            pg8::Gemm g{HB, (const pg8::bf16_t*)(wl + WO_FF1), M, DFF, DM}; pg8::StaticOrder S; S.init(M, DFF, F.G, (int)blockIdx.x);
            pg8::EpiFF1 E{(pg8::bf16_t*)(big + BO_HID), RS};
            pg8::gemm_phase<pg8::EpiFF1, pg8::StaticOrder, true, true>(F.lds + RING_OFF, g, S, E);
        }
        SEAM(pb + 4);
        if (PON(6) && IN(pb + 5)) for (int rep = 0; rep < DUPN(6); ++rep) {
            pg8::Gemm g{(const pg8::bf16_t*)(big + BO_HID), (const pg8::bf16_t*)(wl + WO_FF2), M, DM, DFF}; pg8::StaticOrder S; S.init(M, DM, F.G, (int)blockIdx.x);
            pg8::EpiY E{Y, SS, nullptr};
            pg8::gemm_phase<pg8::EpiY, pg8::StaticOrder, true, true>(F.lds + RING_OFF, g, S, E);
        }
        SEAM(pb + 5);
        if (PON(7) && IN(pb + 6)) thin_phase(F, nullptr, post_ff + (size_t)l * DM, pin + (size_t)l * M * PLE);
        SEAM(pb + 6);
        if (PON(8) && IN(pb + 7)) for (int rep = 0; rep < DUPN(8); ++rep) {
            int kple = PLE; asm volatile("" : "+s"(kple));
            pg8::Gemm g{(const pg8::bf16_t*)(big + BO_PB), (const pg8::bf16_t*)(wl + WO_PLE), M, DM, kple}; pg8::StaticOrder S; S.init(M, DM, F.G, (int)blockIdx.x);
            pg8::EpiPlain E{(pg8::bf16_t*)(big + BO_E), DM};
            pg8::gemm_phase<pg8::EpiPlain, pg8::StaticOrder, true, true>(F.lds + RING_OFF, g, S, E);
        }
        SEAM(pb + 7);
        if (PON(9) && IN(pb + 8)) for (int rep = 0; rep < DUPN(9); ++rep) {
            pg8::Gemm g{HB, (const pg8::bf16_t*)(wl + WO_GATE), M, DM, DM}; pg8::StaticOrder S; S.init(M, DM, F.G, (int)blockIdx.x);
            pg8::EpiY E{Y, SS, (const pg8::bf16_t*)(big + BO_E)};
            pg8::gemm_phase<pg8::EpiY, pg8::StaticOrder, true, true>(F.lds + RING_OFF, g, S, E);
        }
        SEAM(pb + 8);
        if (PON(10) && IN(pb + 9)) thin_phase(F, l == DEPTH - 1 ? out : nullptr, ple_norm + (size_t)l * DM, nullptr);
        SEAM(pb + 9);
    }
#undef IN
#undef SEAM
}

extern "C" void kernel_launch(void* const* d_in, const int* in_sizes, int n_in, void* d_out, int out_size, void* d_ws, size_t ws_size, hipStream_t stream) {
    static int grid = 0;
    if (grid == 0) {
        if (n_in != 15 || out_size != M * DM || ws_size < WS_END) { fprintf(stderr, "kernel_launch: unexpected shapes (n_in %d, out %d, ws %zu, need %zu)\n", n_in, out_size, ws_size, (size_t)WS_END); grid = -1; return; }
        int dev = 0, cus = 0, per_cu = 0;
        if (hipGetDevice(&dev) != hipSuccess || hipDeviceGetAttribute(&cus, hipDeviceAttributeMultiprocessorCount, dev) != hipSuccess) { grid = -1; return; }
        if (hipFuncSetAttribute((const void*)hyb_fwd, hipFuncAttributeMaxDynamicSharedMemorySize, LDS_BYTES) != hipSuccess) { fprintf(stderr, "kernel_launch: hipFuncSetAttribute failed\n"); grid = -1; return; }
        if (hipOccupancyMaxActiveBlocksPerMultiprocessor(&per_cu, (const void*)hyb_fwd, NWAVES * 64, LDS_BYTES) != hipSuccess || per_cu < 1)
            fprintf(stderr, "kernel_launch: note: occupancy query reports %d workgroups per CU\n", per_cu);
        (void)hipGetLastError();
        grid = cus;
    }
    if (grid < 0) return;
    if (hipMemsetAsync((char*)d_ws + WS_CTL, 0, CTL_ZERO_BYTES, stream) != hipSuccess) return;
    Args a{};
    for (int i = 0; i < 15; ++i) a.in[i] = d_in[i];
    a.out = (float*)d_out; a.ws = (unsigned char*)d_ws;
    for (int li = 0; li < N_LAUNCHES; ++li) {
        a.ph_lo = (N_LAUNCHES == 1) ? 0 : li; a.ph_hi = (N_LAUNCHES == 1) ? NPH : li + 1; a.li = li; a.pad = 0;
        hipLaunchKernelGGL(hyb_fwd, dim3(grid), dim3(NWAVES * 64), LDS_BYTES, stream, a);
        if (hipPeekAtLastError() != hipSuccess) { fprintf(stderr, "kernel_launch: launch %d failed\n", li); break; }
    }
}
```

```cpp
#include <hip/hip_runtime.h>
#include <cstdio>
#include <cstdint>

constexpr int NWAVES = 8;
constexpr int BATCH = 16, SEQ = 2048, DM = 2048, DEPTH = 2, M = BATCH * SEQ;
constexpr int NINL = 5456, NINP = 5632, DFF = 8192, PLE = 256;
constexpr float RMS_EPS = 1e-6f, GN_EPS = 1e-5f;
constexpr float QSCALE = 0.08838834764831845f * 1.4426950408889634f;
constexpr float LOG2_THETA_A = 18.931568569324174f, LOG2_THETA_R = 13.287712379549449f;

constexpr size_t MiB = 1u << 20;
constexpr size_t WS_CTL = 0, CTL_ZERO_BYTES = 65536;
constexpr size_t WS_W = 1 * MiB, W_LAYER = 103 * MiB;
constexpr size_t WO_IN = 0, WO_OUT = 22 * MiB, WO_FF1 = 30 * MiB, WO_FF2 = 62 * MiB, WO_PLE = 94 * MiB, WO_GATE = 95 * MiB;
constexpr size_t WS_ROPE = 207 * MiB;
constexpr size_t WS_HB = 221 * MiB, WS_Y = 349 * MiB, WS_SS = 477 * MiB, WS_RS = 481 * MiB, WS_BIG = 482 * MiB;
constexpr size_t BO_AQ = 0, BO_AKV = 64 * MiB, BO_IQ = 80 * MiB, BO_IK = 144 * MiB, BO_IW = 148 * MiB, BO_RQ = 150 * MiB, BO_RK = 182 * MiB,
                 BO_RV = 214 * MiB, BO_RG = 278 * MiB, BO_MIX = 342 * MiB;
constexpr size_t BO_HID = 0, BO_E = 0, BO_PB = 128 * MiB;
constexpr size_t WS_END = 994 * MiB;
constexpr int ROPE_W = 112;
constexpr int CW_BAR = 4096, CW_Q = 8192;
constexpr int RING_OFF = 0, RING_BYTES = 139264;
constexpr int LDSCTL_OFF = RING_BYTES, MISC_OFF = LDSCTL_OFF + 320;
constexpr int LDS_BYTES = 147456;
static_assert(MISC_OFF + 128 <= LDS_BYTES, "LDS map");
namespace pg8 {
#define PG8_LAS __attribute__((address_space(3)))
typedef unsigned short bf16_t;
typedef short bf16x8 __attribute__((ext_vector_type(8)));
typedef float f32x4 __attribute__((ext_vector_type(4)));
typedef unsigned u32x4 __attribute__((ext_vector_type(4)));
constexpr int BM = 256, BK = 64, HALF = 128, HTB = HALF * BK * 2  , STAGE_BYTES = 8 * HTB, NXCD = 8, WGM = 8;

__host__ __device__ __forceinline__ int lds_byte(int r, int c) { const int st = (r >> 4) * 2 + (c >> 5), rr = r & 15, cc = c & 31, ob = rr * 64 + cc * 2; return st * 1024 + (ob ^ (((ob >> 9) & 1) << 5)); }
__host__ __device__ __forceinline__ void stage_rc(int b, int& R, int& C) { const int st = b / 1024, sb = b % 1024, swz = sb ^ (((sb >> 9) & 1) << 5); R = (st >> 1) * 16 + swz / 64; C = (st & 1) * 32 + (swz % 64) / 2; }
__host__ __device__ __forceinline__ int perm32(int rho) { const int n = rho >> 4, i = rho & 15; return 8 * (i >> 2) + 4 * n + (i & 3); }

struct Unit { int pm, pn; };
struct Gemm { const bf16_t* A; const bf16_t* Bt; int M, N, K; };

struct StaticOrder {
    int nM, nN, nwg, G, c;
    __host__ __device__ void init(int M, int N, int G_, int c_) { nM = M / BM; nN = N / BM; nwg = nM * nN; G = G_; c = c_; }
    __host__ __device__ bool next(int i, Unit& u) const {
        const long L = (long)i * G + c; if (L >= nwg) return false;
        int wgid = (int)L; { const int q = nwg / NXCD, r = nwg % NXCD, xcd = wgid % NXCD, off = wgid / NXCD; wgid = (xcd < r ? xcd * (q + 1) : r * (q + 1) + (xcd - r) * q) + off; }
        const int nig = WGM * nN, gid = wgid / nig, fm = gid * WGM, gsz = (nM - fm) < WGM ? (nM - fm) : WGM;
        u.pm = fm + ((wgid % nig) % gsz); u.pn = (wgid % nig) / gsz; return true;
    }
    __device__ __forceinline__ void a_ready(const Unit&) const {}
    __device__ __forceinline__ void done(const Unit&) const {}
};
__device__ __forceinline__ unsigned cvt_pk_bf16(float lo, float hi) { unsigned r; asm volatile("v_cvt_pk_bf16_f32 %0, %1, %2" : "=v"(r) : "v"(lo), "v"(hi)); return r; }
typedef float f32x2 __attribute__((ext_vector_type(2)));

__device__ __forceinline__ u32x4 pack8(const f32x4& v0, const f32x4& v1) { u32x4 w; w.x = cvt_pk_bf16(v0[0], v0[1]); w.y = cvt_pk_bf16(v0[2], v0[3]); w.z = cvt_pk_bf16(v1[0], v1[1]); w.w = cvt_pk_bf16(v1[2], v1[3]); return w; }
__device__ __forceinline__ float bf_lo(unsigned w) { return __uint_as_float(w << 16); }
__device__ __forceinline__ float bf_hi(unsigned w) { return __uint_as_float(w & 0xffff0000u); }
__device__ __forceinline__ float fast_sigmoid(float x) { return __builtin_amdgcn_rcpf(1.0f + __builtin_amdgcn_exp2f(-1.4426950408889634f * x)); }
__device__ __forceinline__ float log2_gamma(int h) { const float e = __builtin_amdgcn_exp2f(-5.0f - (float)h); return -(e * (1.0f + e * (0.5f + e * (0.33333333f + e * (0.25f + e * 0.2f))))) * 1.4426950408889634f; }

struct EpiIn {
    static constexpr bool PERM = true, AFTER_DRAIN = false;
    unsigned char* big; const float* RS; const float* ROPE;
    struct Col { size_t dofs; int ldc, dcol, mode; bool has, rot; float scale, lg; };
    __device__ __forceinline__ void operator()(const f32x4 (&acc)[2][2][4][2], const Unit& u, int wr, int wc, int fr_, int fq_) const {
        int fr = fr_, fq = fq_; asm volatile("" : "+v"(fr), "+v"(fq));
        const int pn = u.pn;
        Col cl[2]; int coff = 0, soff = 0;
#pragma unroll
        for (int bj = 0; bj < 2; ++bj) {
            const int c256 = 128 * bj + 32 * wc + 8 * fq;
            Col k; k.dofs = 0; k.ldc = 0; k.dcol = 0; k.mode = 0; k.has = false; k.rot = false; k.scale = 1.f; k.lg = 0.f;
            if (pn < 4)       { k.dofs = BO_AQ;  k.has = true; k.ldc = 1024; k.dcol = pn * 256 + c256;        k.rot = (wc == 0); coff = 4 * fq; soff = 16 + 4 * fq; k.scale = QSCALE; }
            else if (pn == 4) { k.dofs = BO_AKV; k.has = true; k.ldc = 256;  k.dcol = c256;                   k.rot = (bj == 0 && wc == 0); coff = 4 * fq; soff = 16 + 4 * fq; }
            else if (pn < 9)  { k.dofs = BO_IQ;  k.has = true; k.ldc = 1024; k.dcol = (pn - 5) * 256 + c256;  k.rot = ((wc & 1) == 0 && fq < 2); coff = 32 + 4 * fq; soff = 40 + 4 * fq; }
            else if (pn == 9) { if (bj == 0 && wc < 2) { k.dofs = BO_IK; k.has = true; k.ldc = 64; k.dcol = c256; k.rot = (wc == 0 && fq < 2); coff = 32 + 4 * fq; soff = 40 + 4 * fq; }
                                else if (bj == 0 && wc == 2 && fq < 2) { k.mode = 3; } }
            else if (pn < 12) { k.dofs = BO_RQ;  k.has = true; k.ldc = 512;  k.dcol = (pn - 10) * 256 + c256; k.rot = true; coff = 48 + 16 * (wc & 1) + 4 * fq; soff = 80 + 16 * (wc & 1) + 4 * fq; }
            else if (pn < 14) { k.dofs = BO_RK;  k.has = true; k.ldc = 512;  k.dcol = (pn - 12) * 256 + c256; k.rot = true; coff = 48 + 16 * (wc & 1) + 4 * fq; soff = 80 + 16 * (wc & 1) + 4 * fq; k.scale = 0.125f; k.mode = 2;
                                k.lg = log2_gamma(4 * (pn - 12) + 2 * bj + (wc >> 1)); }
            else if (pn < 18) { k.dofs = BO_RV;  k.has = true; k.ldc = 1024; k.dcol = (pn - 14) * 256 + c256; }
            else              { k.dofs = BO_RG;  k.has = true; k.ldc = 1024; k.dcol = (pn - 18) * 256 + c256; k.mode = 1; }
            cl[bj] = k;
        }
        const bool anyrot = cl[0].rot || cl[1].rot;
        float* IW = (float*)(big + BO_IW);
#pragma unroll
        for (int ai = 0; ai < 2; ++ai) {
            float rsv[4]; f32x4 cs[4], sn[4];
#pragma unroll
            for (int m = 0; m < 4; ++m) { const int row = u.pm * BM + ai * HALF + wr * 64 + m * 16 + fr; rsv[m] = RS[row];
                cs[m] = (f32x4){1.f, 1.f, 1.f, 1.f}; sn[m] = (f32x4){0.f, 0.f, 0.f, 0.f};
                if (anyrot) { const float* rp = ROPE + (size_t)row * ROPE_W; cs[m] = *(const f32x4*)(rp + coff); sn[m] = *(const f32x4*)(rp + soff); } }
#pragma unroll
            for (int m = 0; m < 4; ++m) {
                const int row = u.pm * BM + ai * HALF + wr * 64 + m * 16 + fr;
#pragma unroll
                for (int bj = 0; bj < 2; ++bj) {
                    const Col& k = cl[bj];
                    if (!k.has && k.mode != 3) continue;
                    float sc = rsv[m] * k.scale;
                    if (k.mode == 2) sc *= __builtin_amdgcn_exp2f((float)(127 - (row & 127)) * k.lg);
                    f32x4 v0 = acc[ai][bj][m][0], v1 = acc[ai][bj][m][1];
                    if (k.rot) { const f32x4 a = v0 * cs[m] - v1 * sn[m], b = v1 * cs[m] + v0 * sn[m]; v0 = a; v1 = b; }
                    v0 = v0 * sc; v1 = v1 * sc;
                    if (k.mode == 1) {
#pragma unroll
                        for (int j = 0; j < 4; ++j) { v0[j] = v0[j] * fast_sigmoid(v0[j]); v1[j] = v1[j] * fast_sigmoid(v1[j]); } }
                    if (k.mode == 3) { float* p = IW + (size_t)row * 16 + 8 * fq; *(f32x4*)p = v0; *(f32x4*)(p + 4) = v1; }
                    else *(u32x4*)((bf16_t*)(big + k.dofs) + (size_t)row * k.ldc + k.dcol) = pack8(v0, v1);
                }
            }
            asm volatile("" ::: "memory");
        }
    }
};
struct EpiY {
    static constexpr bool PERM = true, AFTER_DRAIN = false;
    bf16_t* Y; float* SS; const bf16_t* E;
    __device__ __forceinline__ void operator()(const f32x4 (&acc)[2][2][4][2], const Unit& u, int wr, int wc, int fr_, int fq_) const {
        int fr = fr_, fq = fq_; asm volatile("" : "+v"(fr), "+v"(fq));
        const int col0 = u.pn * BM + wc * 32 + 8 * fq;
#pragma unroll
        for (int ai = 0; ai < 2; ++ai) {
            u32x4 ev[4][2];
            if (E) {
#pragma unroll
                for (int m = 0; m < 4; ++m)
#pragma unroll
                    for (int bj = 0; bj < 2; ++bj) ev[m][bj] = *(const u32x4*)(E + (size_t)(u.pm * BM + ai * HALF + wr * 64 + m * 16 + fr) * DM + col0 + bj * HALF);
            }
#pragma unroll
            for (int m = 0; m < 4; ++m) {
                const int row = u.pm * BM + ai * HALF + wr * 64 + m * 16 + fr; float q = 0.f;
#pragma unroll
                for (int bj = 0; bj < 2; ++bj) {
                    f32x4 v0 = acc[ai][bj][m][0], v1 = acc[ai][bj][m][1];
                    if (E) { const u32x4 e = ev[m][bj];
                        v0[0] = fast_sigmoid(v0[0]) * bf_lo(e.x); v0[1] = fast_sigmoid(v0[1]) * bf_hi(e.x); v0[2] = fast_sigmoid(v0[2]) * bf_lo(e.y); v0[3] = fast_sigmoid(v0[3]) * bf_hi(e.y);
                        v1[0] = fast_sigmoid(v1[0]) * bf_lo(e.z); v1[1] = fast_sigmoid(v1[1]) * bf_hi(e.z); v1[2] = fast_sigmoid(v1[2]) * bf_lo(e.w); v1[3] = fast_sigmoid(v1[3]) * bf_hi(e.w); }
                    q += (v0[0] * v0[0] + v0[1] * v0[1]) + (v0[2] * v0[2] + v0[3] * v0[3]) + (v1[0] * v1[0] + v1[1] * v1[1]) + (v1[2] * v1[2] + v1[3] * v1[3]);
                    *(u32x4*)(Y + (size_t)row * DM + col0 + bj * HALF) = pack8(v0, v1);
                }
                q += __shfl_xor(q, 16); q += __shfl_xor(q, 32);
                if (fq == 0) SS[(size_t)row * 32 + u.pn * 4 + wc] = q;
            }
            asm volatile("" ::: "memory");
        }
    }
};
struct EpiFF1 {
    static constexpr bool PERM = true, AFTER_DRAIN = false;
    bf16_t* H; const float* RS;
    __device__ __forceinline__ void operator()(const f32x4 (&acc)[2][2][4][2], const Unit& u, int wr, int wc, int fr_, int fq_) const {
        int fr = fr_, fq = fq_; asm volatile("" : "+v"(fr), "+v"(fq));
        const int col0 = u.pn * BM + wc * 32 + 8 * fq;
        float rsv[2][4];
#pragma unroll
        for (int ai = 0; ai < 2; ++ai)
#pragma unroll
            for (int m = 0; m < 4; ++m) rsv[ai][m] = RS[u.pm * BM + ai * HALF + wr * 64 + m * 16 + fr];
#pragma unroll
        for (int ai = 0; ai < 2; ++ai)
#pragma unroll
            for (int m = 0; m < 4; ++m) {
                const int row = u.pm * BM + ai * HALF + wr * 64 + m * 16 + fr; const float rs = rsv[ai][m];
#pragma unroll
                for (int bj = 0; bj < 2; ++bj) {
                    f32x4 v0 = acc[ai][bj][m][0] * rs, v1 = acc[ai][bj][m][1] * rs;
#pragma unroll
                    for (int j = 0; j < 4; ++j) { const float a = fmaxf(v0[j], 0.f), b = fmaxf(v1[j], 0.f); v0[j] = a * a; v1[j] = b * b; }
                    *(u32x4*)(H + (size_t)row * DFF + col0 + bj * HALF) = pack8(v0, v1);
                }
            }
    }
};
struct EpiPlain {
    static constexpr bool PERM = true, AFTER_DRAIN = false;
    bf16_t* O; int ldc;
    __device__ __forceinline__ void operator()(const f32x4 (&acc)[2][2][4][2], const Unit& u, int wr, int wc, int fr_, int fq_) const {
        int fr = fr_, fq = fq_; asm volatile("" : "+v"(fr), "+v"(fq));
        const int col0 = u.pn * BM + wc * 32 + 8 * fq;
#pragma unroll
        for (int ai = 0; ai < 2; ++ai)
#pragma unroll
            for (int m = 0; m < 4; ++m) {
                const int row = u.pm * BM + ai * HALF + wr * 64 + m * 16 + fr;
#pragma unroll
                for (int bj = 0; bj < 2; ++bj) *(u32x4*)(O + (size_t)row * ldc + col0 + bj * HALF) = pack8(acc[ai][bj][m][0], acc[ai][bj][m][1]);
            }
    }
};
template <class Epi, class Sched, bool ALIGN_EPI = false, bool SP2 = false>
__device__ __forceinline__ void gemm_phase(PG8_LAS unsigned char* lds, const Gemm g, const Sched& S, const Epi& E) {
    int tid_ = threadIdx.x; asm volatile("" : "+v"(tid_));
    const int tid = tid_, wid = __builtin_amdgcn_readfirstlane(tid >> 6), lane = tid & 63, wr = wid >> 2, wc = wid & 3, fr = lane & 15, fq = lane >> 4;
    const int K = g.K, nt = K / BK;
    unsigned voffA[2], voffB[2];
#pragma unroll
    for (int i = 0; i < 2; ++i) { int R, C; stage_rc(tid * 16 + i * 8192, R, C); const int Rb = Epi::PERM ? ((R & ~31) + perm32(R & 31)) : R;
        voffA[i] = (unsigned)(R * K + C) * 2u; voffB[i] = (unsigned)(Rb * K + C) * 2u; }
    const size_t kstep = (size_t)(BK * 2);
    const size_t hstep = (size_t)HALF * K * 2;
    const size_t tstep = 2 * hstep;
    const unsigned ldsw = (unsigned)wid * 1024u;
    const int aoff = lds_byte(wr * 64 + fr, fq * 8), boff = lds_byte(wc * 32 + fr, fq * 8);
#define PG8_SA(b, h) (((b) * 2 + (h)) * HTB)
#define PG8_SB(b, h) ((4 + (b) * 2 + (h)) * HTB)
#define PG8_STAGE(bufoff, gbase, voff) do { _Pragma("unroll") for (int _i = 0; _i < 2; ++_i) \
        __builtin_amdgcn_global_load_lds((const unsigned*)((const char*)(gbase) + (voff)[_i]), (PG8_LAS unsigned*)(lds + (bufoff) + ldsw + _i * 8192), 16, 0, 0); } while (0)
#define PG8_LDA(dst, b, h) do { _Pragma("unroll") for (int m = 0; m < 4; ++m) _Pragma("unroll") for (int k = 0; k < 2; ++k) dst[m][k] = *(const PG8_LAS bf16x8*)(lds + PG8_SA(b, h) + aoff + m * 2048 + k * 1024); } while (0)
#define PG8_LDB(dst, b, h) do { _Pragma("unroll") for (int n = 0; n < 2; ++n) _Pragma("unroll") for (int k = 0; k < 2; ++k) dst[n][k] = *(const PG8_LAS bf16x8*)(lds + PG8_SB(b, h) + boff + n * 2048 + k * 1024); } while (0)
#define PG8_MMA(ai, bj, At, Bt) do { __builtin_amdgcn_s_setprio(1); _Pragma("unroll") for (int m = 0; m < 4; ++m) _Pragma("unroll") for (int n = 0; n < 2; ++n) _Pragma("unroll") for (int k = 0; k < 2; ++k) \
        acc[ai][bj][m][n] = __builtin_amdgcn_mfma_f32_16x16x32_bf16(Bt[n][k], At[m][k], acc[ai][bj][m][n], 0, 0, 0); __builtin_amdgcn_s_setprio(0); } while (0)
#define PG8_WAIT_V(n) asm volatile("s_waitcnt vmcnt(" #n ")" ::: "memory")
#define PG8_WAIT_L(n) asm volatile("s_waitcnt lgkmcnt(" #n ")" ::: "memory")
#define PG8_BAR __builtin_amdgcn_s_barrier()
#define PG8_SCHED __builtin_amdgcn_sched_barrier(0)
    Unit cur, nxt; int ui = 0;
    if (!S.next(0, cur)) return;
    f32x4 acc[2][2][4][2];
#pragma unroll
    for (int a = 0; a < 2; ++a)
#pragma unroll
        for (int b = 0; b < 2; ++b)
#pragma unroll
            for (int m = 0; m < 4; ++m)
#pragma unroll
                for (int n = 0; n < 2; ++n) acc[a][b][m][n] = (f32x4){0.f, 0.f, 0.f, 0.f};
    bf16x8 At[4][2], B0[2][2], B1[2][2];
    const char* cA = (const char*)g.A + (size_t)cur.pm * tstep; const char* cB = (const char*)g.Bt + (size_t)cur.pn * tstep;
    S.a_ready(cur);
    if constexpr (SP2) {
        PG8_STAGE(PG8_SB(0, 0), cB, voffB); PG8_STAGE(PG8_SB(0, 1), cB + hstep, voffB); PG8_STAGE(PG8_SA(0, 0), cA, voffA); PG8_STAGE(PG8_SA(0, 1), cA + hstep, voffA);
        if (wr == 1) PG8_BAR;
        PG8_WAIT_V(2); PG8_BAR;
        PG8_STAGE(PG8_SB(1, 0), cB + kstep, voffB); PG8_STAGE(PG8_SA(1, 0), cA + kstep, voffA); PG8_STAGE(PG8_SB(1, 1), cB + hstep + kstep, voffB);
        PG8_WAIT_V(6); PG8_BAR;
    } else {
        PG8_STAGE(PG8_SB(0, 0), cB, voffB); PG8_STAGE(PG8_SA(0, 0), cA, voffA); PG8_STAGE(PG8_SB(0, 1), cB + hstep, voffB); PG8_STAGE(PG8_SA(0, 1), cA + hstep, voffA);
        if (wr == 1) PG8_BAR;
        PG8_WAIT_V(4); PG8_BAR;
        PG8_STAGE(PG8_SB(1, 0), cB + kstep, voffB); PG8_STAGE(PG8_SA(1, 0), cA + kstep, voffA); PG8_STAGE(PG8_SB(1, 1), cB + hstep + kstep, voffB);
        PG8_WAIT_V(6); PG8_BAR;
    }
    for (;;) {
        const bool has_next = S.next(ui + 1, nxt);
        const char* nA = has_next ? (const char*)g.A + (size_t)nxt.pm * tstep : cA; const char* nB = has_next ? (const char*)g.Bt + (size_t)nxt.pn * tstep : cB;
        for (int t = 0; t < nt; t += 2) {
            const bool last = (t == nt - 2);
            const char* a1 = cA + (size_t)(t + 1) * kstep;
            const char* a2 = last ? nA : cA + (size_t)(t + 2) * kstep; const char* b2 = last ? nB : cB + (size_t)(t + 2) * kstep;
            const char* a3 = a2 + kstep; const char* b3 = b2 + kstep;
            if (last && has_next) S.a_ready(nxt);
            if constexpr (SP2) {
            PG8_LDB(B0, 0, 0); PG8_LDB(B1, 0, 1); PG8_SCHED; PG8_LDA(At, 0, 0); PG8_STAGE(PG8_SA(1, 1), a1 + hstep, voffA);
            PG8_WAIT_V(8); PG8_WAIT_L(0); PG8_BAR; PG8_MMA(0, 0, At, B0); PG8_MMA(0, 1, At, B1); PG8_BAR; PG8_SCHED;
            PG8_LDA(At, 0, 1); PG8_STAGE(PG8_SB(0, 0), b2, voffB); PG8_STAGE(PG8_SB(0, 1), b2 + hstep, voffB); PG8_STAGE(PG8_SA(0, 0), a2, voffA);
            PG8_WAIT_V(8); PG8_WAIT_L(0); PG8_BAR; PG8_MMA(1, 0, At, B0); PG8_MMA(1, 1, At, B1); PG8_BAR; PG8_SCHED;
            PG8_LDB(B0, 1, 0); PG8_LDB(B1, 1, 1); PG8_SCHED; PG8_LDA(At, 1, 0); PG8_STAGE(PG8_SA(0, 1), a2 + hstep, voffA);
            PG8_WAIT_V(8); PG8_WAIT_L(0); PG8_BAR; PG8_MMA(0, 0, At, B0); PG8_MMA(0, 1, At, B1); PG8_BAR; PG8_SCHED;
            PG8_LDA(At, 1, 1); PG8_STAGE(PG8_SB(1, 0), b3, voffB); PG8_STAGE(PG8_SB(1, 1), b3 + hstep, voffB); PG8_STAGE(PG8_SA(1, 0), a3, voffA);
            PG8_WAIT_V(8); PG8_WAIT_L(0); PG8_BAR; PG8_MMA(1, 0, At, B0); PG8_MMA(1, 1, At, B1); PG8_BAR; PG8_SCHED;
            } else {
            PG8_LDB(B0, 0, 0); PG8_SCHED; PG8_LDA(At, 0, 0); PG8_STAGE(PG8_SA(1, 1), a1 + hstep, voffA);
            PG8_WAIT_L(8); PG8_BAR; PG8_WAIT_L(0); PG8_MMA(0, 0, At, B0); PG8_BAR; PG8_SCHED;
            PG8_LDB(B1, 0, 1); PG8_STAGE(PG8_SB(0, 0), b2, voffB);
            PG8_BAR; PG8_WAIT_L(0); PG8_MMA(0, 1, At, B1); PG8_BAR;
            PG8_LDA(At, 0, 1); PG8_STAGE(PG8_SA(0, 0), a2, voffA);
            PG8_BAR; PG8_WAIT_L(0); PG8_MMA(1, 0, At, B0); PG8_BAR; PG8_SCHED;
            PG8_STAGE(PG8_SB(0, 1), b2 + hstep, voffB);
            PG8_WAIT_V(6); PG8_BAR; PG8_MMA(1, 1, At, B1); PG8_BAR;
            PG8_LDB(B0, 1, 0); PG8_SCHED; PG8_LDA(At, 1, 0); PG8_STAGE(PG8_SA(0, 1), a2 + hstep, voffA);
            PG8_WAIT_L(8); PG8_BAR; PG8_WAIT_L(0); PG8_MMA(0, 0, At, B0); PG8_BAR; PG8_SCHED;
            PG8_LDB(B1, 1, 1); PG8_STAGE(PG8_SB(1, 0), b3, voffB);
            PG8_BAR; PG8_WAIT_L(0); PG8_MMA(0, 1, At, B1); PG8_BAR;
            PG8_LDA(At, 1, 1); PG8_STAGE(PG8_SA(1, 0), a3, voffA);
            PG8_BAR; PG8_WAIT_L(0); PG8_MMA(1, 0, At, B0); PG8_BAR; PG8_SCHED;
            PG8_STAGE(PG8_SB(1, 1), b3 + hstep, voffB);
            PG8_WAIT_V(6); PG8_BAR; PG8_MMA(1, 1, At, B1); PG8_BAR;
            }
        }
        if constexpr (ALIGN_EPI) { if (wr == 0) PG8_BAR; }
        if constexpr (!Epi::AFTER_DRAIN) { E(acc, cur, wr, wc, fr, fq); S.done(cur); }
        if (!has_next) break;
#pragma unroll
        for (int a = 0; a < 2; ++a)
#pragma unroll
            for (int b = 0; b < 2; ++b)
#pragma unroll
                for (int m = 0; m < 4; ++m)
#pragma unroll
                    for (int n = 0; n < 2; ++n) acc[a][b][m][n] = (f32x4){0.f, 0.f, 0.f, 0.f};
        cur = nxt; cA = nA; cB = nB; ++ui;
        if constexpr (ALIGN_EPI) { if (wr == 1) PG8_BAR; }
    }
    PG8_WAIT_V(0);
    if constexpr (!ALIGN_EPI) { if (wr == 0) PG8_BAR; }
    PG8_BAR;
    if constexpr (Epi::AFTER_DRAIN) { E.fused(acc, cur, wr, wc, fr, fq, lds, wid, lane); S.done(cur); }
#undef PG8_SA
#undef PG8_SB
#undef PG8_STAGE
#undef PG8_LDA
#undef PG8_LDB
#undef PG8_MMA
#undef PG8_WAIT_V
#undef PG8_WAIT_L
#undef PG8_BAR
#undef PG8_SCHED
}
}
#define GAS __attribute__((address_space(1)))
#define LAS __attribute__((address_space(3)))
typedef unsigned short bf16;
typedef unsigned v4u __attribute__((ext_vector_type(4)));
typedef float f32x4 __attribute__((ext_vector_type(4)));
typedef short bf16x8 __attribute__((ext_vector_type(8)));
typedef GAS unsigned gu32;
typedef GAS unsigned long long gu64;
#define RLX_AGENT __ATOMIC_RELAXED, __HIP_MEMORY_SCOPE_AGENT
#define LDS_WAIT() asm volatile("s_waitcnt lgkmcnt(0)" ::: "memory")
#define VM_WAIT() asm volatile("s_waitcnt vmcnt(0)" ::: "memory")
__device__ __forceinline__ unsigned long long rt() { return __builtin_amdgcn_s_memrealtime(); }
__device__ __forceinline__ unsigned f2bf(float f) { unsigned u = __builtin_bit_cast(unsigned, f); return (u + 0x7fffu + ((u >> 16) & 1u)) >> 16; }
__device__ __forceinline__ unsigned pk2(float lo, float hi) { return f2bf(lo) | (f2bf(hi) << 16); }

#define XB_TMO      128
#define XB_XCNT(j)  (256  + 64 * (j))
#define XB_XSUB(j)  (1280 + 64 * (j))
#define XB_XGEN(j)  (2304 + 64 * (j))
#define XB_TOP      3328
#define XB_TOPGEN   3392
#define XCD_BAR_WORDS 3456
#define XB_SPIN_CAP (1u << 22)

__device__ __forceinline__ unsigned xb_ld(unsigned* p)              { return __hip_atomic_load(p, __ATOMIC_RELAXED, __HIP_MEMORY_SCOPE_AGENT); }
__device__ __forceinline__ unsigned xb_add(unsigned* p, unsigned v) { return __hip_atomic_fetch_add(p, v, __ATOMIC_RELAXED, __HIP_MEMORY_SCOPE_AGENT); }
__device__ __forceinline__ unsigned xb_xcc_id() { return (unsigned)__builtin_amdgcn_s_getreg((3 << 11) | 20) & 0xFu; }
#define XB_SPIN(cond, bar) do { unsigned _sp = 0; while (cond) { __builtin_amdgcn_s_sleep(1); \
    if ((++_sp & 255u) == 0u) { if (xb_ld(&(bar)[XB_TMO])) break; if (_sp > XB_SPIN_CAP) { atomicAdd(&(bar)[XB_TMO], 1u); break; } } } } while (0)

struct XcdBarrier {
    unsigned* bar; unsigned x;
    volatile LAS unsigned* st;
};

__device__ __forceinline__ XcdBarrier xcd_barrier_post(unsigned* bar, volatile LAS unsigned* st) {
    XcdBarrier b; b.bar = bar; b.x = xb_xcc_id(); b.st = st;
    if (threadIdx.x == 0) (void)xb_add(&bar[XB_XCNT(b.x)], 1u);
    return b;
}
__device__ __forceinline__ void xcd_barrier_complete(unsigned* bar, unsigned x, unsigned& nloc, unsigned& nx) {
    const unsigned G = gridDim.x * gridDim.y * gridDim.z;
    unsigned sum, cnt, mine, sp = 0u;
    for (;;) {
        sum = 0u; cnt = 0u; mine = 0u;
#pragma unroll
        for (unsigned j = 0; j < 16; ++j) { const unsigned c = xb_ld(&bar[XB_XCNT(j)]); sum += c; cnt += (c > 0u) ? 1u : 0u; mine = (j == x) ? c : mine; }
        if (sum == G) break;
        __builtin_amdgcn_s_sleep(1);
        if ((++sp & 255u) == 0u) { if (xb_ld(&bar[XB_TMO])) break; if (sp > XB_SPIN_CAP) { atomicAdd(&bar[XB_TMO], 1u); break; } }
    }
    nloc = mine > 0u ? mine : 1u; nx = cnt > 0u ? cnt : 1u;
}

__device__ __forceinline__ void xcd_barrier(const XcdBarrier& b) {
    asm volatile("s_waitcnt vmcnt(0)" ::: "memory");
    __syncthreads();
    if (threadIdx.x == 0) {
        unsigned* bar = b.bar;
        __builtin_amdgcn_s_waitcnt(0);
        unsigned nloc = b.st[0], nx = b.st[1];
        if (nloc == 0u) { xcd_barrier_complete(bar, b.x, nloc, nx); b.st[0] = nloc; b.st[1] = nx; }
        const unsigned old = xb_add(&bar[XB_XSUB(b.x)], 1u);
        const unsigned gen = old / nloc;
        if (old + 1u == (gen + 1u) * nloc) {
            __builtin_amdgcn_fence(__ATOMIC_RELEASE, "agent");
            asm volatile("s_waitcnt vmcnt(0)" ::: "memory");
            const unsigned og = xb_add(&bar[XB_TOP], 1u);
            const unsigned tg = og / nx;
            if (og + 1u == (tg + 1u) * nx) xb_add(&bar[XB_TOPGEN], 1u);
            else XB_SPIN(xb_ld(&bar[XB_TOPGEN]) == tg, bar);
            __builtin_amdgcn_fence(__ATOMIC_ACQUIRE, "agent");
            xb_add(&bar[XB_XGEN(b.x)], 1u);
            asm volatile("s_waitcnt vmcnt(0)" ::: "memory");
        } else {
            XB_SPIN(xb_ld(&bar[XB_XGEN(b.x)]) == gen, bar);
            __builtin_amdgcn_fence(__ATOMIC_ACQUIRE, "agent");
            asm volatile("s_waitcnt vmcnt(0)" ::: "memory");
        }
    }
    __syncthreads();
}

typedef unsigned u32x4 __attribute__((ext_vector_type(4)));
typedef unsigned u32x2 __attribute__((ext_vector_type(2)));
typedef short s16x4 __attribute__((ext_vector_type(4)));
typedef float f32x2t __attribute__((ext_vector_type(2)));
typedef __bf16 bf16x2t __attribute__((ext_vector_type(2)));
#define DI __device__ __forceinline__
DI unsigned cvtpk(float lo, float hi) { f32x2t v = {lo, hi}; bf16x2t b = __builtin_convertvector(v, bf16x2t); return __builtin_bit_cast(unsigned, b); }
DI float bflo(unsigned w) { return __uint_as_float(w << 16); }
DI float bfhi(unsigned w) { return __uint_as_float(w & 0xffff0000u); }
DI s16x4 tr_read(LAS unsigned char* p) { return __builtin_bit_cast(s16x4, __builtin_amdgcn_ds_read_tr16_b64_v4i16((LAS s16x4*)p)); }
DI bf16x8 cat8(s16x4 lo, s16x4 hi) { return (bf16x8){lo[0], lo[1], lo[2], lo[3], hi[0], hi[1], hi[2], hi[3]}; }
DI int fresh_tid() { int t = threadIdx.x; asm volatile("" : "+v"(t)); return t; }
#define MFMA16(a, b, c) __builtin_amdgcn_mfma_f32_16x16x32_bf16((a), (b), (c), 0, 0, 0)
DI float wave_sum(float v) {
#pragma unroll
    for (int o = 1; o < 64; o <<= 1) v += __shfl_xor(v, o);
    return v;
}

struct Frame {
    LAS unsigned char* lds;
    volatile LAS unsigned* MISC;
    gu32* ctl;
    int G;
    unsigned char* ws;
    const float* const* in;
};

DI int perm_pairs(int p, int half) {
    const int g = p >> 3, r = p & 7; return (r < 4) ? 4 * g + r : half + 4 * g + (r - 4);
}
DI int inmap(int np) {
    if (np < 1024) { const int head = np >> 7, p = np & 127; return head * 128 + (p < 32 ? perm_pairs(p, 16) : p); }
    if (np < 1280) { const int c = np - 1024; if (c < 128) return 1024 + (c < 32 ? perm_pairs(c, 16) : c); return 1152 + (c - 128); }
    if (np < 2304) { const int q = np - 1280, head = q >> 6, p = q & 63; return 1280 + head * 64 + (p < 16 ? perm_pairs(p, 8) : p); }
    if (np < 2560) { const int c = np - 2304; if (c < 64) return 2304 + (c < 16 ? perm_pairs(c, 8) : c); if (c < 80) return 2368 + (c - 64); return -1; }
    if (np < 3584) { const int q = np - 2560, which = q >> 9, qq = q & 511, head = qq >> 6, p = qq & 63; return (which ? 2896 : 2384) + head * 64 + perm_pairs(p, 32); }
    if (np < 4608) return 3408 + (np - 3584);
    return 4432 + (np - 4608);
}
template <bool INMAP>
DI void transpose_item(const float* W, int K, int N, int NP, bf16* WT, const float* gain, LAS float* scr, int item, int lane) {
    const int nblk = NP / 64, kb = item / nblk, nb = item % nblk, k0 = 64 * kb, n0 = 64 * nb;
    const int kr = lane >> 4, nq = lane & 15;
    const int np = n0 + 4 * nq; const int L = INMAP ? inmap(np) : np;
    f32x4 v[16];
#pragma unroll
    for (int i = 0; i < 16; ++i) { v[i] = (f32x4){0.f, 0.f, 0.f, 0.f}; if (L >= 0) v[i] = *(const GAS f32x4*)(W + (size_t)(k0 + 4 * i + kr) * N + L); }
#pragma unroll
    for (int i = 0; i < 16; ++i) { const int kk = 4 * i + kr; f32x4 t = v[i]; if (gain) t = t * gain[k0 + kk]; *(LAS f32x4*)(scr + kk * 68 + 4 * nq) = t; }
    LDS_WAIT(); asm volatile("" ::: "memory");
    const int c = lane & 7;
#pragma unroll
    for (int j = 0; j < 8; ++j) { const int n = (lane >> 3) + 8 * j; const LAS float* s = scr + (8 * c) * 68 + n;
        v4u o; o.x = pk2(s[0 * 68], s[1 * 68]); o.y = pk2(s[2 * 68], s[3 * 68]); o.z = pk2(s[4 * 68], s[5 * 68]); o.w = pk2(s[6 * 68], s[7 * 68]);
        *(GAS v4u*)(WT + (size_t)(n0 + n) * K + k0 + 8 * c) = o; }
    LDS_WAIT(); asm volatile("" ::: "memory");
}
DI void sincos_rr(float x, float& s, float& c) {
    const float k = rintf(x * 0.15915494309189535f);
    float r = fmaf(-k, 6.28318548202514648f, x); r = fmaf(-k, -1.74845553e-7f, r);
    const float f = r * 0.15915494309189535f;
    s = __builtin_amdgcn_sinf(f); c = __builtin_amdgcn_cosf(f);
}

DI void p0_prologue(Frame& F, const float* x, const int* positions, const float* w_in, const float* w_out, const float* w_ff1, const float* w_ff2, const float* w_ple, const float* w_gate,
                    const float* pre_mix, const float* pre_ff) {
    const int tid = fresh_tid(), lane = tid & 63, wave = __builtin_amdgcn_readfirstlane(tid >> 6);
    LAS float* scr = (LAS float*)(F.lds + RING_OFF + wave * 17408);
    const int gw = blockIdx.x * NWAVES + wave, NGW = F.G * NWAVES;
    constexpr int I_IN = (DM / 64) * (NINP / 64), I_OUT = (DM / 64) * (DM / 64), I_FF1 = (DM / 64) * (DFF / 64), I_FF2 = (DFF / 64) * (DM / 64), I_PLE = (PLE / 64) * (DM / 64), I_GATE = I_OUT;
    static_assert(NWAVES * 17408 <= RING_BYTES, "prologue LDS");
    constexpr int PER_LAYER = I_IN + I_OUT + I_FF1 + I_FF2 + I_PLE + I_GATE;
    for (int it = gw; it < DEPTH * PER_LAYER; it += NGW) {
        const int l = it / PER_LAYER; int r = it % PER_LAYER;
        unsigned char* wl = F.ws + WS_W + (size_t)l * W_LAYER;
        if (r < I_IN)  { transpose_item<true >(w_in  + (size_t)l * DM * NINL, DM, NINL, NINP, (bf16*)(wl + WO_IN),  pre_mix + l * DM, scr, r, lane); continue; } r -= I_IN;
        if (r < I_OUT) { transpose_item<false>(w_out + (size_t)l * DM * DM,   DM, DM,  DM,    (bf16*)(wl + WO_OUT), nullptr,          scr, r, lane); continue; } r -= I_OUT;
        if (r < I_FF1) { transpose_item<false>(w_ff1 + (size_t)l * DM * DFF,  DM, DFF, DFF,   (bf16*)(wl + WO_FF1), pre_ff + l * DM,  scr, r, lane); continue; } r -= I_FF1;
        if (r < I_FF2) { transpose_item<false>(w_ff2 + (size_t)l * DFF * DM,  DFF, DM, DM,    (bf16*)(wl + WO_FF2), nullptr,          scr, r, lane); continue; } r -= I_FF2;
        if (r < I_PLE) { transpose_item<false>(w_ple + (size_t)l * PLE * DM,  PLE, DM, DM,    (bf16*)(wl + WO_PLE), nullptr,          scr, r, lane); continue; } r -= I_PLE;
        transpose_item<false>(w_gate + (size_t)l * DM * DM, DM, DM, DM, (bf16*)(wl + WO_GATE), nullptr, scr, r, lane);
    }
    float* rope = (float*)(F.ws + WS_ROPE);
    for (int e = blockIdx.x * (NWAVES * 64) + tid; e < M * 56; e += F.G * NWAVES * 64) {
        const int m = e / 56, i = e % 56; const float pos = (float)positions[m];
        float inv; int co, so;
        if (i < 16)      { inv = __builtin_amdgcn_exp2f(-(float)i * (1.0f / 16.0f) * LOG2_THETA_A);        co = i;             so = 16 + i; }
        else if (i < 24) { inv = __builtin_amdgcn_exp2f(-(float)(i - 16) * (1.0f / 8.0f) * LOG2_THETA_A);  co = 32 + (i - 16); so = 40 + (i - 16); }
        else             { inv = __builtin_amdgcn_exp2f(-(float)(i - 24) * (1.0f / 32.0f) * LOG2_THETA_R); co = 48 + (i - 24); so = 80 + (i - 24); }
        float s, c; sincos_rr(pos * inv, s, c);
        rope[(size_t)m * ROPE_W + co] = c; rope[(size_t)m * ROPE_W + so] = s;
    }
    bf16* HB = (bf16*)(F.ws + WS_HB); float* RS = (float*)(F.ws + WS_RS);
    for (int row = gw; row < M; row += NGW) {
        const GAS f32x4* xr = (const GAS f32x4*)(x + (size_t)row * DM) + lane; GAS u32x2* hb = (GAS u32x2*)(HB + (size_t)row * DM) + lane; float ss = 0.f;
#pragma unroll
        for (int j = 0; j < 8; ++j) { const f32x4 v = xr[64 * j]; ss += (v.x * v.x + v.y * v.y) + (v.z * v.z + v.w * v.w); u32x2 o; o.x = cvtpk(v.x, v.y); o.y = cvtpk(v.z, v.w); hb[64 * j] = o; }
        ss = wave_sum(ss);
        if (lane == 0) RS[row] = 1.0f / sqrtf(ss * (1.0f / DM) + RMS_EPS);
    }
}

DI void thin_phase(Frame& F, float* fout, const float* wpost, const float* pconv) {
    const int tid = fresh_tid(), lane = tid & 63, wave = __builtin_amdgcn_readfirstlane(tid >> 6);
    const int gw = blockIdx.x * NWAVES + wave, NGW = F.G * NWAVES;
    const bf16* Y = (const bf16*)(F.ws + WS_Y); const float* SS = (const float*)(F.ws + WS_SS); bf16* HB = (bf16*)(F.ws + WS_HB); float* RS = (float*)(F.ws + WS_RS);
    bf16* PB = (bf16*)(F.ws + WS_BIG + BO_PB);
    f32x4 w[8];
#pragma unroll
    for (int j = 0; j < 8; ++j) w[j] = *((const GAS f32x4*)wpost + lane + 64 * j);
    for (int row = gw; row < M; row += NGW) {
        float q = (lane < 32) ? SS[(size_t)row * 32 + lane] : 0.f; q = wave_sum(q);
        const float rstd = 1.0f / sqrtf(q * (1.0f / DM) + RMS_EPS);
        const GAS u32x2* yr = (const GAS u32x2*)(Y + (size_t)row * DM) + lane; GAS u32x2* hb = (GAS u32x2*)(HB + (size_t)row * DM) + lane; float ss = 0.f;
        u32x2 hv[8], yv[8];
#pragma unroll
        for (int j = 0; j < 8; ++j) { hv[j] = hb[64 * j]; yv[j] = yr[64 * j]; }
#pragma unroll
        for (int j = 0; j < 8; ++j) { f32x4 h;
            h.x = bflo(hv[j].x) + bflo(yv[j].x) * rstd * w[j].x; h.y = bfhi(hv[j].x) + bfhi(yv[j].x) * rstd * w[j].y; h.z = bflo(hv[j].y) + bflo(yv[j].y) * rstd * w[j].z; h.w = bfhi(hv[j].y) + bfhi(yv[j].y) * rstd * w[j].w;
            if (fout) { *((GAS f32x4*)(fout + (size_t)row * DM) + lane + 64 * j) = h; }
            else { u32x2 o; o.x = cvtpk(h.x, h.y); o.y = cvtpk(h.z, h.w); hb[64 * j] = o;
                   const float rx = bflo(o.x), ry = bfhi(o.x), rz = bflo(o.y), rw = bfhi(o.y); ss += (rx * rx + ry * ry) + (rz * rz + rw * rw); } }
        if (!fout) { ss = wave_sum(ss); if (lane == 0) RS[row] = 1.0f / sqrtf(ss * (1.0f / DM) + RMS_EPS); }
        if (pconv) { const f32x4 pv = *((const GAS f32x4*)(pconv + (size_t)row * PLE) + lane); u32x2 o; o.x = cvtpk(pv.x, pv.y); o.y = cvtpk(pv.z, pv.w); *((GAS u32x2*)(PB + (size_t)row * PLE) + lane) = o; }
    }
}

constexpr int ATT_WL = 16384 + 512;
constexpr int RET_KST = 144, RET_VST = 288, RET_K = 0, RET_V = 128 * RET_KST, RET_R = RET_V + 128 * RET_VST, RET_BYTES = RET_R + 128 * RET_KST;
static_assert(NWAVES * ATT_WL <= RING_BYTES && RET_BYTES <= RING_BYTES, "mixer LDS");
constexpr int N_RET_ITEMS = BATCH * 8, N_ATT_ITEMS = BATCH * (SEQ / NWAVES), N_MIX_ITEMS = N_RET_ITEMS + N_ATT_ITEMS;

DI void dma16(const void* g, LAS unsigned char* l) { __builtin_amdgcn_global_load_lds((const unsigned*)g, (LAS unsigned*)l, 16, 0, 0); }
#define VMW(n) asm volatile("s_waitcnt vmcnt(" #n ")" ::: "memory")
#ifndef PROF_SEC
#define PROF_SEC 0
#endif
#define PROF_T() ((unsigned)__builtin_amdgcn_s_memrealtime())
#define PROF_BEGIN(k) unsigned pt_##k = 0; if (PROF_SEC == (k)) pt_##k = PROF_T();
#define PROF_END(k) if (PROF_SEC == (k)) pacc += PROF_T() - pt_##k;
DI void attn_item(LAS unsigned char* ring, unsigned char* ws, int b, int t0, int lane, int wave, unsigned& pacc) {
    const int g = lane >> 4, c = lane & 15;
    const int t = t0 + wave;
    LAS unsigned char* wl = ring + wave * 16384;
    const bf16* AQ = (const bf16*)(ws + WS_BIG + BO_AQ); const bf16* AKV = (const bf16*)(ws + WS_BIG + BO_AKV); const bf16* IQ = (const bf16*)(ws + WS_BIG + BO_IQ);
    const bf16* IK = (const bf16*)(ws + WS_BIG + BO_IK); const float* IW = (const float*)(ws + WS_BIG + BO_IW); bf16* MIX = (bf16*)(ws + WS_BIG + BO_MIX);
    const size_t m = (size_t)b * SEQ + t; const size_t brow = (size_t)b * SEQ;
    LAS unsigned short* idx = (LAS unsigned short*)(ring + 131072 + 512 * wave);
    const int nk = t + 1; int nsel;
    if (t0 >= 256) {
        PROF_BEGIN(1)
        const bf16* iqp = IQ + m * 1024 + c * 64 + 8 * g;
        const bf16x8 a0 = *(const bf16x8*)iqp, a1 = *(const bf16x8*)(iqp + 32);
        const f32x4 w4 = *(const f32x4*)(IW + m * 16 + 4 * g);
        u32x4 wfu; wfu.x = cvtpk(w4.x, w4.y); wfu.y = cvtpk(w4.z, w4.w); wfu.z = 0u; wfu.w = 0u;
        const bf16x8 wfrag = __builtin_bit_cast(bf16x8, wfu); const bf16x8 zfrag = (bf16x8){0, 0, 0, 0, 0, 0, 0, 0};
        asm volatile("s_waitcnt vmcnt(0)" :: "v"(a0), "v"(a1), "v"(wfrag) : "memory");
        const int nchunk = (t0 + 8 + 255) >> 8;
        const int r8 = lane >> 3, s8 = lane & 7;
#define ISSUE_IK(k) do { _Pragma("unroll") for (int i_ = 0; i_ < 4; ++i_) { const int row_ = 32 * wave + 8 * i_; \
            dma16(IK + (brow + 256 * (k) + row_ + r8) * 64 + 8 * (s8 ^ (((row_ + r8) >> 1) & 7)), ring + ((k) & 3) * 32768 + 128 * row_); } } while (0)
#pragma unroll
        for (int k = 0; k < 3; ++k) if (k < nchunk) ISSUE_IK(k);
        unsigned u[32];
#pragma unroll
        for (int k = 0; k < 8; ++k) {
            f32x4 d2 = {0.f, 0.f, 0.f, 0.f};
            if (k < nchunk) {
                const int ahead = nchunk - 1 - k;
                if (ahead >= 2) VMW(8); else if (ahead == 1) VMW(4); else VMW(0);
                __builtin_amdgcn_s_barrier();
                asm volatile("" ::: "memory");
                if (k + 3 < nchunk) ISSUE_IK(k + 3);
                int cc = c; asm volatile("" : "+v"(cc));
                const LAS unsigned char* kbase = ring + (k & 3) * 32768 + 128 * cc;
#pragma unroll
                for (int j = 0; j < 16; ++j) {
                    if (256 * k + 16 * j <= t0 + 7) {
                        const LAS unsigned char* kp = kbase + 2048 * j;
                        const int sw = ((16 * j + cc) >> 1) & 7;
                        const bf16x8 kb0 = *(const LAS bf16x8*)(kp + 16 * (g ^ sw)), kb1 = *(const LAS bf16x8*)(kp + 16 * ((4 + g) ^ sw));
                        f32x4 d = {0.f, 0.f, 0.f, 0.f};
                        d = MFMA16(a0, kb0, d); d = MFMA16(a1, kb1, d);
                        u32x4 ru; ru.x = cvtpk(fmaxf(d.x, 0.f), fmaxf(d.y, 0.f)); ru.y = cvtpk(fmaxf(d.z, 0.f), fmaxf(d.w, 0.f)); ru.z = 0u; ru.w = 0u;
                        d2 = MFMA16((cc == j) ? wfrag : zfrag, __builtin_bit_cast(bf16x8, ru), d2);
                    }
                }
            }
#pragma unroll
            for (int r = 0; r < 4; ++r) { const int key = 256 * k + 16 * (4 * g + r) + c; const unsigned bb = __float_as_uint(d2[r]); const unsigned ok = (bb & 0x80000000u) ? ~bb : (bb | 0x80000000u); u[4 * k + r] = (key < nk) ? ok : 0u; }
        }
        asm volatile("s_waitcnt lgkmcnt(0)" ::: "memory");
        __builtin_amdgcn_s_barrier();
        asm volatile("" ::: "memory");
#undef ISSUE_IK
        PROF_END(1)
        PROF_BEGIN(2)
        unsigned T = 0u;
        for (int bit = 31; bit >= 0; --bit) {
            const unsigned cand = T | (1u << bit); int cnt = 0;
#pragma unroll
            for (int i = 0; i < 32; ++i) cnt += __popcll(__ballot(u[i] >= cand));
            if (cnt >= 256) T = cand;
            if (cnt == 256) break;
        }
        int cgt = 0;
#pragma unroll
        for (int i = 0; i < 32; ++i) cgt += __popcll(__ballot(u[i] > T));
        const int quota = 256 - cgt;
        const unsigned long long lt = (1ull << lane) - 1ull;
        int base = 0, eqrun = 0;
#pragma unroll
        for (int i = 0; i < 32; ++i) {
            const bool gt = u[i] > T, eq = u[i] == T;
            const unsigned long long meq = __ballot(eq);
            const int eqrank = eqrun + __popcll(meq & lt);
            const bool sel = gt || (eq && eqrank < quota);
            const unsigned long long ms = __ballot(sel);
            if (sel) idx[base + __popcll(ms & lt)] = (unsigned short)(256 * (i >> 2) + 16 * (4 * g + (i & 3)) + c);
            base += __popcll(ms); eqrun += __popcll(meq);
        }
        PROF_END(2)
        nsel = 256;
    } else {
#pragma unroll
        for (int r = 0; r < 4; ++r) { const int j = lane + 64 * r; idx[j] = (unsigned short)(j < nk ? j : 0); }
        nsel = nk;
    }
    LDS_WAIT(); __builtin_amdgcn_wave_barrier();
    PROF_BEGIN(3)
    int lane3 = lane; asm volatile("" : "+v"(lane3));
    const int G3 = lane3 >> 4, C3 = lane3 & 15;
    bf16x8 qf[4];
#pragma unroll
    for (int ks = 0; ks < 4; ++ks) { qf[ks] = (bf16x8){0, 0, 0, 0, 0, 0, 0, 0}; if (C3 < 8) qf[ks] = *(const bf16x8*)(AQ + m * 1024 + C3 * 128 + 32 * ks + 8 * G3); }
    asm volatile("s_waitcnt vmcnt(0)" :: "v"(qf[0]), "v"(qf[1]), "v"(qf[2]), "v"(qf[3]) : "memory");
    const int ntile = (nsel + 15) >> 4;
#define ISSUE_K(kt) do { const u32x2 iw_ = *(const LAS u32x2*)(idx + 16 * (kt) + 4 * G3); \
        _Pragma("unroll") for (int i_ = 0; i_ < 4; ++i_) { const int r_ = 4 * i_ + G3; const int key_ = (int)(((i_ & 2) ? iw_.y : iw_.x) >> (16 * (i_ & 1))) & 0xffff; \
        dma16(AKV + (brow + key_) * 256 + 8 * (C3 ^ r_), wl + ((kt) & 3) * 4096 + 1024 * i_); } } while (0)
#pragma unroll
    for (int kt = 0; kt < 4; ++kt) if (kt < ntile) ISSUE_K(kt);
    f32x4 s[16];
#pragma unroll
    for (int kt = 0; kt < 16; ++kt) {
        s[kt] = (f32x4){-INFINITY, -INFINITY, -INFINITY, -INFINITY};
        if (kt < ntile) {
            const int ahead = ntile - 1 - kt;
            if (ahead >= 3) VMW(12); else if (ahead == 2) VMW(8); else if (ahead == 1) VMW(4); else VMW(0);
            const LAS unsigned char* kp = wl + (kt & 3) * 4096 + 256 * C3;
            bf16x8 ka[4];
#pragma unroll
            for (int ks = 0; ks < 4; ++ks) ka[ks] = *(const LAS bf16x8*)(kp + 16 * ((4 * ks + G3) ^ C3));
            f32x4 d = {0.f, 0.f, 0.f, 0.f};
#pragma unroll
            for (int ks = 0; ks < 4; ++ks) d = MFMA16(ka[ks], qf[ks], d);
#pragma unroll
            for (int r = 0; r < 4; ++r) s[kt][r] = (16 * kt + 4 * r + G3 < nsel) ? d[r] : -INFINITY;
            asm volatile("" :: "v"(d) : "memory");
            if (kt + 4 < ntile) ISSUE_K(kt + 4);
        }
    }
    const int nstep = (nsel + 31) >> 5;
#define ISSUE_V(st) do { const u32x2 ia_ = *(const LAS u32x2*)(idx + 32 * (st) + 4 * G3), ib_ = *(const LAS u32x2*)(idx + 32 * (st) + 16 + 4 * G3); \
        _Pragma("unroll") for (int i_ = 0; i_ < 8; ++i_) { const int r_ = 4 * i_ + G3; const u32x2 iw_ = (i_ & 4) ? ib_ : ia_; const int key_ = (int)(((i_ & 2) ? iw_.y : iw_.x) >> (16 * (i_ & 1))) & 0xffff; \
        dma16(AKV + (brow + key_) * 256 + 128 + 8 * (C3 ^ (2 * (r_ & 7))), wl + ((st) & 1) * 8192 + 1024 * i_); } } while (0)
    ISSUE_V(0);
    if (nstep > 1) ISSUE_V(1);
    float mx = -INFINITY;
#pragma unroll
    for (int kt = 0; kt < 16; ++kt) mx = fmaxf(fmaxf(mx, fmaxf(s[kt][0], s[kt][1])), fmaxf(s[kt][2], s[kt][3]));
    mx = fmaxf(mx, __shfl_xor(mx, 16)); mx = fmaxf(mx, __shfl_xor(mx, 32));
    float l = 0.f;
#pragma unroll
    for (int kt = 0; kt < 16; ++kt)
#pragma unroll
        for (int r = 0; r < 4; ++r) { const float p = __builtin_amdgcn_exp2f(s[kt][r] - mx); s[kt][r] = p; l += p; }
    l += __shfl_xor(l, 16); l += __shfl_xor(l, 32);
    const float inv = 1.0f / l;
    f32x4 o[8];
#pragma unroll
    for (int dt = 0; dt < 8; ++dt) o[dt] = (f32x4){0.f, 0.f, 0.f, 0.f};
    const int q4 = C3 >> 2, p4 = C3 & 3, r0 = 4 * G3 + q4;
#pragma unroll
    for (int st = 0; st < 8; ++st) {
        if (st < nstep) {
            if (st + 1 < nstep) VMW(8); else VMW(0);
            u32x4 pw; pw.x = cvtpk(s[2 * st][0], s[2 * st][1]); pw.y = cvtpk(s[2 * st][2], s[2 * st][3]); pw.z = cvtpk(s[2 * st + 1][0], s[2 * st + 1][1]); pw.w = cvtpk(s[2 * st + 1][2], s[2 * st + 1][3]);
            const bf16x8 pb = __builtin_bit_cast(bf16x8, pw);
            const unsigned vb = (unsigned)(uintptr_t)(wl + (st & 1) * 8192 + 256 * r0 + 8 * (p4 & 1));
            s16x4 lo[8], hi[8];
#pragma unroll
            for (int dt = 0; dt < 8; ++dt) {
                const unsigned pos = vb + 16 * ((2 * dt + (p4 >> 1)) ^ (2 * (r0 & 7)));
                asm volatile("ds_read_b64_tr_b16 %0, %1" : "=&v"(lo[dt]) : "v"(pos) : "memory");
                asm volatile("ds_read_b64_tr_b16 %0, %1 offset:4096" : "=&v"(hi[dt]) : "v"(pos) : "memory");
            }
            asm volatile("s_waitcnt lgkmcnt(0)" : "+v"(lo[0]), "+v"(lo[1]), "+v"(lo[2]), "+v"(lo[3]), "+v"(lo[4]), "+v"(lo[5]), "+v"(lo[6]), "+v"(lo[7]),
                                                  "+v"(hi[0]), "+v"(hi[1]), "+v"(hi[2]), "+v"(hi[3]), "+v"(hi[4]), "+v"(hi[5]), "+v"(hi[6]), "+v"(hi[7]) :: "memory");
#pragma unroll
            for (int dt = 0; dt < 8; ++dt) o[dt] = MFMA16(cat8(lo[dt], hi[dt]), pb, o[dt]);
            asm volatile("" :: "v"(o[7]) : "memory");
            if (st + 2 < nstep) ISSUE_V(st + 2);
        }
    }
    if (C3 < 8) {
        bf16* op = MIX + m * 2048 + C3 * 128 + 4 * G3;
#pragma unroll
        for (int dt = 0; dt < 8; ++dt) { u32x2 w; w.x = cvtpk(o[dt][0] * inv, o[dt][1] * inv); w.y = cvtpk(o[dt][2] * inv, o[dt][3] * inv); *(u32x2*)(op + 16 * dt) = w; }
    }
    PROF_END(3)
#undef ISSUE_K
#undef ISSUE_V
}

DI void ret_chain(Frame& F, int b, int h, const float* gn) {
    LAS unsigned char* lds = F.lds + RING_OFF; unsigned char* ws = F.ws;
    const bf16* RQ = (const bf16*)(ws + WS_BIG + BO_RQ); const bf16* RK = (const bf16*)(ws + WS_BIG + BO_RK); const bf16* RV = (const bf16*)(ws + WS_BIG + BO_RV);
    const bf16* RG = (const bf16*)(ws + WS_BIG + BO_RG); bf16* MIX = (bf16*)(ws + WS_BIG + BO_MIX);
    const int tid = fresh_tid(), lane = tid & 63, w = __builtin_amdgcn_readfirstlane(tid >> 6), g = lane >> 4, c = lane & 15, q4 = c >> 2, p4 = c & 3;
    const float lg = pg8::log2_gamma(h);
    const int i = 16 * w + c;
    const float xi = __builtin_amdgcn_exp2f((float)(i + 1) * lg), fi = __builtin_amdgcn_exp2f((float)(i - 127) * lg), gC = __builtin_amdgcn_exp2f(128.0f * lg);
    f32x4 RT[4];
#pragma unroll
    for (int dt = 0; dt < 4; ++dt) RT[dt] = (f32x4){0.f, 0.f, 0.f, 0.f};
    for (int ch = 0; ch < 16; ++ch) {
        const size_t row0 = (size_t)b * SEQ + 128 * ch;
        __syncthreads();
#pragma unroll
        for (int r = 0; r < 2; ++r) { const int row = (tid >> 3) + 64 * r, ck = tid & 7; *(LAS u32x4*)(lds + RET_K + row * RET_KST + 16 * ck) = *(const u32x4*)(RK + (row0 + row) * 512 + h * 64 + 8 * ck); }
#pragma unroll
        for (int r = 0; r < 4; ++r) { const int row = (tid >> 4) + 32 * r, ck = tid & 15; *(LAS u32x4*)(lds + RET_V + row * RET_VST + 16 * ck) = *(const u32x4*)(RV + (row0 + row) * 1024 + h * 128 + 8 * ck); }
#pragma unroll
        for (int dt = 0; dt < 4; ++dt)
#pragma unroll
            for (int r = 0; r < 4; ++r) *(LAS unsigned short*)(lds + RET_R + (16 * w + 4 * g + r) * RET_KST + 2 * (16 * dt + c)) = (unsigned short)f2bf(RT[dt][r]);
        __syncthreads();
        const bf16* qp = RQ + (row0 + i) * 512 + h * 64 + 8 * g;
        const bf16x8 qb0 = *(const bf16x8*)qp, qb1 = *(const bf16x8*)(qp + 32);
        f32x4 o[8];
#pragma unroll
        for (int vt = 0; vt < 8; ++vt) o[vt] = (f32x4){0.f, 0.f, 0.f, 0.f};
        if (ch > 0) {
#pragma unroll
            for (int vt = 0; vt < 8; ++vt) {
                const LAS unsigned char* rp = lds + RET_R + (16 * vt + c) * RET_KST + 16 * g;
                o[vt] = MFMA16(*(const LAS bf16x8*)rp, qb0, o[vt]); o[vt] = MFMA16(*(const LAS bf16x8*)(rp + 64), qb1, o[vt]);
            }
#pragma unroll
            for (int vt = 0; vt < 8; ++vt) o[vt] = o[vt] * xi;
        }
#pragma unroll
        for (int st = 0; st < 4; ++st) {
            if (2 * st <= w) {
                f32x4 d0 = {0.f, 0.f, 0.f, 0.f}, d1 = {0.f, 0.f, 0.f, 0.f};
                { const LAS unsigned char* kp = lds + RET_K + (32 * st + c) * RET_KST + 16 * g;
                  d0 = MFMA16(*(const LAS bf16x8*)kp, qb0, d0); d0 = MFMA16(*(const LAS bf16x8*)(kp + 64), qb1, d0);
                  d1 = MFMA16(*(const LAS bf16x8*)(kp + 16 * RET_KST), qb0, d1); d1 = MFMA16(*(const LAS bf16x8*)(kp + 16 * RET_KST + 64), qb1, d1); }
#pragma unroll
                for (int r = 0; r < 4; ++r) { const int j0 = 32 * st + 4 * g + r; d0[r] = (j0 <= i) ? d0[r] * fi : 0.f; d1[r] = (j0 + 16 <= i) ? d1[r] * fi : 0.f; }
                u32x4 pw; pw.x = cvtpk(d0[0], d0[1]); pw.y = cvtpk(d0[2], d0[3]); pw.z = cvtpk(d1[0], d1[1]); pw.w = cvtpk(d1[2], d1[3]);
                const bf16x8 pb = __builtin_bit_cast(bf16x8, pw);
                LAS unsigned char* vb = lds + RET_V + (32 * st + 4 * g + q4) * RET_VST + 8 * p4;
#pragma unroll
                for (int vt = 0; vt < 8; ++vt) {
                    const s16x4 lo = tr_read(vb + 32 * vt), hi = tr_read(vb + 16 * RET_VST + 32 * vt);
                    o[vt] = MFMA16(cat8(lo, hi), pb, o[vt]);
                }
            }
        }
        {
            float sm = 0.f;
#pragma unroll
            for (int vt = 0; vt < 8; ++vt) sm += (o[vt][0] + o[vt][1]) + (o[vt][2] + o[vt][3]);
            sm += __shfl_xor(sm, 16); sm += __shfl_xor(sm, 32);
            const float mu = sm * (1.0f / 128.0f); float vq = 0.f;
#pragma unroll
            for (int vt = 0; vt < 8; ++vt) { const f32x4 dd = o[vt] - mu; vq += (dd[0] * dd[0] + dd[1] * dd[1]) + (dd[2] * dd[2] + dd[3] * dd[3]); }
            vq += __shfl_xor(vq, 16); vq += __shfl_xor(vq, 32);
            const float rstd = 1.0f / sqrtf(vq * (1.0f / 128.0f) + GN_EPS);
            const size_t mrow = row0 + i;
#pragma unroll
            for (int vt = 0; vt < 8; ++vt) {
                const int v0 = h * 128 + 16 * vt + 4 * g;
                const f32x4 gw = *(const f32x4*)(gn + v0); const u32x2 gt = *(const u32x2*)(RG + mrow * 1024 + v0);
                const float y0 = (o[vt][0] - mu) * rstd * gw[0] * bflo(gt.x), y1 = (o[vt][1] - mu) * rstd * gw[1] * bfhi(gt.x), y2 = (o[vt][2] - mu) * rstd * gw[2] * bflo(gt.y), y3 = (o[vt][3] - mu) * rstd * gw[3] * bfhi(gt.y);
                u32x2 ow; ow.x = cvtpk(y0, y1); ow.y = cvtpk(y2, y3); *(u32x2*)(MIX + mrow * 2048 + 1024 + v0) = ow;
            }
        }
#pragma unroll
        for (int dt = 0; dt < 4; ++dt) RT[dt] = RT[dt] * gC;
#pragma unroll
        for (int st = 0; st < 4; ++st) {
            LAS unsigned char* vb = lds + RET_V + (32 * st + 8 * g + q4) * RET_VST + 32 * w + 8 * p4;
            const bf16x8 va = cat8(tr_read(vb), tr_read(vb + 4 * RET_VST));
            LAS unsigned char* kp = lds + RET_K + (32 * st + 8 * g + q4) * RET_KST + 8 * p4;
#pragma unroll
            for (int dt = 0; dt < 4; ++dt) { const bf16x8 kbf = cat8(tr_read(kp + 32 * dt), tr_read(kp + 4 * RET_KST + 32 * dt)); RT[dt] = MFMA16(va, kbf, RT[dt]); }
        }
    }
    __syncthreads();
}

constexpr int N_Q_ITEMS = 16 + 2 * (SEQ / NWAVES);
DI void mixer_phase(Frame& F, int lq, const float* gn) {
    const int tid = fresh_tid(), lane = tid & 63, wave = __builtin_amdgcn_readfirstlane(tid >> 6);
    unsigned pacc = 0;
    gu32* qbase = F.ctl + CW_Q + 64 * 8 * lq;
    int q = (int)(xb_xcc_id() & 7u);
    unsigned nxt = 0xffffffffu;
    if (tid == 0) nxt = __hip_atomic_fetch_add(qbase + 64 * q, 1u, __ATOMIC_RELAXED, __HIP_MEMORY_SCOPE_AGENT);
    for (;;) {
        if (tid == 0) {
            for (int tries = 0; nxt >= (unsigned)N_Q_ITEMS && tries < 8; ++tries) { q = (q + 1) & 7;
                if (__hip_atomic_load(qbase + 64 * q, __ATOMIC_RELAXED, __HIP_MEMORY_SCOPE_AGENT) < (unsigned)N_Q_ITEMS) nxt = __hip_atomic_fetch_add(qbase + 64 * q, 1u, __ATOMIC_RELAXED, __HIP_MEMORY_SCOPE_AGENT); }
            F.MISC[0] = nxt < (unsigned)N_Q_ITEMS ? nxt : 0xffffffffu; F.MISC[1] = (unsigned)q;
        }
        __syncthreads();
        const unsigned item = F.MISC[0]; const int qi = (int)F.MISC[1];
        __syncthreads();
        if (item == 0xffffffffu) break;
        if (tid == 0) nxt = __hip_atomic_fetch_add(qbase + 64 * q, 1u, __ATOMIC_RELAXED, __HIP_MEMORY_SCOPE_AGENT);
        if (item < 16u) { PROF_BEGIN(4) ret_chain(F, 2 * qi + (int)(item >> 3), (int)(item & 7u), gn); PROF_END(4) }
        else { const int ia = (int)item - 16; const int tb = (SEQ / NWAVES - 1) - (ia >> 1), b = 2 * qi + (ia & 1);
            PROF_BEGIN(5) attn_item(F.lds + RING_OFF, F.ws, b, tb * NWAVES, lane, wave, pacc); PROF_END(5) }
    }
    if (PROF_SEC != 0) { pacc = __builtin_amdgcn_readfirstlane(pacc); const unsigned t0 = PROF_T(); while (PROF_T() - t0 < pacc && pacc < 400000000u) __builtin_amdgcn_s_sleep(4); }
}

#ifndef MK_N_LAUNCHES
#define MK_N_LAUNCHES 1
#endif
constexpr int NPH = 1 + 10 * DEPTH;
constexpr int N_LAUNCHES = MK_N_LAUNCHES;
static_assert(N_LAUNCHES == 1 || N_LAUNCHES == NPH, "MK_N_LAUNCHES must be 1 or NPH");
struct Args { const void* in[15]; float* out; unsigned char* ws; int ph_lo, ph_hi, li, pad; };

__global__ void __launch_bounds__(NWAVES * 64, 2) hyb_fwd(Args args) {
    extern __shared__ __attribute__((aligned(16))) unsigned char lds[];
    Frame F;
    F.lds = (LAS unsigned char*)lds;
    F.MISC = (volatile LAS unsigned*)(F.lds + MISC_OFF);
    F.G = gridDim.x; F.ws = args.ws; F.ctl = (gu32*)(args.ws + WS_CTL); F.in = nullptr;
    for (int u = threadIdx.x; u < (LDS_BYTES - LDSCTL_OFF) / 4; u += NWAVES * 64) ((LAS unsigned*)(F.lds + LDSCTL_OFF))[u] = 0u;
    __syncthreads();
    XcdBarrier bar; bar.bar = (unsigned*)(F.ctl + CW_BAR); bar.x = 0; bar.st = nullptr;
    if (N_LAUNCHES == 1) bar = xcd_barrier_post((unsigned*)(F.ctl + CW_BAR), F.MISC + 8);
    const int lo = args.ph_lo, hi = args.ph_hi;
#ifndef PHASE_MASK
#define PHASE_MASK 0x7ff
#endif
#define PON(j) (((PHASE_MASK) >> (j)) & 1)
#ifndef PROBE_DUP
#define PROBE_DUP 0
#endif
#define DUPN(j) (1 + (((PROBE_DUP) >> (j)) & 1))
#define IN(k) (lo <= (k) && (k) < hi)
#ifndef PROF_PHASE
#define PROF_PHASE 0
#endif
    unsigned pp_acc = 0, pp_t0 = 0;
#define PP_ON(j) ((((PROF_PHASE) >> (j)) & 1) != 0)
#define PP_BEGIN(j) do { if (PP_ON(j)) pp_t0 = (unsigned)__builtin_amdgcn_s_memrealtime(); } while (0)
#define PP_END(j) do { if (PP_ON(j)) pp_acc += (unsigned)__builtin_amdgcn_s_memrealtime() - pp_t0; } while (0)
#define SEAM(k) do { if (N_LAUNCHES == 1 && IN(k) && IN((k) + 1)) xcd_barrier(bar); } while (0)
    const float* x = (const float*)args.in[0]; const float* pin = (const float*)args.in[1]; const int* positions = (const int*)args.in[2];
    const float* w_in = (const float*)args.in[3]; const float* w_out = (const float*)args.in[4]; const float* w_ff1 = (const float*)args.in[5]; const float* w_ff2 = (const float*)args.in[6];
    const float* w_ple = (const float*)args.in[7]; const float* w_gate = (const float*)args.in[8]; const float* pre_mix = (const float*)args.in[9]; const float* post_mix = (const float*)args.in[10];
    const float* pre_ff = (const float*)args.in[11]; const float* post_ff = (const float*)args.in[12]; const float* ple_norm = (const float*)args.in[13]; const float* ret_gn = (const float*)args.in[14];
    float* out = args.out; unsigned char* ws = args.ws; unsigned char* big = ws + WS_BIG;
    pg8::bf16_t* HB = (pg8::bf16_t*)(ws + WS_HB); pg8::bf16_t* Y = (pg8::bf16_t*)(ws + WS_Y); float* SS = (float*)(ws + WS_SS); float* RS = (float*)(ws + WS_RS);

    PP_BEGIN(0);
    if (PON(0) && IN(0)) for (int rep = 0; rep < DUPN(0); ++rep) p0_prologue(F, x, positions, w_in, w_out, w_ff1, w_ff2, w_ple, w_gate, pre_mix, pre_ff);
    SEAM(0); PP_END(0);
    for (int l = 0; l < DEPTH; ++l) {
        const int pb = 1 + 10 * l;
        unsigned char* wl = ws + WS_W + (size_t)l * W_LAYER;
        PP_BEGIN(1);
        if (PON(1) && IN(pb + 0)) for (int rep = 0; rep < DUPN(1); ++rep) {
            pg8::Gemm g{HB, (const pg8::bf16_t*)(wl + WO_IN), M, NINP, DM}; pg8::StaticOrder S; S.init(M, NINP, F.G, (int)blockIdx.x);
            pg8::EpiIn E{big, RS, (const float*)(ws + WS_ROPE)};
            pg8::gemm_phase<pg8::EpiIn, pg8::StaticOrder, true, true>(F.lds + RING_OFF, g, S, E);
        }
        SEAM(pb + 0); PP_END(1);
        PP_BEGIN(2);
        if (PON(2) && IN(pb + 1)) for (int rep = 0; rep < DUPN(2); ++rep) mixer_phase(F, l + 2 * rep, ret_gn + (size_t)l * 1024);
        SEAM(pb + 1); PP_END(2);
        PP_BEGIN(3);
        if (PON(3) && IN(pb + 2)) for (int rep = 0; rep < DUPN(3); ++rep) {
            pg8::Gemm g{(const pg8::bf16_t*)(big + BO_MIX), (const pg8::bf16_t*)(wl + WO_OUT), M, DM, DM}; pg8::StaticOrder S; S.init(M, DM, F.G, (int)blockIdx.x);
            pg8::EpiY E{Y, SS, nullptr};
            pg8::gemm_phase<pg8::EpiY, pg8::StaticOrder, true, true>(F.lds + RING_OFF, g, S, E);
        }
        SEAM(pb + 2); PP_END(3);
        PP_BEGIN(4);
        if (PON(4) && IN(pb + 3)) thin_phase(F, nullptr, post_mix + (size_t)l * DM, nullptr);
        SEAM(pb + 3); PP_END(4);
        PP_BEGIN(5);
        if (PON(5) && IN(pb + 4)) for (int rep = 0; rep < DUPN(5); ++rep) {
            pg8::Gemm g{HB, (const pg8::bf16_t*)(wl + WO_FF1), M, DFF, DM}; pg8::StaticOrder S; S.init(M, DFF, F.G, (int)blockIdx.x);
            pg8::EpiFF1 E{(pg8::bf16_t*)(big + BO_HID), RS};
            pg8::gemm_phase<pg8::EpiFF1, pg8::StaticOrder, true, true>(F.lds + RING_OFF, g, S, E);
        }
        SEAM(pb + 4); PP_END(5);
        PP_BEGIN(6);
        if (PON(6) && IN(pb + 5)) for (int rep = 0; rep < DUPN(6); ++rep) {
            pg8::Gemm g{(const pg8::bf16_t*)(big + BO_HID), (const pg8::bf16_t*)(wl + WO_FF2), M, DM, DFF}; pg8::StaticOrder S; S.init(M, DM, F.G, (int)blockIdx.x);
            pg8::EpiY E{Y, SS, nullptr};
            pg8::gemm_phase<pg8::EpiY, pg8::StaticOrder, true, true>(F.lds + RING_OFF, g, S, E);
        }
        SEAM(pb + 5); PP_END(6);
        PP_BEGIN(7);
        if (PON(7) && IN(pb + 6)) thin_phase(F, nullptr, post_ff + (size_t)l * DM, pin + (size_t)l * M * PLE);
        SEAM(pb + 6); PP_END(7);
        PP_BEGIN(8);
        if (PON(8) && IN(pb + 7)) for (int rep = 0; rep < DUPN(8); ++rep) {
            int kple = PLE; asm volatile("" : "+s"(kple));
            pg8::Gemm g{(const pg8::bf16_t*)(big + BO_PB), (const pg8::bf16_t*)(wl + WO_PLE), M, DM, kple}; pg8::StaticOrder S; S.init(M, DM, F.G, (int)blockIdx.x);
            pg8::EpiPlain E{(pg8::bf16_t*)(big + BO_E), DM};
            pg8::gemm_phase<pg8::EpiPlain, pg8::StaticOrder, true, true>(F.lds + RING_OFF, g, S, E);
        }
        SEAM(pb + 7); PP_END(8);
        PP_BEGIN(9);
        if (PON(9) && IN(pb + 8)) for (int rep = 0; rep < DUPN(9); ++rep) {
            pg8::Gemm g{HB, (const pg8::bf16_t*)(wl + WO_GATE), M, DM, DM}; pg8::StaticOrder S; S.init(M, DM, F.G, (int)blockIdx.x);
            pg8::EpiY E{Y, SS, (const pg8::bf16_t*)(big + BO_E)};
            pg8::gemm_phase<pg8::EpiY, pg8::StaticOrder, true, true>(F.lds + RING_OFF, g, S, E);
        }
        SEAM(pb + 8); PP_END(9);
        PP_BEGIN(10);
        if (PON(10) && IN(pb + 9)) thin_phase(F, l == DEPTH - 1 ? out : nullptr, ple_norm + (size_t)l * DM, nullptr);
        SEAM(pb + 9); PP_END(10);
    }
    if (PROF_PHASE != 0) { pp_acc = __builtin_amdgcn_readfirstlane(pp_acc); const unsigned t0 = (unsigned)__builtin_amdgcn_s_memrealtime(); while ((unsigned)__builtin_amdgcn_s_memrealtime() - t0 < pp_acc) __builtin_amdgcn_s_sleep(4); }
#undef IN
#undef SEAM
}

extern "C" void kernel_launch(void* const* d_in, const int* in_sizes, int n_in, void* d_out, int out_size, void* d_ws, size_t ws_size, hipStream_t stream) {
    static int grid = 0;
    if (grid == 0) {
        if (n_in != 15 || out_size != M * DM || ws_size < WS_END) { fprintf(stderr, "kernel_launch: unexpected shapes (n_in %d, out %d, ws %zu, need %zu)\n", n_in, out_size, ws_size, (size_t)WS_END); grid = -1; return; }
        int dev = 0, cus = 0, per_cu = 0;
        if (hipGetDevice(&dev) != hipSuccess || hipDeviceGetAttribute(&cus, hipDeviceAttributeMultiprocessorCount, dev) != hipSuccess) { grid = -1; return; }
        if (hipFuncSetAttribute((const void*)hyb_fwd, hipFuncAttributeMaxDynamicSharedMemorySize, LDS_BYTES) != hipSuccess) { fprintf(stderr, "kernel_launch: hipFuncSetAttribute failed\n"); grid = -1; return; }
        if (hipOccupancyMaxActiveBlocksPerMultiprocessor(&per_cu, (const void*)hyb_fwd, NWAVES * 64, LDS_BYTES) != hipSuccess || per_cu < 1)
            fprintf(stderr, "kernel_launch: note: occupancy query reports %d workgroups per CU\n", per_cu);
        (void)hipGetLastError();
        grid = cus;
    }
    if (grid < 0) return;
    if (hipMemsetAsync((char*)d_ws + WS_CTL, 0, CTL_ZERO_BYTES, stream) != hipSuccess) return;
    Args a{};
    for (int i = 0; i < 15; ++i) a.in[i] = d_in[i];
    a.out = (float*)d_out; a.ws = (unsigned char*)d_ws;
    for (int li = 0; li < N_LAUNCHES; ++li) {
        a.ph_lo = (N_LAUNCHES == 1) ? 0 : li; a.ph_hi = (N_LAUNCHES == 1) ? NPH : li + 1; a.li = li; a.pad = 0;
        hipLaunchKernelGGL(hyb_fwd, dim3(grid), dim3(NWAVES * 64), LDS_BYTES, stream, a);
        if (hipPeekAtLastError() != hipSuccess) { fprintf(stderr, "kernel_launch: launch %d failed\n", li); break; }
    }
}
```

```cpp
#include <hip/hip_runtime.h>
#include <cstdio>
#include <cstdint>

constexpr int NWAVES = 8;
constexpr int BATCH = 16, SEQ = 2048, DM = 2048, DEPTH = 2, M = BATCH * SEQ;
constexpr int NINL = 5456, NINP = 5632, DFF = 8192, PLE = 256;
constexpr float RMS_EPS = 1e-6f, GN_EPS = 1e-5f;
constexpr float QSCALE = 0.08838834764831845f * 1.4426950408889634f;
constexpr float HID_SCALE = 4.0f, W2_SCALE = 64.0f;
constexpr float LOG2_THETA_A = 18.931568569324174f, LOG2_THETA_R = 13.287712379549449f;

constexpr size_t MiB = 1u << 20;
constexpr size_t WS_CTL = 0, CTL_ZERO_BYTES = 65536;
constexpr size_t WS_W = 1 * MiB, W_LAYER = 103 * MiB;
constexpr size_t WO_IN = 0, WO_OUT = 22 * MiB, WO_FF1 = 30 * MiB, WO_FF2 = 62 * MiB, WO_PLE = 94 * MiB, WO_GATE = 95 * MiB;
constexpr size_t WS_ROPE = 207 * MiB;
constexpr size_t WS_HB = 221 * MiB, WS_Y = 349 * MiB, WS_SS = 477 * MiB, WS_RS = 481 * MiB, WS_BIG = 482 * MiB;
constexpr size_t BO_AQ = 0, BO_AKV = 64 * MiB, BO_IQ = 80 * MiB, BO_IK = 144 * MiB, BO_IW = 148 * MiB, BO_RQ = 150 * MiB, BO_RK = 182 * MiB,
                 BO_RV = 214 * MiB, BO_RG = 278 * MiB, BO_MIX = 342 * MiB;
constexpr size_t BO_HID = 0, BO_E = 0, BO_PB = 128 * MiB;
constexpr size_t WS_END = 994 * MiB;
constexpr int ROPE_W = 112;
constexpr int CW_BAR = 4096, CW_Q = 8192;
constexpr int RING_OFF = 0, RING_BYTES = 139264;
constexpr int LDSCTL_OFF = RING_BYTES, MISC_OFF = LDSCTL_OFF + 320;
constexpr int LDS_BYTES = 147456;
static_assert(MISC_OFF + 128 <= LDS_BYTES, "LDS map");
namespace pg8 {
#define PG8_LAS __attribute__((address_space(3)))
typedef unsigned short bf16_t;
typedef short bf16x8 __attribute__((ext_vector_type(8)));
typedef float f32x4 __attribute__((ext_vector_type(4)));
typedef unsigned u32x4 __attribute__((ext_vector_type(4)));
constexpr int BM = 256, BK = 64, HALF = 128, HTB = HALF * BK * 2  , STAGE_BYTES = 8 * HTB, NXCD = 8, WGM = 8;

__host__ __device__ __forceinline__ int lds_byte(int r, int c) { const int st = (r >> 4) * 2 + (c >> 5), rr = r & 15, cc = c & 31, ob = rr * 64 + cc * 2; return st * 1024 + (ob ^ (((ob >> 9) & 1) << 5)); }
__host__ __device__ __forceinline__ void stage_rc(int b, int& R, int& C) { const int st = b / 1024, sb = b % 1024, swz = sb ^ (((sb >> 9) & 1) << 5); R = (st >> 1) * 16 + swz / 64; C = (st & 1) * 32 + (swz % 64) / 2; }
__host__ __device__ __forceinline__ int perm32(int rho) { const int n = rho >> 4, i = rho & 15; return 8 * (i >> 2) + 4 * n + (i & 3); }

struct Unit { int pm, pn; };
struct Gemm { const bf16_t* A; const bf16_t* Bt; int M, N, K; };

struct StaticOrder {
    int nM, nN, nwg, G, c;
    __host__ __device__ void init(int M, int N, int G_, int c_) { nM = M / BM; nN = N / BM; nwg = nM * nN; G = G_; c = c_; }
    __host__ __device__ bool next(int i, Unit& u) const {
        const long L = (long)i * G + c; if (L >= nwg) return false;
        int wgid = (int)L; { const int q = nwg / NXCD, r = nwg % NXCD, xcd = wgid % NXCD, off = wgid / NXCD; wgid = (xcd < r ? xcd * (q + 1) : r * (q + 1) + (xcd - r) * q) + off; }
        const int nig = WGM * nN, gid = wgid / nig, fm = gid * WGM, gsz = (nM - fm) < WGM ? (nM - fm) : WGM;
        u.pm = fm + ((wgid % nig) % gsz); u.pn = (wgid % nig) / gsz; return true;
    }
    __device__ __forceinline__ void a_ready(const Unit&) const {}
    __device__ __forceinline__ void done(const Unit&) const {}
};
__device__ __forceinline__ unsigned cvt_pk_bf16(float lo, float hi) { unsigned r; asm volatile("v_cvt_pk_bf16_f32 %0, %1, %2" : "=v"(r) : "v"(lo), "v"(hi)); return r; }
typedef float f32x2 __attribute__((ext_vector_type(2)));

__device__ __forceinline__ u32x4 pack8(const f32x4& v0, const f32x4& v1) { u32x4 w; w.x = cvt_pk_bf16(v0[0], v0[1]); w.y = cvt_pk_bf16(v0[2], v0[3]); w.z = cvt_pk_bf16(v1[0], v1[1]); w.w = cvt_pk_bf16(v1[2], v1[3]); return w; }
__device__ __forceinline__ float bf_lo(unsigned w) { return __uint_as_float(w << 16); }
__device__ __forceinline__ float bf_hi(unsigned w) { return __uint_as_float(w & 0xffff0000u); }
__device__ __forceinline__ float fast_sigmoid(float x) { return __builtin_amdgcn_rcpf(1.0f + __builtin_amdgcn_exp2f(-1.4426950408889634f * x)); }
__device__ __forceinline__ float log2_gamma(int h) { const float e = __builtin_amdgcn_exp2f(-5.0f - (float)h); return -(e * (1.0f + e * (0.5f + e * (0.33333333f + e * (0.25f + e * 0.2f))))) * 1.4426950408889634f; }

struct EpiIn {
    static constexpr bool PERM = true, AFTER_DRAIN = false;
    unsigned char* big; const float* RS; const float* ROPE;
    struct Col { size_t dofs; int ldc, dcol, mode; bool has, rot; float scale, lg; };
    __device__ __forceinline__ void operator()(const f32x4 (&acc)[2][2][4][2], const Unit& u, int wr, int wc, int fr_, int fq_) const {
        int fr = fr_, fq = fq_; asm volatile("" : "+v"(fr), "+v"(fq));
        const int pn = u.pn;
        Col cl[2]; int coff = 0, soff = 0;
#pragma unroll
        for (int bj = 0; bj < 2; ++bj) {
            const int c256 = 128 * bj + 32 * wc + 8 * fq;
            Col k; k.dofs = 0; k.ldc = 0; k.dcol = 0; k.mode = 0; k.has = false; k.rot = false; k.scale = 1.f; k.lg = 0.f;
            if (pn < 4)       { k.dofs = BO_AQ;  k.has = true; k.ldc = 1024; k.dcol = pn * 256 + c256;        k.rot = (wc == 0); coff = 4 * fq; soff = 16 + 4 * fq; k.scale = QSCALE; }
            else if (pn == 4) { k.dofs = BO_AKV; k.has = true; k.ldc = 256;  k.dcol = c256;                   k.rot = (bj == 0 && wc == 0); coff = 4 * fq; soff = 16 + 4 * fq; }
            else if (pn < 9)  { k.dofs = BO_IQ;  k.has = true; k.ldc = 1024; k.dcol = (pn - 5) * 256 + c256;  k.rot = ((wc & 1) == 0 && fq < 2); coff = 32 + 4 * fq; soff = 40 + 4 * fq; }
            else if (pn == 9) { if (bj == 0 && wc < 2) { k.dofs = BO_IK; k.has = true; k.ldc = 64; k.dcol = c256; k.rot = (wc == 0 && fq < 2); coff = 32 + 4 * fq; soff = 40 + 4 * fq; }
                                else if (bj == 0 && wc == 2 && fq < 2) { k.mode = 3; } }
            else if (pn < 12) { k.dofs = BO_RQ;  k.has = true; k.ldc = 512;  k.dcol = (pn - 10) * 256 + c256; k.rot = true; coff = 48 + 16 * (wc & 1) + 4 * fq; soff = 80 + 16 * (wc & 1) + 4 * fq; }
            else if (pn < 14) { k.dofs = BO_RK;  k.has = true; k.ldc = 512;  k.dcol = (pn - 12) * 256 + c256; k.rot = true; coff = 48 + 16 * (wc & 1) + 4 * fq; soff = 80 + 16 * (wc & 1) + 4 * fq; k.scale = 0.125f; k.mode = 2;
                                k.lg = log2_gamma(4 * (pn - 12) + 2 * bj + (wc >> 1)); }
            else if (pn < 18) { k.dofs = BO_RV;  k.has = true; k.ldc = 1024; k.dcol = (pn - 14) * 256 + c256; }
            else              { k.dofs = BO_RG;  k.has = true; k.ldc = 1024; k.dcol = (pn - 18) * 256 + c256; k.mode = 1; }
            cl[bj] = k;
        }
        const bool anyrot = cl[0].rot || cl[1].rot;
        float* IW = (float*)(big + BO_IW);
#pragma unroll
        for (int ai = 0; ai < 2; ++ai) {
            float rsv[4]; f32x4 cs[4], sn[4];
#pragma unroll
            for (int m = 0; m < 4; ++m) { const int row = u.pm * BM + ai * HALF + wr * 64 + m * 16 + fr; rsv[m] = RS[row];
                cs[m] = (f32x4){1.f, 1.f, 1.f, 1.f}; sn[m] = (f32x4){0.f, 0.f, 0.f, 0.f};
                if (anyrot) { const float* rp = ROPE + (size_t)row * ROPE_W; cs[m] = *(const f32x4*)(rp + coff); sn[m] = *(const f32x4*)(rp + soff); } }
#pragma unroll
            for (int m = 0; m < 4; ++m) {
                const int row = u.pm * BM + ai * HALF + wr * 64 + m * 16 + fr;
#pragma unroll
                for (int bj = 0; bj < 2; ++bj) {
                    const Col& k = cl[bj];
                    if (!k.has && k.mode != 3) continue;
                    float sc = rsv[m] * k.scale;
                    if (k.mode == 2) sc *= __builtin_amdgcn_exp2f((float)(127 - (row & 127)) * k.lg);
                    f32x4 v0 = acc[ai][bj][m][0], v1 = acc[ai][bj][m][1];
                    if (k.rot) { const f32x4 a = v0 * cs[m] - v1 * sn[m], b = v1 * cs[m] + v0 * sn[m]; v0 = a; v1 = b; }
                    v0 = v0 * sc; v1 = v1 * sc;
                    if (k.mode == 1) {
#pragma unroll
                        for (int j = 0; j < 4; ++j) { v0[j] = v0[j] * fast_sigmoid(v0[j]); v1[j] = v1[j] * fast_sigmoid(v1[j]); } }
                    if (k.mode == 3) { float* p = IW + (size_t)row * 16 + 8 * fq; *(f32x4*)p = v0; *(f32x4*)(p + 4) = v1; }
                    else *(u32x4*)((bf16_t*)(big + k.dofs) + (size_t)row * k.ldc + k.dcol) = pack8(v0, v1);
                }
            }
            asm volatile("" ::: "memory");
        }
    }
};
template <bool PERMV> struct EpiYT {
    static constexpr bool PERM = PERMV, AFTER_DRAIN = false;
    bf16_t* Y; float* SS; const bf16_t* E; float oscale;
    __device__ __forceinline__ void operator()(const f32x4 (&acc)[2][2][4][2], const Unit& u, int wr, int wc, int fr_, int fq_) const {
        int fr = fr_, fq = fq_; asm volatile("" : "+v"(fr), "+v"(fq));
        const int col0 = u.pn * BM + wc * 32 + (PERMV ? 8 : 4) * fq;
#pragma unroll
        for (int ai = 0; ai < 2; ++ai) {
            u32x4 ev[4][2];
            if (PERMV && E) {
#pragma unroll
                for (int m = 0; m < 4; ++m)
#pragma unroll
                    for (int bj = 0; bj < 2; ++bj) ev[m][bj] = *(const u32x4*)(E + (size_t)(u.pm * BM + ai * HALF + wr * 64 + m * 16 + fr) * DM + col0 + bj * HALF);
            }
#pragma unroll
            for (int m = 0; m < 4; ++m) {
                const int row = u.pm * BM + ai * HALF + wr * 64 + m * 16 + fr; float q = 0.f;
#pragma unroll
                for (int bj = 0; bj < 2; ++bj) {
                    f32x4 v0 = acc[ai][bj][m][0] * oscale, v1 = acc[ai][bj][m][1] * oscale;
                    if (PERMV && E) { const u32x4 e = ev[m][bj];
                        v0[0] = fast_sigmoid(v0[0]) * bf_lo(e.x); v0[1] = fast_sigmoid(v0[1]) * bf_hi(e.x); v0[2] = fast_sigmoid(v0[2]) * bf_lo(e.y); v0[3] = fast_sigmoid(v0[3]) * bf_hi(e.y);
                        v1[0] = fast_sigmoid(v1[0]) * bf_lo(e.z); v1[1] = fast_sigmoid(v1[1]) * bf_hi(e.z); v1[2] = fast_sigmoid(v1[2]) * bf_lo(e.w); v1[3] = fast_sigmoid(v1[3]) * bf_hi(e.w); }
                    q += (v0[0] * v0[0] + v0[1] * v0[1]) + (v0[2] * v0[2] + v0[3] * v0[3]) + (v1[0] * v1[0] + v1[1] * v1[1]) + (v1[2] * v1[2] + v1[3] * v1[3]);
                    if (PERMV) *(u32x4*)(Y + (size_t)row * DM + col0 + bj * HALF) = pack8(v0, v1);
                    else { typedef unsigned u32x2e __attribute__((ext_vector_type(2)));
                        *(u32x2e*)(Y + (size_t)row * DM + col0 + bj * HALF) = (u32x2e){cvt_pk_bf16(v0[0], v0[1]), cvt_pk_bf16(v0[2], v0[3])};
                        *(u32x2e*)(Y + (size_t)row * DM + col0 + bj * HALF + 16) = (u32x2e){cvt_pk_bf16(v1[0], v1[1]), cvt_pk_bf16(v1[2], v1[3])}; }
                }
                q += __shfl_xor(q, 16); q += __shfl_xor(q, 32);
                if (fq == 0) SS[(size_t)row * 32 + u.pn * 4 + wc] = q;
            }
            asm volatile("" ::: "memory");
        }
    }
};
typedef EpiYT<true> EpiY;
struct EpiFF1 {
    static constexpr bool PERM = true, AFTER_DRAIN = false;
    unsigned char* H; const float* RS;
    __device__ __forceinline__ void operator()(const f32x4 (&acc)[2][2][4][2], const Unit& u, int wr, int wc, int fr_, int fq_) const {
        int fr = fr_, fq = fq_; asm volatile("" : "+v"(fr), "+v"(fq));
        const int col0 = u.pn * BM + wc * 32 + 8 * fq;
        float rsv[2][4];
#pragma unroll
        for (int ai = 0; ai < 2; ++ai)
#pragma unroll
            for (int m = 0; m < 4; ++m) rsv[ai][m] = RS[u.pm * BM + ai * HALF + wr * 64 + m * 16 + fr];
#pragma unroll
        for (int ai = 0; ai < 2; ++ai)
#pragma unroll
            for (int m = 0; m < 4; ++m) {
                const int row = u.pm * BM + ai * HALF + wr * 64 + m * 16 + fr; const float rs = rsv[ai][m];
#pragma unroll
                for (int bj = 0; bj < 2; ++bj) {
                    f32x4 v0 = acc[ai][bj][m][0] * rs, v1 = acc[ai][bj][m][1] * rs;
#pragma unroll
                    for (int j = 0; j < 4; ++j) { const float a = fmaxf(v0[j], 0.f), b = fmaxf(v1[j], 0.f); v0[j] = a * a * HID_SCALE; v1[j] = b * b * HID_SCALE; }
                    unsigned w0 = 0u, w1 = 0u;
                    w0 = __builtin_amdgcn_cvt_pk_fp8_f32(v0[0], v0[1], w0, false); w0 = __builtin_amdgcn_cvt_pk_fp8_f32(v0[2], v0[3], w0, true);
                    w1 = __builtin_amdgcn_cvt_pk_fp8_f32(v1[0], v1[1], w1, false); w1 = __builtin_amdgcn_cvt_pk_fp8_f32(v1[2], v1[3], w1, true);
                    typedef unsigned u32x2e __attribute__((ext_vector_type(2)));
                    *(u32x2e*)(H + (size_t)row * DFF + col0 + bj * HALF) = (u32x2e){w0, w1};
                }
            }
    }
};
struct EpiPlain {
    static constexpr bool PERM = true, AFTER_DRAIN = false;
    bf16_t* O; int ldc;
    __device__ __forceinline__ void operator()(const f32x4 (&acc)[2][2][4][2], const Unit& u, int wr, int wc, int fr_, int fq_) const {
        int fr = fr_, fq = fq_; asm volatile("" : "+v"(fr), "+v"(fq));
        const int col0 = u.pn * BM + wc * 32 + 8 * fq;
#pragma unroll
        for (int ai = 0; ai < 2; ++ai)
#pragma unroll
            for (int m = 0; m < 4; ++m) {
                const int row = u.pm * BM + ai * HALF + wr * 64 + m * 16 + fr;
#pragma unroll
                for (int bj = 0; bj < 2; ++bj) *(u32x4*)(O + (size_t)row * ldc + col0 + bj * HALF) = pack8(acc[ai][bj][m][0], acc[ai][bj][m][1]);
            }
    }
};
typedef int pg8_v8i __attribute__((ext_vector_type(8))); typedef int pg8_v4i __attribute__((ext_vector_type(4)));
__device__ __forceinline__ pg8_v8i pg8_cat(bf16x8 lo, bf16x8 hi) { return __builtin_shufflevector(__builtin_bit_cast(pg8_v4i, lo), __builtin_bit_cast(pg8_v4i, hi), 0, 1, 2, 3, 4, 5, 6, 7); }
template <class Epi, class Sched, bool ALIGN_EPI = false, bool SP2 = false, bool F8 = false>
__device__ __forceinline__ void gemm_phase(PG8_LAS unsigned char* lds, const Gemm g, const Sched& S, const Epi& E, const int wave_id) {
    unsigned ones_ = ~0u; asm volatile("" : "+s"(ones_)); int tid_ = wave_id * 64 + (int)__builtin_amdgcn_mbcnt_hi(ones_, __builtin_amdgcn_mbcnt_lo(ones_, 0u)); asm volatile("" : "+v"(tid_));
    const int tid = tid_, wid = __builtin_amdgcn_readfirstlane(tid >> 6), lane = tid & 63, wr = wid >> 2, wc = wid & 3, fr = lane & 15, fq = lane >> 4;
    const int K = g.K, nt = K / BK;
    unsigned voffA[2], voffB[2];
#pragma unroll
    for (int i = 0; i < 2; ++i) { int R, C; stage_rc(tid * 16 + i * 8192, R, C); const int Rb = Epi::PERM ? ((R & ~31) + perm32(R & 31)) : R;
        voffA[i] = (unsigned)(R * K + C) * 2u; voffB[i] = (unsigned)(Rb * K + C) * 2u; }
    const size_t kstep = (size_t)(BK * 2);
    const size_t hstep = (size_t)HALF * K * 2;
    const size_t tstep = 2 * hstep;
    const unsigned ldsw = (unsigned)wid * 1024u;
    const int aoff = lds_byte(wr * 64 + fr, fq * 8), boff = lds_byte(wc * 32 + fr, fq * 8);
#define PG8_SA(b, h) (((b) * 2 + (h)) * HTB)
#define PG8_SB(b, h) ((4 + (b) * 2 + (h)) * HTB)
#define PG8_STAGE(bufoff, gbase, voff) do { if constexpr (F8) { _Pragma("unroll") for (int _i = 0; _i < 2; ++_i) {   \
        const unsigned m0v_ = (unsigned)(uintptr_t)(lds + (bufoff) + ldsw + _i * 8192); \
        unsigned keep_; asm volatile("s_mov_b32 %0, m0\n\ts_mov_b32 m0, %3\n\ts_nop 0\n\tglobal_load_lds_dwordx4 %1, %2\n\ts_mov_b32 m0, %0" : "=&s"(keep_) : "v"((voff)[_i]), "s"((const void*)(gbase)), "s"(m0v_) : "memory"); } } \
        else { _Pragma("unroll") for (int _i = 0; _i < 2; ++_i) \
        __builtin_amdgcn_global_load_lds((const unsigned*)((const char*)(gbase) + (voff)[_i]), (PG8_LAS unsigned*)(lds + (bufoff) + ldsw + _i * 8192), 16, 0, 0); } } while (0)
#define PG8_LDA(dst, b, h) do { if constexpr (F8) { _Pragma("unroll") for (int m = 0; m < 4; ++m) dst##8[m] = pg8_cat(*(const PG8_LAS bf16x8*)(lds + PG8_SA(b, h) + aoff + m * 2048), *(const PG8_LAS bf16x8*)(lds + PG8_SA(b, h) + aoff + m * 2048 + 1024)); } \
        else { _Pragma("unroll") for (int m = 0; m < 4; ++m) _Pragma("unroll") for (int k = 0; k < 2; ++k) dst[m][k] = *(const PG8_LAS bf16x8*)(lds + PG8_SA(b, h) + aoff + m * 2048 + k * 1024); } } while (0)
#define PG8_LDB(dst, b, h) do { if constexpr (F8) { _Pragma("unroll") for (int n = 0; n < 2; ++n) dst##8[n] = pg8_cat(*(const PG8_LAS bf16x8*)(lds + PG8_SB(b, h) + boff + n * 2048), *(const PG8_LAS bf16x8*)(lds + PG8_SB(b, h) + boff + n * 2048 + 1024)); } \
        else { _Pragma("unroll") for (int n = 0; n < 2; ++n) _Pragma("unroll") for (int k = 0; k < 2; ++k) dst[n][k] = *(const PG8_LAS bf16x8*)(lds + PG8_SB(b, h) + boff + n * 2048 + k * 1024); } } while (0)
#define PG8_MMA(ai, bj, At, Bt) do { __builtin_amdgcn_s_setprio(1); if constexpr (F8) { _Pragma("unroll") for (int m = 0; m < 4; ++m) _Pragma("unroll") for (int n = 0; n < 2; ++n) \
        acc[ai][bj][m][n] = __builtin_amdgcn_mfma_scale_f32_16x16x128_f8f6f4(Bt##8[n], At##8[m], acc[ai][bj][m][n], 0, 0, 0, 0x7f7f7f7f, 0, 0x7f7f7f7f); } \
        else { _Pragma("unroll") for (int m = 0; m < 4; ++m) _Pragma("unroll") for (int n = 0; n < 2; ++n) _Pragma("unroll") for (int k = 0; k < 2; ++k) \
        acc[ai][bj][m][n] = __builtin_amdgcn_mfma_f32_16x16x32_bf16(Bt[n][k], At[m][k], acc[ai][bj][m][n], 0, 0, 0); } __builtin_amdgcn_s_setprio(0); } while (0)
#define PG8_WAIT_V(n) asm volatile("s_waitcnt vmcnt(" #n ")" ::: "memory")
#define PG8_WAIT_L(n) asm volatile("s_waitcnt lgkmcnt(" #n ")" ::: "memory")
#define PG8_BAR __builtin_amdgcn_s_barrier()
#define PG8_SCHED __builtin_amdgcn_sched_barrier(0)
    Unit cur, nxt; int ui = 0;
    if (!S.next(0, cur)) return;
    f32x4 acc[2][2][4][2];
#pragma unroll
    for (int a = 0; a < 2; ++a)
#pragma unroll
        for (int b = 0; b < 2; ++b)
#pragma unroll
            for (int m = 0; m < 4; ++m)
#pragma unroll
                for (int n = 0; n < 2; ++n) acc[a][b][m][n] = (f32x4){0.f, 0.f, 0.f, 0.f};
    bf16x8 At[4][2], B0[2][2], B1[2][2]; pg8_v8i At8[4], B08[2], B18[2];
    const char* cA = (const char*)g.A + (size_t)cur.pm * tstep; const char* cB = (const char*)g.Bt + (size_t)cur.pn * tstep;
    S.a_ready(cur);
    if constexpr (SP2) {
        PG8_STAGE(PG8_SB(0, 0), cB, voffB); PG8_STAGE(PG8_SB(0, 1), cB + hstep, voffB); PG8_STAGE(PG8_SA(0, 0), cA, voffA); PG8_STAGE(PG8_SA(0, 1), cA + hstep, voffA);
        if (wr == 1) PG8_BAR;
        PG8_WAIT_V(2); PG8_BAR;
        PG8_STAGE(PG8_SB(1, 0), cB + kstep, voffB); PG8_STAGE(PG8_SA(1, 0), cA + kstep, voffA); PG8_STAGE(PG8_SB(1, 1), cB + hstep + kstep, voffB);
        PG8_WAIT_V(6); PG8_BAR;
    } else {
        PG8_STAGE(PG8_SB(0, 0), cB, voffB); PG8_STAGE(PG8_SA(0, 0), cA, voffA); PG8_STAGE(PG8_SB(0, 1), cB + hstep, voffB); PG8_STAGE(PG8_SA(0, 1), cA + hstep, voffA);
        if (wr == 1) PG8_BAR;
        PG8_WAIT_V(4); PG8_BAR;
        PG8_STAGE(PG8_SB(1, 0), cB + kstep, voffB); PG8_STAGE(PG8_SA(1, 0), cA + kstep, voffA); PG8_STAGE(PG8_SB(1, 1), cB + hstep + kstep, voffB);
        PG8_WAIT_V(6); PG8_BAR;
    }
    for (;;) {
        const bool has_next = S.next(ui + 1, nxt);
        const char* nA = has_next ? (const char*)g.A + (size_t)nxt.pm * tstep : cA; const char* nB = has_next ? (const char*)g.Bt + (size_t)nxt.pn * tstep : cB;
        if constexpr (F8) {
            static_assert(!F8 || SP2, "the fp8 loop is the SP2 schedule");
#pragma unroll 1
            for (int t = 0; t < nt; ++t) {
                const int b = t & 1;
                const char* a1 = (t + 1 >= nt) ? nA + (size_t)(t + 1 - nt) * kstep : cA + (size_t)(t + 1) * kstep;
                const char* a2 = (t + 2 >= nt) ? nA + (size_t)(t + 2 - nt) * kstep : cA + (size_t)(t + 2) * kstep;
                const char* b2 = (t + 2 >= nt) ? nB + (size_t)(t + 2 - nt) * kstep : cB + (size_t)(t + 2) * kstep;
                if (t == nt - 2 && has_next) S.a_ready(nxt);
                PG8_LDB(B0, b, 0); PG8_LDB(B1, b, 1); PG8_SCHED; PG8_LDA(At, b, 0); PG8_STAGE(PG8_SA(1 - b, 1), a1 + hstep, voffA);
                PG8_WAIT_V(8); PG8_WAIT_L(0); PG8_BAR; PG8_MMA(0, 0, At, B0); PG8_MMA(0, 1, At, B1); PG8_BAR; PG8_SCHED;
                PG8_LDA(At, b, 1); PG8_STAGE(PG8_SB(b, 0), b2, voffB); PG8_STAGE(PG8_SB(b, 1), b2 + hstep, voffB); PG8_STAGE(PG8_SA(b, 0), a2, voffA);
                PG8_WAIT_V(8); PG8_WAIT_L(0); PG8_BAR; PG8_MMA(1, 0, At, B0); PG8_MMA(1, 1, At, B1); PG8_BAR; PG8_SCHED;
            }
        } else
        for (int t = 0; t < nt; t += 2) {
            const bool last = (t == nt - 2);
            const char* a1 = cA + (size_t)(t + 1) * kstep;
            const char* a2 = last ? nA : cA + (size_t)(t + 2) * kstep; const char* b2 = last ? nB : cB + (size_t)(t + 2) * kstep;
            const char* a3 = a2 + kstep; const char* b3 = b2 + kstep;
            if (last && has_next) S.a_ready(nxt);
            if constexpr (SP2) {
            PG8_LDB(B0, 0, 0); PG8_LDB(B1, 0, 1); PG8_SCHED; PG8_LDA(At, 0, 0); PG8_STAGE(PG8_SA(1, 1), a1 + hstep, voffA);
            PG8_WAIT_V(8); PG8_WAIT_L(0); PG8_BAR; PG8_MMA(0, 0, At, B0); PG8_MMA(0, 1, At, B1); PG8_BAR; PG8_SCHED;
            PG8_LDA(At, 0, 1); PG8_STAGE(PG8_SB(0, 0), b2, voffB); PG8_STAGE(PG8_SB(0, 1), b2 + hstep, voffB); PG8_STAGE(PG8_SA(0, 0), a2, voffA);
            PG8_WAIT_V(8); PG8_WAIT_L(0); PG8_BAR; PG8_MMA(1, 0, At, B0); PG8_MMA(1, 1, At, B1); PG8_BAR; PG8_SCHED;
            PG8_LDB(B0, 1, 0); PG8_LDB(B1, 1, 1); PG8_SCHED; PG8_LDA(At, 1, 0); PG8_STAGE(PG8_SA(0, 1), a2 + hstep, voffA);
            PG8_WAIT_V(8); PG8_WAIT_L(0); PG8_BAR; PG8_MMA(0, 0, At, B0); PG8_MMA(0, 1, At, B1); PG8_BAR; PG8_SCHED;
            PG8_LDA(At, 1, 1); PG8_STAGE(PG8_SB(1, 0), b3, voffB); PG8_STAGE(PG8_SB(1, 1), b3 + hstep, voffB); PG8_STAGE(PG8_SA(1, 0), a3, voffA);
            PG8_WAIT_V(8); PG8_WAIT_L(0); PG8_BAR; PG8_MMA(1, 0, At, B0); PG8_MMA(1, 1, At, B1); PG8_BAR; PG8_SCHED;
            } else {
            PG8_LDB(B0, 0, 0); PG8_SCHED; PG8_LDA(At, 0, 0); PG8_STAGE(PG8_SA(1, 1), a1 + hstep, voffA);
            PG8_WAIT_L(8); PG8_BAR; PG8_WAIT_L(0); PG8_MMA(0, 0, At, B0); PG8_BAR; PG8_SCHED;
            PG8_LDB(B1, 0, 1); PG8_STAGE(PG8_SB(0, 0), b2, voffB);
            PG8_BAR; PG8_WAIT_L(0); PG8_MMA(0, 1, At, B1); PG8_BAR;
            PG8_LDA(At, 0, 1); PG8_STAGE(PG8_SA(0, 0), a2, voffA);
            PG8_BAR; PG8_WAIT_L(0); PG8_MMA(1, 0, At, B0); PG8_BAR; PG8_SCHED;
            PG8_STAGE(PG8_SB(0, 1), b2 + hstep, voffB);
            PG8_WAIT_V(6); PG8_BAR; PG8_MMA(1, 1, At, B1); PG8_BAR;
            PG8_LDB(B0, 1, 0); PG8_SCHED; PG8_LDA(At, 1, 0); PG8_STAGE(PG8_SA(0, 1), a2 + hstep, voffA);
            PG8_WAIT_L(8); PG8_BAR; PG8_WAIT_L(0); PG8_MMA(0, 0, At, B0); PG8_BAR; PG8_SCHED;
            PG8_LDB(B1, 1, 1); PG8_STAGE(PG8_SB(1, 0), b3, voffB);
            PG8_BAR; PG8_WAIT_L(0); PG8_MMA(0, 1, At, B1); PG8_BAR;
            PG8_LDA(At, 1, 1); PG8_STAGE(PG8_SA(1, 0), a3, voffA);
            PG8_BAR; PG8_WAIT_L(0); PG8_MMA(1, 0, At, B0); PG8_BAR; PG8_SCHED;
            PG8_STAGE(PG8_SB(1, 1), b3 + hstep, voffB);
            PG8_WAIT_V(6); PG8_BAR; PG8_MMA(1, 1, At, B1); PG8_BAR;
            }
        }
        if constexpr (ALIGN_EPI) { if (wr == 0) PG8_BAR; }
        if constexpr (!Epi::AFTER_DRAIN) { E(acc, cur, wr, wc, fr, fq); S.done(cur); }
        if (!has_next) break;
#pragma unroll
        for (int a = 0; a < 2; ++a)
#pragma unroll
            for (int b = 0; b < 2; ++b)
#pragma unroll
                for (int m = 0; m < 4; ++m)
#pragma unroll
                    for (int n = 0; n < 2; ++n) acc[a][b][m][n] = (f32x4){0.f, 0.f, 0.f, 0.f};
        cur = nxt; cA = nA; cB = nB; ++ui;
        if constexpr (ALIGN_EPI) { if (wr == 1) PG8_BAR; }
    }
    PG8_WAIT_V(0);
    if constexpr (!ALIGN_EPI) { if (wr == 0) PG8_BAR; }
    PG8_BAR;
    if constexpr (Epi::AFTER_DRAIN) { E.fused(acc, cur, wr, wc, fr, fq, lds, wid, lane); S.done(cur); }
#undef PG8_SA
#undef PG8_SB
#undef PG8_STAGE
#undef PG8_LDA
#undef PG8_LDB
#undef PG8_MMA
#undef PG8_WAIT_V
#undef PG8_WAIT_L
#undef PG8_BAR
#undef PG8_SCHED
}
}
#define GAS __attribute__((address_space(1)))
#define LAS __attribute__((address_space(3)))
typedef unsigned short bf16;
typedef unsigned v4u __attribute__((ext_vector_type(4)));
typedef float f32x4 __attribute__((ext_vector_type(4)));
typedef short bf16x8 __attribute__((ext_vector_type(8)));
typedef GAS unsigned gu32;
typedef GAS unsigned long long gu64;
#define RLX_AGENT __ATOMIC_RELAXED, __HIP_MEMORY_SCOPE_AGENT
#define LDS_WAIT() asm volatile("s_waitcnt lgkmcnt(0)" ::: "memory")
#define VM_WAIT() asm volatile("s_waitcnt vmcnt(0)" ::: "memory")
__device__ __forceinline__ unsigned long long rt() { return __builtin_amdgcn_s_memrealtime(); }
__device__ __forceinline__ unsigned f2bf(float f) { unsigned u = __builtin_bit_cast(unsigned, f); return (u + 0x7fffu + ((u >> 16) & 1u)) >> 16; }
__device__ __forceinline__ unsigned pk2(float lo, float hi) { return f2bf(lo) | (f2bf(hi) << 16); }

#define XB_TMO      128
#define XB_XCNT(j)  (256  + 64 * (j))
#define XB_XSUB(j)  (1280 + 64 * (j))
#define XB_XGEN(j)  (2304 + 64 * (j))
#define XB_TOP      3328
#define XB_TOPGEN   3392
#define XCD_BAR_WORDS 3456
#define XB_SPIN_CAP (1u << 22)

__device__ __forceinline__ unsigned xb_ld(unsigned* p)              { return __hip_atomic_load(p, __ATOMIC_RELAXED, __HIP_MEMORY_SCOPE_AGENT); }
__device__ __forceinline__ unsigned xb_add(unsigned* p, unsigned v) { return __hip_atomic_fetch_add(p, v, __ATOMIC_RELAXED, __HIP_MEMORY_SCOPE_AGENT); }
__device__ __forceinline__ unsigned xb_xcc_id() { return (unsigned)__builtin_amdgcn_s_getreg((3 << 11) | 20) & 0xFu; }
#define XB_SPIN(cond, bar) do { unsigned _sp = 0; while (cond) { __builtin_amdgcn_s_sleep(1); \
    if ((++_sp & 255u) == 0u) { if (xb_ld(&(bar)[XB_TMO])) break; if (_sp > XB_SPIN_CAP) { atomicAdd(&(bar)[XB_TMO], 1u); break; } } } } while (0)

struct XcdBarrier {
    unsigned* bar; unsigned x;
    volatile LAS unsigned* st;
};

__device__ __forceinline__ XcdBarrier xcd_barrier_post(unsigned* bar, volatile LAS unsigned* st) {
    XcdBarrier b; b.bar = bar; b.x = xb_xcc_id(); b.st = st;
    if (threadIdx.x == 0) (void)xb_add(&bar[XB_XCNT(b.x)], 1u);
    return b;
}
__device__ __forceinline__ void xcd_barrier_complete(unsigned* bar, unsigned x, unsigned& nloc, unsigned& nx) {
    const unsigned G = gridDim.x * gridDim.y * gridDim.z;
    unsigned sum, cnt, mine, sp = 0u;
    for (;;) {
        sum = 0u; cnt = 0u; mine = 0u;
#pragma unroll
        for (unsigned j = 0; j < 16; ++j) { const unsigned c = xb_ld(&bar[XB_XCNT(j)]); sum += c; cnt += (c > 0u) ? 1u : 0u; mine = (j == x) ? c : mine; }
        if (sum == G) break;
        __builtin_amdgcn_s_sleep(1);
        if ((++sp & 255u) == 0u) { if (xb_ld(&bar[XB_TMO])) break; if (sp > XB_SPIN_CAP) { atomicAdd(&bar[XB_TMO], 1u); break; } }
    }
    nloc = mine > 0u ? mine : 1u; nx = cnt > 0u ? cnt : 1u;
}

__device__ __forceinline__ void xcd_barrier(const XcdBarrier& b) {
    asm volatile("s_waitcnt vmcnt(0)" ::: "memory");
    __syncthreads();
    if (threadIdx.x == 0) {
        unsigned* bar = b.bar;
        __builtin_amdgcn_s_waitcnt(0);
        unsigned nloc = b.st[0], nx = b.st[1];
        if (nloc == 0u) { xcd_barrier_complete(bar, b.x, nloc, nx); b.st[0] = nloc; b.st[1] = nx; }
        const unsigned old = xb_add(&bar[XB_XSUB(b.x)], 1u);
        const unsigned gen = old / nloc;
        if (old + 1u == (gen + 1u) * nloc) {
            __builtin_amdgcn_fence(__ATOMIC_RELEASE, "agent");
            asm volatile("s_waitcnt vmcnt(0)" ::: "memory");
            const unsigned og = xb_add(&bar[XB_TOP], 1u);
            const unsigned tg = og / nx;
            if (og + 1u == (tg + 1u) * nx) xb_add(&bar[XB_TOPGEN], 1u);
            else XB_SPIN(xb_ld(&bar[XB_TOPGEN]) == tg, bar);
            __builtin_amdgcn_fence(__ATOMIC_ACQUIRE, "agent");
            xb_add(&bar[XB_XGEN(b.x)], 1u);
            asm volatile("s_waitcnt vmcnt(0)" ::: "memory");
        } else {
            XB_SPIN(xb_ld(&bar[XB_XGEN(b.x)]) == gen, bar);
            __builtin_amdgcn_fence(__ATOMIC_ACQUIRE, "agent");
            asm volatile("s_waitcnt vmcnt(0)" ::: "memory");
        }
    }
    __syncthreads();
}

typedef unsigned u32x4 __attribute__((ext_vector_type(4)));
typedef unsigned u32x2 __attribute__((ext_vector_type(2)));
typedef short s16x4 __attribute__((ext_vector_type(4)));
typedef float f32x2t __attribute__((ext_vector_type(2)));
typedef __bf16 bf16x2t __attribute__((ext_vector_type(2)));
#define DI __device__ __forceinline__
DI unsigned cvtpk(float lo, float hi) { f32x2t v = {lo, hi}; bf16x2t b = __builtin_convertvector(v, bf16x2t); return __builtin_bit_cast(unsigned, b); }
DI float bflo(unsigned w) { return __uint_as_float(w << 16); }
DI float bfhi(unsigned w) { return __uint_as_float(w & 0xffff0000u); }
DI s16x4 tr_read(LAS unsigned char* p) { return __builtin_bit_cast(s16x4, __builtin_amdgcn_ds_read_tr16_b64_v4i16((LAS s16x4*)p)); }
DI bf16x8 cat8(s16x4 lo, s16x4 hi) { return (bf16x8){lo[0], lo[1], lo[2], lo[3], hi[0], hi[1], hi[2], hi[3]}; }
DI int fresh_tid(int wave_id) { unsigned ones = ~0u; asm volatile("" : "+s"(ones)); int t = wave_id * 64 + (int)__builtin_amdgcn_mbcnt_hi(ones, __builtin_amdgcn_mbcnt_lo(ones, 0u)); asm volatile("" : "+v"(t)); return t; }
#define MFMA16(a, b, c) __builtin_amdgcn_mfma_f32_16x16x32_bf16((a), (b), (c), 0, 0, 0)
DI float wave_sum(float v) {
#pragma unroll
    for (int o = 1; o < 64; o <<= 1) v += __shfl_xor(v, o);
    return v;
}

struct Frame {
    LAS unsigned char* lds;
    volatile LAS unsigned* MISC;
    gu32* ctl;
    int G, wave_id;
    unsigned char* ws;
    const float* const* in;
};

DI int perm_pairs(int p, int half) {
    const int g = p >> 3, r = p & 7; return (r < 4) ? 4 * g + r : half + 4 * g + (r - 4);
}
DI int inmap(int np) {
    if (np < 1024) { const int head = np >> 7, p = np & 127; return head * 128 + (p < 32 ? perm_pairs(p, 16) : p); }
    if (np < 1280) { const int c = np - 1024; if (c < 128) return 1024 + (c < 32 ? perm_pairs(c, 16) : c); return 1152 + (c - 128); }
    if (np < 2304) { const int q = np - 1280, head = q >> 6, p = q & 63; return 1280 + head * 64 + (p < 16 ? perm_pairs(p, 8) : p); }
    if (np < 2560) { const int c = np - 2304; if (c < 64) return 2304 + (c < 16 ? perm_pairs(c, 8) : c); if (c < 80) return 2368 + (c - 64); return -1; }
    if (np < 3584) { const int q = np - 2560, which = q >> 9, qq = q & 511, head = qq >> 6, p = qq & 63; return (which ? 2896 : 2384) + head * 64 + perm_pairs(p, 32); }
    if (np < 4608) return 3408 + (np - 3584);
    return 4432 + (np - 4608);
}
template <bool INMAP, bool OUT8 = false>
DI void transpose_item(const float* W, int K, int N, int NP, bf16* WT, const float* gain, LAS float* scr, int item, int lane) {
    const int nblk = NP / 64, kb = item / nblk, nb = item % nblk, k0 = 64 * kb, n0 = 64 * nb;
    const int kr = lane >> 4, nq = lane & 15;
    const int np = n0 + 4 * nq; const int L = INMAP ? inmap(np) : np;
    f32x4 v[16];
#pragma unroll
    for (int i = 0; i < 16; ++i) { v[i] = (f32x4){0.f, 0.f, 0.f, 0.f}; if (L >= 0) v[i] = *(const GAS f32x4*)(W + (size_t)(k0 + 4 * i + kr) * N + L); }
#pragma unroll
    for (int i = 0; i < 16; ++i) { const int kk = 4 * i + kr; f32x4 t = v[i]; if (gain) t = t * gain[k0 + kk]; *(LAS f32x4*)(scr + kk * 68 + 4 * nq) = t; }
    LDS_WAIT(); asm volatile("" ::: "memory");
    const int c = lane & 7;
#pragma unroll
    for (int j = 0; j < 8; ++j) { const int n = (lane >> 3) + 8 * j; const LAS float* s = scr + (8 * c) * 68 + n;
        if constexpr (OUT8) { unsigned w0 = 0u, w1 = 0u;
            w0 = __builtin_amdgcn_cvt_pk_fp8_f32(s[0 * 68] * W2_SCALE, s[1 * 68] * W2_SCALE, w0, false); w0 = __builtin_amdgcn_cvt_pk_fp8_f32(s[2 * 68] * W2_SCALE, s[3 * 68] * W2_SCALE, w0, true);
            w1 = __builtin_amdgcn_cvt_pk_fp8_f32(s[4 * 68] * W2_SCALE, s[5 * 68] * W2_SCALE, w1, false); w1 = __builtin_amdgcn_cvt_pk_fp8_f32(s[6 * 68] * W2_SCALE, s[7 * 68] * W2_SCALE, w1, true);
            *(GAS u32x2*)((unsigned char*)WT + (size_t)(n0 + n) * K + k0 + 8 * c) = (u32x2){w0, w1}; }
        else { v4u o; o.x = pk2(s[0 * 68], s[1 * 68]); o.y = pk2(s[2 * 68], s[3 * 68]); o.z = pk2(s[4 * 68], s[5 * 68]); o.w = pk2(s[6 * 68], s[7 * 68]);
            *(GAS v4u*)(WT + (size_t)(n0 + n) * K + k0 + 8 * c) = o; } }
    LDS_WAIT(); asm volatile("" ::: "memory");
}
DI void sincos_rr(float x, float& s, float& c) {
    const float k = rintf(x * 0.15915494309189535f);
    float r = fmaf(-k, 6.28318548202514648f, x); r = fmaf(-k, -1.74845553e-7f, r);
    const float f = r * 0.15915494309189535f;
    s = __builtin_amdgcn_sinf(f); c = __builtin_amdgcn_cosf(f);
}

DI void p0_prologue(Frame& F, const float* x, const int* positions, const float* w_in, const float* w_out, const float* w_ff1, const float* w_ff2, const float* w_ple, const float* w_gate,
                    const float* pre_mix, const float* pre_ff) {
    const int tid = fresh_tid(F.wave_id), lane = tid & 63, wave = __builtin_amdgcn_readfirstlane(tid >> 6);
    LAS float* scr = (LAS float*)(F.lds + RING_OFF + wave * 17408);
    const int gw = blockIdx.x * NWAVES + wave, NGW = F.G * NWAVES;
    constexpr int I_IN = (DM / 64) * (NINP / 64), I_OUT = (DM / 64) * (DM / 64), I_FF1 = (DM / 64) * (DFF / 64), I_FF2 = (DFF / 64) * (DM / 64), I_PLE = (PLE / 64) * (DM / 64), I_GATE = I_OUT;
    static_assert(NWAVES * 17408 <= RING_BYTES, "prologue LDS");
    constexpr int PER_LAYER = I_IN + I_OUT + I_FF1 + I_FF2 + I_PLE + I_GATE;
    for (int it = gw; it < DEPTH * PER_LAYER; it += NGW) {
        const int l = it / PER_LAYER; int r = it % PER_LAYER;
        unsigned char* wl = F.ws + WS_W + (size_t)l * W_LAYER;
        if (r < I_IN)  { transpose_item<true >(w_in  + (size_t)l * DM * NINL, DM, NINL, NINP, (bf16*)(wl + WO_IN),  pre_mix + l * DM, scr, r, lane); continue; } r -= I_IN;
        if (r < I_OUT) { transpose_item<false>(w_out + (size_t)l * DM * DM,   DM, DM,  DM,    (bf16*)(wl + WO_OUT), nullptr,          scr, r, lane); continue; } r -= I_OUT;
        if (r < I_FF1) { transpose_item<false>(w_ff1 + (size_t)l * DM * DFF,  DM, DFF, DFF,   (bf16*)(wl + WO_FF1), pre_ff + l * DM,  scr, r, lane); continue; } r -= I_FF1;
        if (r < I_FF2) { transpose_item<false, true>(w_ff2 + (size_t)l * DFF * DM,  DFF, DM, DM,    (bf16*)(wl + WO_FF2), nullptr,          scr, r, lane); continue; } r -= I_FF2;
        if (r < I_PLE) { transpose_item<false>(w_ple + (size_t)l * PLE * DM,  PLE, DM, DM,    (bf16*)(wl + WO_PLE), nullptr,          scr, r, lane); continue; } r -= I_PLE;
        transpose_item<false>(w_gate + (size_t)l * DM * DM, DM, DM, DM, (bf16*)(wl + WO_GATE), nullptr, scr, r, lane);
    }
    float* rope = (float*)(F.ws + WS_ROPE);
    for (int e = blockIdx.x * (NWAVES * 64) + tid; e < M * 56; e += F.G * NWAVES * 64) {
        const int m = e / 56, i = e % 56; const float pos = (float)positions[m];
        float inv; int co, so;
        if (i < 16)      { inv = __builtin_amdgcn_exp2f(-(float)i * (1.0f / 16.0f) * LOG2_THETA_A);        co = i;             so = 16 + i; }
        else if (i < 24) { inv = __builtin_amdgcn_exp2f(-(float)(i - 16) * (1.0f / 8.0f) * LOG2_THETA_A);  co = 32 + (i - 16); so = 40 + (i - 16); }
        else             { inv = __builtin_amdgcn_exp2f(-(float)(i - 24) * (1.0f / 32.0f) * LOG2_THETA_R); co = 48 + (i - 24); so = 80 + (i - 24); }
        float s, c; sincos_rr(pos * inv, s, c);
        rope[(size_t)m * ROPE_W + co] = c; rope[(size_t)m * ROPE_W + so] = s;
    }
    bf16* HB = (bf16*)(F.ws + WS_HB); float* RS = (float*)(F.ws + WS_RS);
    for (int row = gw; row < M; row += NGW) {
        const GAS f32x4* xr = (const GAS f32x4*)(x + (size_t)row * DM) + lane; GAS u32x2* hb = (GAS u32x2*)(HB + (size_t)row * DM) + lane; float ss = 0.f;
#pragma unroll
        for (int j = 0; j < 8; ++j) { const f32x4 v = xr[64 * j]; ss += (v.x * v.x + v.y * v.y) + (v.z * v.z + v.w * v.w); u32x2 o; o.x = cvtpk(v.x, v.y); o.y = cvtpk(v.z, v.w); hb[64 * j] = o; }
        ss = wave_sum(ss);
        if (lane == 0) RS[row] = 1.0f / sqrtf(ss * (1.0f / DM) + RMS_EPS);
    }
}

DI void thin_phase(Frame& F, float* fout, const float* wpost, const float* pconv) {
    const int tid = fresh_tid(F.wave_id), lane = tid & 63, wave = __builtin_amdgcn_readfirstlane(tid >> 6);
    const int gw = blockIdx.x * NWAVES + wave, NGW = F.G * NWAVES;
    const bf16* Y = (const bf16*)(F.ws + WS_Y); const float* SS = (const float*)(F.ws + WS_SS); bf16* HB = (bf16*)(F.ws + WS_HB); float* RS = (float*)(F.ws + WS_RS);
    bf16* PB = (bf16*)(F.ws + WS_BIG + BO_PB);
    f32x4 w[8];
#pragma unroll
    for (int j = 0; j < 8; ++j) w[j] = *((const GAS f32x4*)wpost + lane + 64 * j);
    for (int row = gw; row < M; row += NGW) {
        float q = (lane < 32) ? SS[(size_t)row * 32 + lane] : 0.f; q = wave_sum(q);
        const float rstd = 1.0f / sqrtf(q * (1.0f / DM) + RMS_EPS);
        const GAS u32x2* yr = (const GAS u32x2*)(Y + (size_t)row * DM) + lane; GAS u32x2* hb = (GAS u32x2*)(HB + (size_t)row * DM) + lane; float ss = 0.f;
        u32x2 hv[8], yv[8];
#pragma unroll
        for (int j = 0; j < 8; ++j) { hv[j] = hb[64 * j]; yv[j] = yr[64 * j]; }
#pragma unroll
        for (int j = 0; j < 8; ++j) { f32x4 h;
            h.x = bflo(hv[j].x) + bflo(yv[j].x) * rstd * w[j].x; h.y = bfhi(hv[j].x) + bfhi(yv[j].x) * rstd * w[j].y; h.z = bflo(hv[j].y) + bflo(yv[j].y) * rstd * w[j].z; h.w = bfhi(hv[j].y) + bfhi(yv[j].y) * rstd * w[j].w;
            if (fout) { *((GAS f32x4*)(fout + (size_t)row * DM) + lane + 64 * j) = h; }
            else { u32x2 o; o.x = cvtpk(h.x, h.y); o.y = cvtpk(h.z, h.w); hb[64 * j] = o;
                   const float rx = bflo(o.x), ry = bfhi(o.x), rz = bflo(o.y), rw = bfhi(o.y); ss += (rx * rx + ry * ry) + (rz * rz + rw * rw); } }
        if (!fout) { ss = wave_sum(ss); if (lane == 0) RS[row] = 1.0f / sqrtf(ss * (1.0f / DM) + RMS_EPS); }
        if (pconv) { const f32x4 pv = *((const GAS f32x4*)(pconv + (size_t)row * PLE) + lane); u32x2 o; o.x = cvtpk(pv.x, pv.y); o.y = cvtpk(pv.z, pv.w); *((GAS u32x2*)(PB + (size_t)row * PLE) + lane) = o; }
    }
}

constexpr int ATT_WL = 16384 + 512;
constexpr int RET_KST = 144, RET_VST = 288, RET_K = 0, RET_V = 128 * RET_KST, RET_R = RET_V + 128 * RET_VST, RET_BYTES = RET_R + 128 * RET_KST;
static_assert(NWAVES * ATT_WL <= RING_BYTES && RET_BYTES <= RING_BYTES, "mixer LDS");
constexpr int N_RET_ITEMS = BATCH * 8, N_ATT_ITEMS = BATCH * (SEQ / NWAVES), N_MIX_ITEMS = N_RET_ITEMS + N_ATT_ITEMS;

DI void dma16(const void* g, LAS unsigned char* l) { __builtin_amdgcn_global_load_lds((const unsigned*)g, (LAS unsigned*)l, 16, 0, 0); }
#define VMW(n) asm volatile("s_waitcnt vmcnt(" #n ")" ::: "memory")
#ifndef PROF_SEC
#define PROF_SEC 0
#endif
#define PROF_T() ((unsigned)__builtin_amdgcn_s_memrealtime())
#define PROF_BEGIN(k) unsigned pt_##k = 0; if (PROF_SEC == (k)) pt_##k = PROF_T();
#define PROF_END(k) if (PROF_SEC == (k)) pacc += PROF_T() - pt_##k;
DI void attn_item(LAS unsigned char* ring, unsigned char* ws, int b, int t0, int lane, int wave, unsigned& pacc) {
    const int g = lane >> 4, c = lane & 15;
    const int t = t0 + wave;
    LAS unsigned char* wl = ring + wave * 16384;
    const bf16* AQ = (const bf16*)(ws + WS_BIG + BO_AQ); const bf16* AKV = (const bf16*)(ws + WS_BIG + BO_AKV); const bf16* IQ = (const bf16*)(ws + WS_BIG + BO_IQ);
    const bf16* IK = (const bf16*)(ws + WS_BIG + BO_IK); const float* IW = (const float*)(ws + WS_BIG + BO_IW); bf16* MIX = (bf16*)(ws + WS_BIG + BO_MIX);
    const size_t m = (size_t)b * SEQ + t; const size_t brow = (size_t)b * SEQ;
    LAS unsigned short* idx = (LAS unsigned short*)(ring + 131072 + 512 * wave);
    const int nk = t + 1; int nsel;
    if (t0 >= 256) {
        PROF_BEGIN(1)
        const bf16* iqp = IQ + m * 1024 + c * 64 + 8 * g;
        const bf16x8 a0 = *(const bf16x8*)iqp, a1 = *(const bf16x8*)(iqp + 32);
        const f32x4 w4 = *(const f32x4*)(IW + m * 16 + 4 * g);
        u32x4 wfu; wfu.x = cvtpk(w4.x, w4.y); wfu.y = cvtpk(w4.z, w4.w); wfu.z = 0u; wfu.w = 0u;
        const bf16x8 wfrag = __builtin_bit_cast(bf16x8, wfu); const bf16x8 zfrag = (bf16x8){0, 0, 0, 0, 0, 0, 0, 0};
        asm volatile("s_waitcnt vmcnt(0)" :: "v"(a0), "v"(a1), "v"(wfrag) : "memory");
        const int nchunk = (t0 + 8 + 255) >> 8;
        const int r8 = lane >> 3, s8 = lane & 7;
#define ISSUE_IK(k) do { _Pragma("unroll") for (int i_ = 0; i_ < 4; ++i_) { const int row_ = 32 * wave + 8 * i_; \
            dma16(IK + (brow + 256 * (k) + row_ + r8) * 64 + 8 * (s8 ^ (((row_ + r8) >> 1) & 7)), ring + ((k) & 3) * 32768 + 128 * row_); } } while (0)
#pragma unroll
        for (int k = 0; k < 3; ++k) if (k < nchunk) ISSUE_IK(k);
        unsigned u[32];
#pragma unroll
        for (int k = 0; k < 8; ++k) {
            f32x4 d2 = {0.f, 0.f, 0.f, 0.f};
            if (k < nchunk) {
                const int ahead = nchunk - 1 - k;
                if (ahead >= 2) VMW(8); else if (ahead == 1) VMW(4); else VMW(0);
                __builtin_amdgcn_s_barrier();
                asm volatile("" ::: "memory");
                if (k + 3 < nchunk) ISSUE_IK(k + 3);
                int cc = c; asm volatile("" : "+v"(cc));
                const LAS unsigned char* kbase = ring + (k & 3) * 32768 + 128 * cc;
#pragma unroll
                for (int j = 0; j < 16; ++j) {
                    if (256 * k + 16 * j <= t0 + 7) {
                        const LAS unsigned char* kp = kbase + 2048 * j;
                        const int sw = ((16 * j + cc) >> 1) & 7;
                        const bf16x8 kb0 = *(const LAS bf16x8*)(kp + 16 * (g ^ sw)), kb1 = *(const LAS bf16x8*)(kp + 16 * ((4 + g) ^ sw));
                        f32x4 d = {0.f, 0.f, 0.f, 0.f};
                        d = MFMA16(a0, kb0, d); d = MFMA16(a1, kb1, d);
                        u32x4 ru; ru.x = cvtpk(fmaxf(d.x, 0.f), fmaxf(d.y, 0.f)); ru.y = cvtpk(fmaxf(d.z, 0.f), fmaxf(d.w, 0.f)); ru.z = 0u; ru.w = 0u;
                        d2 = MFMA16((cc == j) ? wfrag : zfrag, __builtin_bit_cast(bf16x8, ru), d2);
                    }
                }
            }
#pragma unroll
            for (int r = 0; r < 4; ++r) { const int key = 256 * k + 16 * (4 * g + r) + c; const unsigned bb = __float_as_uint(d2[r]); const unsigned ok = (bb & 0x80000000u) ? ~bb : (bb | 0x80000000u); u[4 * k + r] = (key < nk) ? ok : 0u; }
        }
        asm volatile("s_waitcnt lgkmcnt(0)" ::: "memory");
        __builtin_amdgcn_s_barrier();
        asm volatile("" ::: "memory");
#undef ISSUE_IK
        PROF_END(1)
        PROF_BEGIN(2)
        unsigned T = 0u;
        for (int bit = 31; bit >= 0; --bit) {
            const unsigned cand = T | (1u << bit); int cnt = 0;
#pragma unroll
            for (int i = 0; i < 32; ++i) cnt += __popcll(__ballot(u[i] >= cand));
            if (cnt >= 256) T = cand;
            if (cnt == 256) break;
        }
        int cgt = 0;
#pragma unroll
        for (int i = 0; i < 32; ++i) cgt += __popcll(__ballot(u[i] > T));
        const int quota = 256 - cgt;
        const unsigned long long lt = (1ull << lane) - 1ull;
        int base = 0, eqrun = 0;
#pragma unroll
        for (int i = 0; i < 32; ++i) {
            const bool gt = u[i] > T, eq = u[i] == T;
            const unsigned long long meq = __ballot(eq);
            const int eqrank = eqrun + __popcll(meq & lt);
            const bool sel = gt || (eq && eqrank < quota);
            const unsigned long long ms = __ballot(sel);
            if (sel) idx[base + __popcll(ms & lt)] = (unsigned short)(256 * (i >> 2) + 16 * (4 * g + (i & 3)) + c);
            base += __popcll(ms); eqrun += __popcll(meq);
        }
        PROF_END(2)
        nsel = 256;
    } else {
#pragma unroll
        for (int r = 0; r < 4; ++r) { const int j = lane + 64 * r; idx[j] = (unsigned short)(j < nk ? j : 0); }
        nsel = nk;
    }
    LDS_WAIT(); __builtin_amdgcn_wave_barrier();
    PROF_BEGIN(3)
    int lane3 = lane; asm volatile("" : "+v"(lane3));
    const int G3 = lane3 >> 4, C3 = lane3 & 15;
    bf16x8 qf[4];
#pragma unroll
    for (int ks = 0; ks < 4; ++ks) { qf[ks] = (bf16x8){0, 0, 0, 0, 0, 0, 0, 0}; if (C3 < 8) qf[ks] = *(const bf16x8*)(AQ + m * 1024 + C3 * 128 + 32 * ks + 8 * G3); }
    asm volatile("s_waitcnt vmcnt(0)" :: "v"(qf[0]), "v"(qf[1]), "v"(qf[2]), "v"(qf[3]) : "memory");
    const int ntile = (nsel + 15) >> 4;
#define ISSUE_K(kt) do { const u32x2 iw_ = *(const LAS u32x2*)(idx + 16 * (kt) + 4 * G3); \
        _Pragma("unroll") for (int i_ = 0; i_ < 4; ++i_) { const int r_ = 4 * i_ + G3; const int key_ = (int)(((i_ & 2) ? iw_.y : iw_.x) >> (16 * (i_ & 1))) & 0xffff; \
        dma16(AKV + (brow + key_) * 256 + 8 * (C3 ^ r_), wl + ((kt) & 3) * 4096 + 1024 * i_); } } while (0)
#pragma unroll
    for (int kt = 0; kt < 4; ++kt) if (kt < ntile) ISSUE_K(kt);
    f32x4 s[16];
#pragma unroll
    for (int kt = 0; kt < 16; ++kt) {
        s[kt] = (f32x4){-INFINITY, -INFINITY, -INFINITY, -INFINITY};
        if (kt < ntile) {
            const int ahead = ntile - 1 - kt;
            if (ahead >= 3) VMW(12); else if (ahead == 2) VMW(8); else if (ahead == 1) VMW(4); else VMW(0);
            const LAS unsigned char* kp = wl + (kt & 3) * 4096 + 256 * C3;
            bf16x8 ka[4];
#pragma unroll
            for (int ks = 0; ks < 4; ++ks) ka[ks] = *(const LAS bf16x8*)(kp + 16 * ((4 * ks + G3) ^ C3));
            f32x4 d = {0.f, 0.f, 0.f, 0.f};
#pragma unroll
            for (int ks = 0; ks < 4; ++ks) d = MFMA16(ka[ks], qf[ks], d);
#pragma unroll
            for (int r = 0; r < 4; ++r) s[kt][r] = (16 * kt + 4 * r + G3 < nsel) ? d[r] : -INFINITY;
            asm volatile("" :: "v"(d) : "memory");
            if (kt + 4 < ntile) ISSUE_K(kt + 4);
        }
    }
    const int nstep = (nsel + 31) >> 5;
#define ISSUE_V(st) do { const u32x2 ia_ = *(const LAS u32x2*)(idx + 32 * (st) + 4 * G3), ib_ = *(const LAS u32x2*)(idx + 32 * (st) + 16 + 4 * G3); \
        _Pragma("unroll") for (int i_ = 0; i_ < 8; ++i_) { const int r_ = 4 * i_ + G3; const u32x2 iw_ = (i_ & 4) ? ib_ : ia_; const int key_ = (int)(((i_ & 2) ? iw_.y : iw_.x) >> (16 * (i_ & 1))) & 0xffff; \
        dma16(AKV + (brow + key_) * 256 + 128 + 8 * (C3 ^ (2 * (r_ & 7))), wl + ((st) & 1) * 8192 + 1024 * i_); } } while (0)
    ISSUE_V(0);
    if (nstep > 1) ISSUE_V(1);
    float mx = -INFINITY;
#pragma unroll
    for (int kt = 0; kt < 16; ++kt) mx = fmaxf(fmaxf(mx, fmaxf(s[kt][0], s[kt][1])), fmaxf(s[kt][2], s[kt][3]));
    mx = fmaxf(mx, __shfl_xor(mx, 16)); mx = fmaxf(mx, __shfl_xor(mx, 32));
    float l = 0.f;
#pragma unroll
    for (int kt = 0; kt < 16; ++kt)
#pragma unroll
        for (int r = 0; r < 4; ++r) { const float p = __builtin_amdgcn_exp2f(s[kt][r] - mx); s[kt][r] = p; l += p; }
    l += __shfl_xor(l, 16); l += __shfl_xor(l, 32);
    const float inv = 1.0f / l;
    f32x4 o[8];
#pragma unroll
    for (int dt = 0; dt < 8; ++dt) o[dt] = (f32x4){0.f, 0.f, 0.f, 0.f};
    const int q4 = C3 >> 2, p4 = C3 & 3, r0 = 4 * G3 + q4;
#pragma unroll
    for (int st = 0; st < 8; ++st) {
        if (st < nstep) {
            if (st + 1 < nstep) VMW(8); else VMW(0);
            u32x4 pw; pw.x = cvtpk(s[2 * st][0], s[2 * st][1]); pw.y = cvtpk(s[2 * st][2], s[2 * st][3]); pw.z = cvtpk(s[2 * st + 1][0], s[2 * st + 1][1]); pw.w = cvtpk(s[2 * st + 1][2], s[2 * st + 1][3]);
            const bf16x8 pb = __builtin_bit_cast(bf16x8, pw);
            const unsigned vb = (unsigned)(uintptr_t)(wl + (st & 1) * 8192 + 256 * r0 + 8 * (p4 & 1));
            s16x4 lo[8], hi[8];
#pragma unroll
            for (int dt = 0; dt < 8; ++dt) {
                const unsigned pos = vb + 16 * ((2 * dt + (p4 >> 1)) ^ (2 * (r0 & 7)));
                asm volatile("ds_read_b64_tr_b16 %0, %1" : "=&v"(lo[dt]) : "v"(pos) : "memory");
                asm volatile("ds_read_b64_tr_b16 %0, %1 offset:4096" : "=&v"(hi[dt]) : "v"(pos) : "memory");
            }
            asm volatile("s_waitcnt lgkmcnt(0)" : "+v"(lo[0]), "+v"(lo[1]), "+v"(lo[2]), "+v"(lo[3]), "+v"(lo[4]), "+v"(lo[5]), "+v"(lo[6]), "+v"(lo[7]),
                                                  "+v"(hi[0]), "+v"(hi[1]), "+v"(hi[2]), "+v"(hi[3]), "+v"(hi[4]), "+v"(hi[5]), "+v"(hi[6]), "+v"(hi[7]) :: "memory");
#pragma unroll
            for (int dt = 0; dt < 8; ++dt) o[dt] = MFMA16(cat8(lo[dt], hi[dt]), pb, o[dt]);
            asm volatile("" :: "v"(o[7]) : "memory");
            if (st + 2 < nstep) ISSUE_V(st + 2);
        }
    }
    if (C3 < 8) {
        bf16* op = MIX + m * 2048 + C3 * 128 + 4 * G3;
#pragma unroll
        for (int dt = 0; dt < 8; ++dt) { u32x2 w; w.x = cvtpk(o[dt][0] * inv, o[dt][1] * inv); w.y = cvtpk(o[dt][2] * inv, o[dt][3] * inv); *(u32x2*)(op + 16 * dt) = w; }
    }
    PROF_END(3)
#undef ISSUE_K
#undef ISSUE_V
}

DI void ret_chain(Frame& F, int b, int h, const float* gn) {
    LAS unsigned char* lds = F.lds + RING_OFF; unsigned char* ws = F.ws;
    const bf16* RQ = (const bf16*)(ws + WS_BIG + BO_RQ); const bf16* RK = (const bf16*)(ws + WS_BIG + BO_RK); const bf16* RV = (const bf16*)(ws + WS_BIG + BO_RV);
    const bf16* RG = (const bf16*)(ws + WS_BIG + BO_RG); bf16* MIX = (bf16*)(ws + WS_BIG + BO_MIX);
    const int tid = fresh_tid(F.wave_id), lane = tid & 63, w = __builtin_amdgcn_readfirstlane(tid >> 6), g = lane >> 4, c = lane & 15, q4 = c >> 2, p4 = c & 3;
    const float lg = pg8::log2_gamma(h);
    const int i = 16 * w + c;
    const float xi = __builtin_amdgcn_exp2f((float)(i + 1) * lg), fi = __builtin_amdgcn_exp2f((float)(i - 127) * lg), gC = __builtin_amdgcn_exp2f(128.0f * lg);
    f32x4 RT[4];
#pragma unroll
    for (int dt = 0; dt < 4; ++dt) RT[dt] = (f32x4){0.f, 0.f, 0.f, 0.f};
    for (int ch = 0; ch < 16; ++ch) {
        const size_t row0 = (size_t)b * SEQ + 128 * ch;
        __syncthreads();
#pragma unroll
        for (int r = 0; r < 2; ++r) { const int row = (tid >> 3) + 64 * r, ck = tid & 7; *(LAS u32x4*)(lds + RET_K + row * RET_KST + 16 * ck) = *(const u32x4*)(RK + (row0 + row) * 512 + h * 64 + 8 * ck); }
#pragma unroll
        for (int r = 0; r < 4; ++r) { const int row = (tid >> 4) + 32 * r, ck = tid & 15; *(LAS u32x4*)(lds + RET_V + row * RET_VST + 16 * ck) = *(const u32x4*)(RV + (row0 + row) * 1024 + h * 128 + 8 * ck); }
#pragma unroll
        for (int dt = 0; dt < 4; ++dt)
#pragma unroll
            for (int r = 0; r < 4; ++r) *(LAS unsigned short*)(lds + RET_R + (16 * w + 4 * g + r) * RET_KST + 2 * (16 * dt + c)) = (unsigned short)f2bf(RT[dt][r]);
        __syncthreads();
        const bf16* qp = RQ + (row0 + i) * 512 + h * 64 + 8 * g;
        const bf16x8 qb0 = *(const bf16x8*)qp, qb1 = *(const bf16x8*)(qp + 32);
        f32x4 o[8];
#pragma unroll
        for (int vt = 0; vt < 8; ++vt) o[vt] = (f32x4){0.f, 0.f, 0.f, 0.f};
        if (ch > 0) {
#pragma unroll
            for (int vt = 0; vt < 8; ++vt) {
                const LAS unsigned char* rp = lds + RET_R + (16 * vt + c) * RET_KST + 16 * g;
                o[vt] = MFMA16(*(const LAS bf16x8*)rp, qb0, o[vt]); o[vt] = MFMA16(*(const LAS bf16x8*)(rp + 64), qb1, o[vt]);
            }
#pragma unroll
            for (int vt = 0; vt < 8; ++vt) o[vt] = o[vt] * xi;
        }
#pragma unroll
        for (int st = 0; st < 4; ++st) {
            if (2 * st <= w) {
                f32x4 d0 = {0.f, 0.f, 0.f, 0.f}, d1 = {0.f, 0.f, 0.f, 0.f};
                { const LAS unsigned char* kp = lds + RET_K + (32 * st + c) * RET_KST + 16 * g;
                  d0 = MFMA16(*(const LAS bf16x8*)kp, qb0, d0); d0 = MFMA16(*(const LAS bf16x8*)(kp + 64), qb1, d0);
                  d1 = MFMA16(*(const LAS bf16x8*)(kp + 16 * RET_KST), qb0, d1); d1 = MFMA16(*(const LAS bf16x8*)(kp + 16 * RET_KST + 64), qb1, d1); }
#pragma unroll
                for (int r = 0; r < 4; ++r) { const int j0 = 32 * st + 4 * g + r; d0[r] = (j0 <= i) ? d0[r] * fi : 0.f; d1[r] = (j0 + 16 <= i) ? d1[r] * fi : 0.f; }
                u32x4 pw; pw.x = cvtpk(d0[0], d0[1]); pw.y = cvtpk(d0[2], d0[3]); pw.z = cvtpk(d1[0], d1[1]); pw.w = cvtpk(d1[2], d1[3]);
                const bf16x8 pb = __builtin_bit_cast(bf16x8, pw);
                LAS unsigned char* vb = lds + RET_V + (32 * st + 4 * g + q4) * RET_VST + 8 * p4;
#pragma unroll
                for (int vt = 0; vt < 8; ++vt) {
                    const s16x4 lo = tr_read(vb + 32 * vt), hi = tr_read(vb + 16 * RET_VST + 32 * vt);
                    o[vt] = MFMA16(cat8(lo, hi), pb, o[vt]);
                }
            }
        }
        {
            float sm = 0.f;
#pragma unroll
            for (int vt = 0; vt < 8; ++vt) sm += (o[vt][0] + o[vt][1]) + (o[vt][2] + o[vt][3]);
            sm += __shfl_xor(sm, 16); sm += __shfl_xor(sm, 32);
            const float mu = sm * (1.0f / 128.0f); float vq = 0.f;
#pragma unroll
            for (int vt = 0; vt < 8; ++vt) { const f32x4 dd = o[vt] - mu; vq += (dd[0] * dd[0] + dd[1] * dd[1]) + (dd[2] * dd[2] + dd[3] * dd[3]); }
            vq += __shfl_xor(vq, 16); vq += __shfl_xor(vq, 32);
            const float rstd = 1.0f / sqrtf(vq * (1.0f / 128.0f) + GN_EPS);
            const size_t mrow = row0 + i;
#pragma unroll
            for (int vt = 0; vt < 8; ++vt) {
                const int v0 = h * 128 + 16 * vt + 4 * g;
                const f32x4 gw = *(const f32x4*)(gn + v0); const u32x2 gt = *(const u32x2*)(RG + mrow * 1024 + v0);
                const float y0 = (o[vt][0] - mu) * rstd * gw[0] * bflo(gt.x), y1 = (o[vt][1] - mu) * rstd * gw[1] * bfhi(gt.x), y2 = (o[vt][2] - mu) * rstd * gw[2] * bflo(gt.y), y3 = (o[vt][3] - mu) * rstd * gw[3] * bfhi(gt.y);
                u32x2 ow; ow.x = cvtpk(y0, y1); ow.y = cvtpk(y2, y3); *(u32x2*)(MIX + mrow * 2048 + 1024 + v0) = ow;
            }
        }
#pragma unroll
        for (int dt = 0; dt < 4; ++dt) RT[dt] = RT[dt] * gC;
#pragma unroll
        for (int st = 0; st < 4; ++st) {
            LAS unsigned char* vb = lds + RET_V + (32 * st + 8 * g + q4) * RET_VST + 32 * w + 8 * p4;
            const bf16x8 va = cat8(tr_read(vb), tr_read(vb + 4 * RET_VST));
            LAS unsigned char* kp = lds + RET_K + (32 * st + 8 * g + q4) * RET_KST + 8 * p4;
#pragma unroll
            for (int dt = 0; dt < 4; ++dt) { const bf16x8 kbf = cat8(tr_read(kp + 32 * dt), tr_read(kp + 4 * RET_KST + 32 * dt)); RT[dt] = MFMA16(va, kbf, RT[dt]); }
        }
    }
    __syncthreads();
}

constexpr int N_Q_ITEMS = 16 + 2 * (SEQ / NWAVES);
DI void mixer_phase(Frame& F, int lq, const float* gn) {
    const int tid = fresh_tid(F.wave_id), lane = tid & 63, wave = __builtin_amdgcn_readfirstlane(tid >> 6);
    unsigned pacc = 0;
    gu32* qbase = F.ctl + CW_Q + 64 * 8 * lq;
    int q = (int)(xb_xcc_id() & 7u);
    unsigned nxt = 0xffffffffu;
    if (tid == 0) nxt = __hip_atomic_fetch_add(qbase + 64 * q, 1u, __ATOMIC_RELAXED, __HIP_MEMORY_SCOPE_AGENT);
    for (;;) {
        if (tid == 0) {
            for (int tries = 0; nxt >= (unsigned)N_Q_ITEMS && tries < 8; ++tries) { q = (q + 1) & 7;
                if (__hip_atomic_load(qbase + 64 * q, __ATOMIC_RELAXED, __HIP_MEMORY_SCOPE_AGENT) < (unsigned)N_Q_ITEMS) nxt = __hip_atomic_fetch_add(qbase + 64 * q, 1u, __ATOMIC_RELAXED, __HIP_MEMORY_SCOPE_AGENT); }
            F.MISC[0] = nxt < (unsigned)N_Q_ITEMS ? nxt : 0xffffffffu; F.MISC[1] = (unsigned)q;
        }
        __syncthreads();
        const unsigned item = F.MISC[0]; const int qi = (int)F.MISC[1];
        __syncthreads();
        if (item == 0xffffffffu) break;
        if (tid == 0) nxt = __hip_atomic_fetch_add(qbase + 64 * q, 1u, __ATOMIC_RELAXED, __HIP_MEMORY_SCOPE_AGENT);
        if (item < 16u) { PROF_BEGIN(4) ret_chain(F, 2 * qi + (int)(item >> 3), (int)(item & 7u), gn); PROF_END(4) }
        else { const int ia = (int)item - 16; const int tb = (SEQ / NWAVES - 1) - (ia >> 1), b = 2 * qi + (ia & 1);
            PROF_BEGIN(5) attn_item(F.lds + RING_OFF, F.ws, b, tb * NWAVES, lane, wave, pacc); PROF_END(5) }
    }
    if (PROF_SEC != 0) { pacc = __builtin_amdgcn_readfirstlane(pacc); const unsigned t0 = PROF_T(); while (PROF_T() - t0 < pacc && pacc < 400000000u) __builtin_amdgcn_s_sleep(4); }
}

#ifndef MK_N_LAUNCHES
#define MK_N_LAUNCHES 1
#endif
constexpr int NPH = 1 + 10 * DEPTH;
constexpr int N_LAUNCHES = MK_N_LAUNCHES;
static_assert(N_LAUNCHES == 1 || N_LAUNCHES == NPH, "MK_N_LAUNCHES must be 1 or NPH");
struct Args { const void* in[15]; float* out; unsigned char* ws; int ph_lo, ph_hi, li, pad; };

__global__ void __launch_bounds__(NWAVES * 64, 2) hyb_fwd(Args args) {
    extern __shared__ __attribute__((aligned(16))) unsigned char lds[];
    Frame F;
    F.lds = (LAS unsigned char*)lds;
    F.MISC = (volatile LAS unsigned*)(F.lds + MISC_OFF);
    F.wave_id = __builtin_amdgcn_readfirstlane((int)(threadIdx.x >> 6));
    F.G = gridDim.x; F.ws = args.ws; F.ctl = (gu32*)(args.ws + WS_CTL); F.in = nullptr;
    for (int u = threadIdx.x; u < (LDS_BYTES - LDSCTL_OFF) / 4; u += NWAVES * 64) ((LAS unsigned*)(F.lds + LDSCTL_OFF))[u] = 0u;
    __syncthreads();
    XcdBarrier bar; bar.bar = (unsigned*)(F.ctl + CW_BAR); bar.x = 0; bar.st = nullptr;
    if (N_LAUNCHES == 1) bar = xcd_barrier_post((unsigned*)(F.ctl + CW_BAR), F.MISC + 8);
    const int lo = args.ph_lo, hi = args.ph_hi;
#ifndef PHASE_MASK
#define PHASE_MASK 0x7ff
#endif
#define PON(j) (((PHASE_MASK) >> (j)) & 1)
#ifndef PROBE_DUP
#define PROBE_DUP 0
#endif
#define DUPN(j) (1 + (((PROBE_DUP) >> (j)) & 1))
#define IN(k) (lo <= (k) && (k) < hi)
#ifndef PROF_PHASE
#define PROF_PHASE 0
#endif
    unsigned pp_acc = 0, pp_t0 = 0;
#define PP_ON(j) ((((PROF_PHASE) >> (j)) & 1) != 0)
#define PP_BEGIN(j) do { if (PP_ON(j)) pp_t0 = (unsigned)__builtin_amdgcn_s_memrealtime(); } while (0)
#define PP_END(j) do { if (PP_ON(j)) pp_acc += (unsigned)__builtin_amdgcn_s_memrealtime() - pp_t0; } while (0)
#define SEAM(k) do { if (N_LAUNCHES == 1 && IN(k) && IN((k) + 1)) xcd_barrier(bar); } while (0)
    volatile LAS unsigned long long* PT = (volatile LAS unsigned long long*)(F.lds + LDSCTL_OFF + 1024);
    if (threadIdx.x < 15) PT[threadIdx.x] = (unsigned long long)(uintptr_t)args.in[threadIdx.x];
    if (threadIdx.x == 15) PT[15] = (unsigned long long)(uintptr_t)args.out;
    if (threadIdx.x == 16) PT[16] = (unsigned long long)(uintptr_t)args.ws;
    __syncthreads();
#define LDP(k) ((const float*)(uintptr_t)(((unsigned long long)(unsigned)__builtin_amdgcn_readfirstlane((int)(unsigned)(PT[k] >> 32)) << 32) | (unsigned long long)(unsigned)__builtin_amdgcn_readfirstlane((int)(unsigned)PT[k])))
#define WSP() ((unsigned char*)LDP(16))
    PP_BEGIN(0);
    if (PON(0) && IN(0)) for (int rep = 0; rep < DUPN(0); ++rep) p0_prologue(F, LDP(0), (const int*)LDP(2), LDP(3), LDP(4), LDP(5), LDP(6), LDP(7), LDP(8), LDP(9), LDP(11));
    SEAM(0); PP_END(0);
    for (int l = 0; l < DEPTH; ++l) {
        const int pb = 1 + 10 * l;
        PP_BEGIN(1);
        if (PON(1) && IN(pb + 0)) for (int rep = 0; rep < DUPN(1); ++rep) {
            unsigned char* ws = WSP(); unsigned char* wl = ws + WS_W + (size_t)l * W_LAYER; unsigned char* big = ws + WS_BIG;
            pg8::Gemm g{(const pg8::bf16_t*)(ws + WS_HB), (const pg8::bf16_t*)(wl + WO_IN), M, NINP, DM}; pg8::StaticOrder S; S.init(M, NINP, F.G, (int)blockIdx.x);
            pg8::EpiIn E{big, (const float*)(ws + WS_RS), (const float*)(ws + WS_ROPE)};
            pg8::gemm_phase<pg8::EpiIn, pg8::StaticOrder, true, true>(F.lds + RING_OFF, g, S, E, F.wave_id);
        }
        SEAM(pb + 0); PP_END(1);
        PP_BEGIN(2);
        if (PON(2) && IN(pb + 1)) for (int rep = 0; rep < DUPN(2); ++rep) mixer_phase(F, l + 2 * rep, LDP(14) + (size_t)l * 1024);
        SEAM(pb + 1); PP_END(2);
        PP_BEGIN(3);
        if (PON(3) && IN(pb + 2)) for (int rep = 0; rep < DUPN(3); ++rep) {
            unsigned char* ws = WSP(); unsigned char* wl = ws + WS_W + (size_t)l * W_LAYER; unsigned char* big = ws + WS_BIG;
            pg8::Gemm g{(const pg8::bf16_t*)(big + BO_MIX), (const pg8::bf16_t*)(wl + WO_OUT), M, DM, DM}; pg8::StaticOrder S; S.init(M, DM, F.G, (int)blockIdx.x);
            pg8::EpiY E{(pg8::bf16_t*)(ws + WS_Y), (float*)(ws + WS_SS), nullptr, 1.0f};
            pg8::gemm_phase<pg8::EpiY, pg8::StaticOrder, true, true>(F.lds + RING_OFF, g, S, E, F.wave_id);
        }
        SEAM(pb + 2); PP_END(3);
        PP_BEGIN(4);
        if (PON(4) && IN(pb + 3)) thin_phase(F, nullptr, LDP(10) + (size_t)l * DM, nullptr);
        SEAM(pb + 3); PP_END(4);
        PP_BEGIN(5);
        if (PON(5) && IN(pb + 4)) for (int rep = 0; rep < DUPN(5); ++rep) {
            unsigned char* ws = WSP(); unsigned char* wl = ws + WS_W + (size_t)l * W_LAYER; unsigned char* big = ws + WS_BIG;
            pg8::Gemm g{(const pg8::bf16_t*)(ws + WS_HB), (const pg8::bf16_t*)(wl + WO_FF1), M, DFF, DM}; pg8::StaticOrder S; S.init(M, DFF, F.G, (int)blockIdx.x);
            pg8::EpiFF1 E{big + BO_HID, (const float*)(ws + WS_RS)};
            pg8::gemm_phase<pg8::EpiFF1, pg8::StaticOrder, true, true>(F.lds + RING_OFF, g, S, E, F.wave_id);
        }
        SEAM(pb + 4); PP_END(5);
        PP_BEGIN(6);
        if (PON(6) && IN(pb + 5)) for (int rep = 0; rep < DUPN(6); ++rep) {
            unsigned char* ws = WSP(); unsigned char* wl = ws + WS_W + (size_t)l * W_LAYER; unsigned char* big = ws + WS_BIG;
            pg8::Gemm g{(const pg8::bf16_t*)(big + BO_HID), (const pg8::bf16_t*)(wl + WO_FF2), M, DM, DFF / 2};
            pg8::StaticOrder S; S.init(M, DM, F.G, (int)blockIdx.x);
            pg8::EpiYT<false> E{(pg8::bf16_t*)(ws + WS_Y), (float*)(ws + WS_SS), nullptr, 1.0f / (HID_SCALE * W2_SCALE)};
            pg8::gemm_phase<pg8::EpiYT<false>, pg8::StaticOrder, true, true, true>(F.lds + RING_OFF, g, S, E, F.wave_id);
        }
        SEAM(pb + 5); PP_END(6);
        PP_BEGIN(7);
        if (PON(7) && IN(pb + 6)) thin_phase(F, nullptr, LDP(12) + (size_t)l * DM, LDP(1) + (size_t)l * M * PLE);
        SEAM(pb + 6); PP_END(7);
        PP_BEGIN(8);
        if (PON(8) && IN(pb + 7)) for (int rep = 0; rep < DUPN(8); ++rep) {
            int kple = PLE; asm volatile("" : "+s"(kple));
            unsigned char* ws = WSP(); unsigned char* wl = ws + WS_W + (size_t)l * W_LAYER; unsigned char* big = ws + WS_BIG;
            pg8::Gemm g{(const pg8::bf16_t*)(big + BO_PB), (const pg8::bf16_t*)(wl + WO_PLE), M, DM, kple}; pg8::StaticOrder S; S.init(M, DM, F.G, (int)blockIdx.x);
            pg8::EpiPlain E{(pg8::bf16_t*)(big + BO_E), DM};
            pg8::gemm_phase<pg8::EpiPlain, pg8::StaticOrder, true, true>(F.lds + RING_OFF, g, S, E, F.wave_id);
        }
        SEAM(pb + 7); PP_END(8);
        PP_BEGIN(9);
        if (PON(9) && IN(pb + 8)) for (int rep = 0; rep < DUPN(9); ++rep) {
            unsigned char* ws = WSP(); unsigned char* wl = ws + WS_W + (size_t)l * W_LAYER; unsigned char* big = ws + WS_BIG;
            pg8::Gemm g{(const pg8::bf16_t*)(ws + WS_HB), (const pg8::bf16_t*)(wl + WO_GATE), M, DM, DM}; pg8::StaticOrder S; S.init(M, DM, F.G, (int)blockIdx.x);
            pg8::EpiY E{(pg8::bf16_t*)(ws + WS_Y), (float*)(ws + WS_SS), (const pg8::bf16_t*)(big + BO_E), 1.0f};
            pg8::gemm_phase<pg8::EpiY, pg8::StaticOrder, true, true>(F.lds + RING_OFF, g, S, E, F.wave_id);
        }
        SEAM(pb + 8); PP_END(9);
        PP_BEGIN(10);
        if (PON(10) && IN(pb + 9)) thin_phase(F, l == DEPTH - 1 ? (float*)LDP(15) : nullptr, LDP(13) + (size_t)l * DM, nullptr);
        SEAM(pb + 9); PP_END(10);
    }
    if (PROF_PHASE != 0) { pp_acc = __builtin_amdgcn_readfirstlane(pp_acc); const unsigned t0 = (unsigned)__builtin_amdgcn_s_memrealtime(); while ((unsigned)__builtin_amdgcn_s_memrealtime() - t0 < pp_acc) __builtin_amdgcn_s_sleep(4); }
#undef IN
#undef SEAM
}

extern "C" void kernel_launch(void* const* d_in, const int* in_sizes, int n_in, void* d_out, int out_size, void* d_ws, size_t ws_size, hipStream_t stream) {
    static int grid = 0;
    if (grid == 0) {
        if (n_in != 15 || out_size != M * DM || ws_size < WS_END) { fprintf(stderr, "kernel_launch: unexpected shapes (n_in %d, out %d, ws %zu, need %zu)\n", n_in, out_size, ws_size, (size_t)WS_END); grid = -1; return; }
        int dev = 0, cus = 0, per_cu = 0;
        if (hipGetDevice(&dev) != hipSuccess || hipDeviceGetAttribute(&cus, hipDeviceAttributeMultiprocessorCount, dev) != hipSuccess) { grid = -1; return; }
        if (hipFuncSetAttribute((const void*)hyb_fwd, hipFuncAttributeMaxDynamicSharedMemorySize, LDS_BYTES) != hipSuccess) { fprintf(stderr, "kernel_launch: hipFuncSetAttribute failed\n"); grid = -1; return; }
        if (hipOccupancyMaxActiveBlocksPerMultiprocessor(&per_cu, (const void*)hyb_fwd, NWAVES * 64, LDS_BYTES) != hipSuccess || per_cu < 1)
            fprintf(stderr, "kernel_launch: note: occupancy query reports %d workgroups per CU\n", per_cu);
        (void)hipGetLastError();
        grid = cus;
    }
    if (grid < 0) return;
    if (hipMemsetAsync((char*)d_ws + WS_CTL, 0, CTL_ZERO_BYTES, stream) != hipSuccess) return;
    Args a{};
    for (int i = 0; i < 15; ++i) a.in[i] = d_in[i];
    a.out = (float*)d_out; a.ws = (unsigned char*)d_ws;
    for (int li = 0; li < N_LAUNCHES; ++li) {
        a.ph_lo = (N_LAUNCHES == 1) ? 0 : li; a.ph_hi = (N_LAUNCHES == 1) ? NPH : li + 1; a.li = li; a.pad = 0;
        hipLaunchKernelGGL(hyb_fwd, dim3(grid), dim3(NWAVES * 64), LDS_BYTES, stream, a);
        if (hipPeekAtLastError() != hipSuccess) { fprintf(stderr, "kernel_launch: launch %d failed\n", li); break; }
    }
}
```

```cpp
#include <hip/hip_runtime.h>
#include <cstdio>
#include <cstdint>

constexpr int NWAVES = 8;
constexpr int BATCH = 16, SEQ = 2048, DM = 2048, DEPTH = 2, M = BATCH * SEQ;
constexpr int NINL = 5456, NINP = 5632, DFF = 8192, PLE = 256;
constexpr float RMS_EPS = 1e-6f, GN_EPS = 1e-5f;
constexpr float QSCALE = 0.08838834764831845f * 1.4426950408889634f;
constexpr float HID_SCALE = 4.0f, W2_SCALE = 64.0f;
constexpr float LOG2_THETA_A = 18.931568569324174f, LOG2_THETA_R = 13.287712379549449f;

constexpr size_t MiB = 1u << 20;
constexpr size_t WS_CTL = 0, CTL_ZERO_BYTES = 65536;
constexpr size_t WS_W = 1 * MiB, W_LAYER = 103 * MiB;
constexpr size_t WO_IN = 0, WO_OUT = 22 * MiB, WO_FF1 = 30 * MiB, WO_FF2 = 62 * MiB, WO_PLE = 94 * MiB, WO_GATE = 95 * MiB;
constexpr size_t WS_ROPE = 207 * MiB;
constexpr size_t WS_HB = 221 * MiB, WS_Y = 349 * MiB, WS_SS = 477 * MiB, WS_RS = 481 * MiB, WS_BIG = 482 * MiB;
constexpr size_t BO_AQ = 0, BO_AKV = 64 * MiB, BO_IQ = 80 * MiB, BO_IK = 144 * MiB, BO_IW = 148 * MiB, BO_RQ = 150 * MiB, BO_RK = 182 * MiB,
                 BO_RV = 214 * MiB, BO_RG = 278 * MiB, BO_MIX = 342 * MiB;
constexpr size_t BO_HID = 0, BO_E = 0, BO_PB = 128 * MiB;
constexpr size_t WS_END = 994 * MiB;
constexpr int ROPE_W = 112;
constexpr int CW_BAR = 4096, CW_Q = 8192;
constexpr int RING_OFF = 0, RING_BYTES = 139264;
constexpr int LDSCTL_OFF = RING_BYTES, MISC_OFF = LDSCTL_OFF + 320;
constexpr int LDS_BYTES = 147456;
static_assert(MISC_OFF + 128 <= LDS_BYTES, "LDS map");
namespace pg8 {
#define PG8_LAS __attribute__((address_space(3)))
typedef unsigned short bf16_t;
typedef short bf16x8 __attribute__((ext_vector_type(8)));
typedef float f32x4 __attribute__((ext_vector_type(4)));
typedef unsigned u32x4 __attribute__((ext_vector_type(4)));
constexpr int BM = 256, BK = 64, HALF = 128, HTB = HALF * BK * 2  , STAGE_BYTES = 8 * HTB, NXCD = 8, WGM = 8;

__host__ __device__ __forceinline__ int lds_byte(int r, int c) { const int st = (r >> 4) * 2 + (c >> 5), rr = r & 15, cc = c & 31, ob = rr * 64 + cc * 2; return st * 1024 + (ob ^ (((ob >> 9) & 1) << 5)); }
__host__ __device__ __forceinline__ void stage_rc(int b, int& R, int& C) { const int st = b / 1024, sb = b % 1024, swz = sb ^ (((sb >> 9) & 1) << 5); R = (st >> 1) * 16 + swz / 64; C = (st & 1) * 32 + (swz % 64) / 2; }
__host__ __device__ __forceinline__ int perm32(int rho) { const int n = rho >> 4, i = rho & 15; return 8 * (i >> 2) + 4 * n + (i & 3); }

struct Unit { int pm, pn; };
struct Gemm { const bf16_t* A; const bf16_t* Bt; int M, N, K; };

struct StaticOrder {
    int nM, nN, nwg, G, c;
    __host__ __device__ void init(int M, int N, int G_, int c_) { nM = M / BM; nN = N / BM; nwg = nM * nN; G = G_; c = c_; }
    __host__ __device__ bool next(int i, Unit& u) const {
        const long L = (long)i * G + c; if (L >= nwg) return false;
        int wgid = (int)L; { const int q = nwg / NXCD, r = nwg % NXCD, xcd = wgid % NXCD, off = wgid / NXCD; wgid = (xcd < r ? xcd * (q + 1) : r * (q + 1) + (xcd - r) * q) + off; }
        const int nig = WGM * nN, gid = wgid / nig, fm = gid * WGM, gsz = (nM - fm) < WGM ? (nM - fm) : WGM;
        u.pm = fm + ((wgid % nig) % gsz); u.pn = (wgid % nig) / gsz; return true;
    }
    __device__ __forceinline__ void a_ready(const Unit&) const {}
    __device__ __forceinline__ void done(const Unit&) const {}
};
__device__ __forceinline__ unsigned cvt_pk_bf16(float lo, float hi) { unsigned r; asm volatile("v_cvt_pk_bf16_f32 %0, %1, %2" : "=v"(r) : "v"(lo), "v"(hi)); return r; }
typedef float f32x2 __attribute__((ext_vector_type(2)));

__device__ __forceinline__ u32x4 pack8(const f32x4& v0, const f32x4& v1) { u32x4 w; w.x = cvt_pk_bf16(v0[0], v0[1]); w.y = cvt_pk_bf16(v0[2], v0[3]); w.z = cvt_pk_bf16(v1[0], v1[1]); w.w = cvt_pk_bf16(v1[2], v1[3]); return w; }
__device__ __forceinline__ float bf_lo(unsigned w) { return __uint_as_float(w << 16); }
__device__ __forceinline__ float bf_hi(unsigned w) { return __uint_as_float(w & 0xffff0000u); }
__device__ __forceinline__ float fast_sigmoid(float x) { return __builtin_amdgcn_rcpf(1.0f + __builtin_amdgcn_exp2f(-1.4426950408889634f * x)); }
__device__ __forceinline__ float log2_gamma(int h) { const float e = __builtin_amdgcn_exp2f(-5.0f - (float)h); return -(e * (1.0f + e * (0.5f + e * (0.33333333f + e * (0.25f + e * 0.2f))))) * 1.4426950408889634f; }

struct EpiIn {
    static constexpr bool PERM = true, AFTER_DRAIN = false;
    unsigned char* big; const float* RS; const float* ROPE;
    struct Col { size_t dofs; int ldc, dcol, mode; bool has, rot; float scale, lg; };
    __device__ __forceinline__ void operator()(const f32x4 (&acc)[2][2][4][2], const Unit& u, int wr, int wc, int fr_, int fq_) const {
        int fr = fr_, fq = fq_; asm volatile("" : "+v"(fr), "+v"(fq));
        const int pn = u.pn;
        Col cl[2]; int coff = 0, soff = 0;
#pragma unroll
        for (int bj = 0; bj < 2; ++bj) {
            const int c256 = 128 * bj + 32 * wc + 8 * fq;
            Col k; k.dofs = 0; k.ldc = 0; k.dcol = 0; k.mode = 0; k.has = false; k.rot = false; k.scale = 1.f; k.lg = 0.f;
            if (pn < 4)       { k.dofs = BO_AQ;  k.has = true; k.ldc = 1024; k.dcol = pn * 256 + c256;        k.rot = (wc == 0); coff = 4 * fq; soff = 16 + 4 * fq; k.scale = QSCALE; }
            else if (pn == 4) { k.dofs = BO_AKV; k.has = true; k.ldc = 256;  k.dcol = c256;                   k.rot = (bj == 0 && wc == 0); coff = 4 * fq; soff = 16 + 4 * fq; }
            else if (pn < 9)  { k.dofs = BO_IQ;  k.has = true; k.ldc = 1024; k.dcol = (pn - 5) * 256 + c256;  k.rot = ((wc & 1) == 0 && fq < 2); coff = 32 + 4 * fq; soff = 40 + 4 * fq; }
            else if (pn == 9) { if (bj == 0 && wc < 2) { k.dofs = BO_IK; k.has = true; k.ldc = 64; k.dcol = c256; k.rot = (wc == 0 && fq < 2); coff = 32 + 4 * fq; soff = 40 + 4 * fq; }
                                else if (bj == 0 && wc == 2 && fq < 2) { k.mode = 3; } }
            else if (pn < 12) { k.dofs = BO_RQ;  k.has = true; k.ldc = 512;  k.dcol = (pn - 10) * 256 + c256; k.rot = true; coff = 48 + 16 * (wc & 1) + 4 * fq; soff = 80 + 16 * (wc & 1) + 4 * fq; }
            else if (pn < 14) { k.dofs = BO_RK;  k.has = true; k.ldc = 512;  k.dcol = (pn - 12) * 256 + c256; k.rot = true; coff = 48 + 16 * (wc & 1) + 4 * fq; soff = 80 + 16 * (wc & 1) + 4 * fq; k.scale = 0.125f; k.mode = 2;
                                k.lg = log2_gamma(4 * (pn - 12) + 2 * bj + (wc >> 1)); }
            else if (pn < 18) { k.dofs = BO_RV;  k.has = true; k.ldc = 1024; k.dcol = (pn - 14) * 256 + c256; }
            else              { k.dofs = BO_RG;  k.has = true; k.ldc = 1024; k.dcol = (pn - 18) * 256 + c256; k.mode = 1; }
            cl[bj] = k;
        }
        const bool anyrot = cl[0].rot || cl[1].rot;
        float* IW = (float*)(big + BO_IW);
#pragma unroll
        for (int ai = 0; ai < 2; ++ai) {
            float rsv[4]; f32x4 cs[4], sn[4];
#pragma unroll
            for (int m = 0; m < 4; ++m) { const int row = u.pm * BM + ai * HALF + wr * 64 + m * 16 + fr; rsv[m] = RS[row];
                cs[m] = (f32x4){1.f, 1.f, 1.f, 1.f}; sn[m] = (f32x4){0.f, 0.f, 0.f, 0.f};
                if (anyrot) { const float* rp = ROPE + (size_t)row * ROPE_W; cs[m] = *(const f32x4*)(rp + coff); sn[m] = *(const f32x4*)(rp + soff); } }
#pragma unroll
            for (int m = 0; m < 4; ++m) {
                const int row = u.pm * BM + ai * HALF + wr * 64 + m * 16 + fr;
#pragma unroll
                for (int bj = 0; bj < 2; ++bj) {
                    const Col& k = cl[bj];
                    if (!k.has && k.mode != 3) continue;
                    float sc = rsv[m] * k.scale;
                    if (k.mode == 2) sc *= __builtin_amdgcn_exp2f((float)(127 - (row & 127)) * k.lg);
                    f32x4 v0 = acc[ai][bj][m][0], v1 = acc[ai][bj][m][1];
                    if (k.rot) { const f32x4 a = v0 * cs[m] - v1 * sn[m], b = v1 * cs[m] + v0 * sn[m]; v0 = a; v1 = b; }
                    v0 = v0 * sc; v1 = v1 * sc;
                    if (k.mode == 1) {
#pragma unroll
                        for (int j = 0; j < 4; ++j) { v0[j] = v0[j] * fast_sigmoid(v0[j]); v1[j] = v1[j] * fast_sigmoid(v1[j]); } }
                    if (k.mode == 3) { float* p = IW + (size_t)row * 16 + 8 * fq; *(f32x4*)p = v0; *(f32x4*)(p + 4) = v1; }
                    else *(u32x4*)((bf16_t*)(big + k.dofs) + (size_t)row * k.ldc + k.dcol) = pack8(v0, v1);
                }
            }
            asm volatile("" ::: "memory");
        }
    }
};
template <bool PERMV> struct EpiYT {
    static constexpr bool PERM = PERMV, AFTER_DRAIN = false;
    bf16_t* Y; float* SS; const bf16_t* E; float oscale;
    __device__ __forceinline__ void operator()(const f32x4 (&acc)[2][2][4][2], const Unit& u, int wr, int wc, int fr_, int fq_) const {
        int fr = fr_, fq = fq_; asm volatile("" : "+v"(fr), "+v"(fq));
        const int col0 = u.pn * BM + wc * 32 + (PERMV ? 8 : 4) * fq;
#pragma unroll
        for (int ai = 0; ai < 2; ++ai) {
            u32x4 ev[4][2];
            if (PERMV && E) {
#pragma unroll
                for (int m = 0; m < 4; ++m)
#pragma unroll
                    for (int bj = 0; bj < 2; ++bj) ev[m][bj] = *(const u32x4*)(E + (size_t)(u.pm * BM + ai * HALF + wr * 64 + m * 16 + fr) * DM + col0 + bj * HALF);
            }
#pragma unroll
            for (int m = 0; m < 4; ++m) {
                const int row = u.pm * BM + ai * HALF + wr * 64 + m * 16 + fr; float q = 0.f;
#pragma unroll
                for (int bj = 0; bj < 2; ++bj) {
                    f32x4 v0 = acc[ai][bj][m][0] * oscale, v1 = acc[ai][bj][m][1] * oscale;
                    if (PERMV && E) { const u32x4 e = ev[m][bj];
                        v0[0] = fast_sigmoid(v0[0]) * bf_lo(e.x); v0[1] = fast_sigmoid(v0[1]) * bf_hi(e.x); v0[2] = fast_sigmoid(v0[2]) * bf_lo(e.y); v0[3] = fast_sigmoid(v0[3]) * bf_hi(e.y);
                        v1[0] = fast_sigmoid(v1[0]) * bf_lo(e.z); v1[1] = fast_sigmoid(v1[1]) * bf_hi(e.z); v1[2] = fast_sigmoid(v1[2]) * bf_lo(e.w); v1[3] = fast_sigmoid(v1[3]) * bf_hi(e.w); }
                    q += (v0[0] * v0[0] + v0[1] * v0[1]) + (v0[2] * v0[2] + v0[3] * v0[3]) + (v1[0] * v1[0] + v1[1] * v1[1]) + (v1[2] * v1[2] + v1[3] * v1[3]);
                    if (PERMV) *(u32x4*)(Y + (size_t)row * DM + col0 + bj * HALF) = pack8(v0, v1);
                    else { typedef unsigned u32x2e __attribute__((ext_vector_type(2)));
                        *(u32x2e*)(Y + (size_t)row * DM + col0 + bj * HALF) = (u32x2e){cvt_pk_bf16(v0[0], v0[1]), cvt_pk_bf16(v0[2], v0[3])};
                        *(u32x2e*)(Y + (size_t)row * DM + col0 + bj * HALF + 16) = (u32x2e){cvt_pk_bf16(v1[0], v1[1]), cvt_pk_bf16(v1[2], v1[3])}; }
                }
                q += __shfl_xor(q, 16); q += __shfl_xor(q, 32);
                if (fq == 0) SS[(size_t)row * 32 + u.pn * 4 + wc] = q;
            }
            asm volatile("" ::: "memory");
        }
    }
};
typedef EpiYT<true> EpiY;
struct EpiFF1 {
    static constexpr bool PERM = true, AFTER_DRAIN = false;
    unsigned char* H; const float* RS;
    __device__ __forceinline__ void operator()(const f32x4 (&acc)[2][2][4][2], const Unit& u, int wr, int wc, int fr_, int fq_) const {
        int fr = fr_, fq = fq_; asm volatile("" : "+v"(fr), "+v"(fq));
        const int col0 = u.pn * BM + wc * 32 + 8 * fq;
        float rsv[2][4];
#pragma unroll
        for (int ai = 0; ai < 2; ++ai)
#pragma unroll
            for (int m = 0; m < 4; ++m) rsv[ai][m] = RS[u.pm * BM + ai * HALF + wr * 64 + m * 16 + fr];
#pragma unroll
        for (int ai = 0; ai < 2; ++ai)
#pragma unroll
            for (int m = 0; m < 4; ++m) {
                const int row = u.pm * BM + ai * HALF + wr * 64 + m * 16 + fr; const float rs = rsv[ai][m];
#pragma unroll
                for (int bj = 0; bj < 2; ++bj) {
                    f32x4 v0 = acc[ai][bj][m][0] * rs, v1 = acc[ai][bj][m][1] * rs;
#pragma unroll
                    for (int j = 0; j < 4; ++j) { const float a = fmaxf(v0[j], 0.f), b = fmaxf(v1[j], 0.f); v0[j] = a * a * HID_SCALE; v1[j] = b * b * HID_SCALE; }
                    unsigned w0 = 0u, w1 = 0u;
                    w0 = __builtin_amdgcn_cvt_pk_fp8_f32(v0[0], v0[1], w0, false); w0 = __builtin_amdgcn_cvt_pk_fp8_f32(v0[2], v0[3], w0, true);
                    w1 = __builtin_amdgcn_cvt_pk_fp8_f32(v1[0], v1[1], w1, false); w1 = __builtin_amdgcn_cvt_pk_fp8_f32(v1[2], v1[3], w1, true);
                    typedef unsigned u32x2e __attribute__((ext_vector_type(2)));
                    *(u32x2e*)(H + (size_t)row * DFF + col0 + bj * HALF) = (u32x2e){w0, w1};
                }
            }
    }
};
struct EpiPlain {
    static constexpr bool PERM = true, AFTER_DRAIN = false;
    bf16_t* O; int ldc;
    __device__ __forceinline__ void operator()(const f32x4 (&acc)[2][2][4][2], const Unit& u, int wr, int wc, int fr_, int fq_) const {
        int fr = fr_, fq = fq_; asm volatile("" : "+v"(fr), "+v"(fq));
        const int col0 = u.pn * BM + wc * 32 + 8 * fq;
#pragma unroll
        for (int ai = 0; ai < 2; ++ai)
#pragma unroll
            for (int m = 0; m < 4; ++m) {
                const int row = u.pm * BM + ai * HALF + wr * 64 + m * 16 + fr;
#pragma unroll
                for (int bj = 0; bj < 2; ++bj) *(u32x4*)(O + (size_t)row * ldc + col0 + bj * HALF) = pack8(acc[ai][bj][m][0], acc[ai][bj][m][1]);
            }
    }
};
typedef int pg8_v8i __attribute__((ext_vector_type(8))); typedef int pg8_v4i __attribute__((ext_vector_type(4)));
__device__ __forceinline__ pg8_v8i pg8_cat(bf16x8 lo, bf16x8 hi) { return __builtin_shufflevector(__builtin_bit_cast(pg8_v4i, lo), __builtin_bit_cast(pg8_v4i, hi), 0, 1, 2, 3, 4, 5, 6, 7); }
template <class Epi, class Sched, bool ALIGN_EPI = false, bool SP2 = false, bool F8 = false>
__device__ __forceinline__ void gemm_phase(PG8_LAS unsigned char* lds, const Gemm g, const Sched& S, const Epi& E, const int wave_id) {
    unsigned ones_ = ~0u; asm volatile("" : "+s"(ones_)); int tid_ = wave_id * 64 + (int)__builtin_amdgcn_mbcnt_hi(ones_, __builtin_amdgcn_mbcnt_lo(ones_, 0u)); asm volatile("" : "+v"(tid_));
    const int tid = tid_, wid = __builtin_amdgcn_readfirstlane(tid >> 6), lane = tid & 63, wr = wid >> 2, wc = wid & 3, fr = lane & 15, fq = lane >> 4;
    const int K = g.K, nt = K / BK;
    unsigned voffA[2], voffB[2];
#pragma unroll
    for (int i = 0; i < 2; ++i) { int R, C; stage_rc(tid * 16 + i * 8192, R, C); const int Rb = Epi::PERM ? ((R & ~31) + perm32(R & 31)) : R;
        voffA[i] = (unsigned)(R * K + C) * 2u; voffB[i] = (unsigned)(Rb * K + C) * 2u; }
    const size_t kstep = (size_t)(BK * 2);
    const size_t hstep = (size_t)HALF * K * 2;
    const size_t tstep = 2 * hstep;
    const unsigned ldsw = (unsigned)wid * 1024u;
    const int aoff = lds_byte(wr * 64 + fr, fq * 8), boff = lds_byte(wc * 32 + fr, fq * 8);
#define PG8_SA(b, h) (((b) * 2 + (h)) * HTB)
#define PG8_SB(b, h) ((4 + (b) * 2 + (h)) * HTB)
#define PG8_STAGE(bufoff, gbase, voff) do { if constexpr (F8) { _Pragma("unroll") for (int _i = 0; _i < 2; ++_i) {   \
        const unsigned m0v_ = (unsigned)(uintptr_t)(lds + (bufoff) + ldsw + _i * 8192); \
        unsigned keep_; asm volatile("s_mov_b32 %0, m0\n\ts_mov_b32 m0, %3\n\ts_nop 0\n\tglobal_load_lds_dwordx4 %1, %2\n\ts_mov_b32 m0, %0" : "=&s"(keep_) : "v"((voff)[_i]), "s"((const void*)(gbase)), "s"(m0v_) : "memory"); } } \
        else { _Pragma("unroll") for (int _i = 0; _i < 2; ++_i) \
        __builtin_amdgcn_global_load_lds((const unsigned*)((const char*)(gbase) + (voff)[_i]), (PG8_LAS unsigned*)(lds + (bufoff) + ldsw + _i * 8192), 16, 0, 0); } } while (0)
#define PG8_LDA(dst, b, h) do { if constexpr (F8) { _Pragma("unroll") for (int m = 0; m < 4; ++m) dst##8[m] = pg8_cat(*(const PG8_LAS bf16x8*)(lds + PG8_SA(b, h) + aoff + m * 2048), *(const PG8_LAS bf16x8*)(lds + PG8_SA(b, h) + aoff + m * 2048 + 1024)); } \
        else { _Pragma("unroll") for (int m = 0; m < 4; ++m) _Pragma("unroll") for (int k = 0; k < 2; ++k) dst[m][k] = *(const PG8_LAS bf16x8*)(lds + PG8_SA(b, h) + aoff + m * 2048 + k * 1024); } } while (0)
#define PG8_LDB(dst, b, h) do { if constexpr (F8) { _Pragma("unroll") for (int n = 0; n < 2; ++n) dst##8[n] = pg8_cat(*(const PG8_LAS bf16x8*)(lds + PG8_SB(b, h) + boff + n * 2048), *(const PG8_LAS bf16x8*)(lds + PG8_SB(b, h) + boff + n * 2048 + 1024)); } \
        else { _Pragma("unroll") for (int n = 0; n < 2; ++n) _Pragma("unroll") for (int k = 0; k < 2; ++k) dst[n][k] = *(const PG8_LAS bf16x8*)(lds + PG8_SB(b, h) + boff + n * 2048 + k * 1024); } } while (0)
#define PG8_MMA(ai, bj, At, Bt) do { __builtin_amdgcn_s_setprio(1); if constexpr (F8) { _Pragma("unroll") for (int m = 0; m < 4; ++m) _Pragma("unroll") for (int n = 0; n < 2; ++n) \
        acc[ai][bj][m][n] = __builtin_amdgcn_mfma_scale_f32_16x16x128_f8f6f4(Bt##8[n], At##8[m], acc[ai][bj][m][n], 0, 0, 0, 0x7f7f7f7f, 0, 0x7f7f7f7f); } \
        else { _Pragma("unroll") for (int m = 0; m < 4; ++m) _Pragma("unroll") for (int n = 0; n < 2; ++n) _Pragma("unroll") for (int k = 0; k < 2; ++k) \
        acc[ai][bj][m][n] = __builtin_amdgcn_mfma_f32_16x16x32_bf16(Bt[n][k], At[m][k], acc[ai][bj][m][n], 0, 0, 0); } __builtin_amdgcn_s_setprio(0); } while (0)
#define PG8_WAIT_V(n) asm volatile("s_waitcnt vmcnt(" #n ")" ::: "memory")
#define PG8_WAIT_L(n) asm volatile("s_waitcnt lgkmcnt(" #n ")" ::: "memory")
#define PG8_BAR __builtin_amdgcn_s_barrier()
#define PG8_SCHED __builtin_amdgcn_sched_barrier(0)
    Unit cur, nxt; int ui = 0;
    if (!S.next(0, cur)) return;
    f32x4 acc[2][2][4][2];
#pragma unroll
    for (int a = 0; a < 2; ++a)
#pragma unroll
        for (int b = 0; b < 2; ++b)
#pragma unroll
            for (int m = 0; m < 4; ++m)
#pragma unroll
                for (int n = 0; n < 2; ++n) acc[a][b][m][n] = (f32x4){0.f, 0.f, 0.f, 0.f};
    bf16x8 At[4][2], B0[2][2], B1[2][2]; pg8_v8i At8[4], B08[2], B18[2];
    const char* cA = (const char*)g.A + (size_t)cur.pm * tstep; const char* cB = (const char*)g.Bt + (size_t)cur.pn * tstep;
    S.a_ready(cur);
    if constexpr (SP2) {
        PG8_STAGE(PG8_SB(0, 0), cB, voffB); PG8_STAGE(PG8_SB(0, 1), cB + hstep, voffB); PG8_STAGE(PG8_SA(0, 0), cA, voffA); PG8_STAGE(PG8_SA(0, 1), cA + hstep, voffA);
        if (wr == 1) PG8_BAR;
        PG8_WAIT_V(2); PG8_BAR;
        PG8_STAGE(PG8_SB(1, 0), cB + kstep, voffB); PG8_STAGE(PG8_SA(1, 0), cA + kstep, voffA); PG8_STAGE(PG8_SB(1, 1), cB + hstep + kstep, voffB);
        PG8_WAIT_V(6); PG8_BAR;
    } else {
        PG8_STAGE(PG8_SB(0, 0), cB, voffB); PG8_STAGE(PG8_SA(0, 0), cA, voffA); PG8_STAGE(PG8_SB(0, 1), cB + hstep, voffB); PG8_STAGE(PG8_SA(0, 1), cA + hstep, voffA);
        if (wr == 1) PG8_BAR;
        PG8_WAIT_V(4); PG8_BAR;
        PG8_STAGE(PG8_SB(1, 0), cB + kstep, voffB); PG8_STAGE(PG8_SA(1, 0), cA + kstep, voffA); PG8_STAGE(PG8_SB(1, 1), cB + hstep + kstep, voffB);
        PG8_WAIT_V(6); PG8_BAR;
    }
    for (;;) {
        const bool has_next = S.next(ui + 1, nxt);
        const char* nA = has_next ? (const char*)g.A + (size_t)nxt.pm * tstep : cA; const char* nB = has_next ? (const char*)g.Bt + (size_t)nxt.pn * tstep : cB;
        if constexpr (F8) {
            static_assert(!F8 || SP2, "the fp8 loop is the SP2 schedule");
#pragma unroll 1
            for (int t = 0; t < nt; ++t) {
                const int b = t & 1;
                const char* a1 = (t + 1 >= nt) ? nA + (size_t)(t + 1 - nt) * kstep : cA + (size_t)(t + 1) * kstep;
                const char* a2 = (t + 2 >= nt) ? nA + (size_t)(t + 2 - nt) * kstep : cA + (size_t)(t + 2) * kstep;
                const char* b2 = (t + 2 >= nt) ? nB + (size_t)(t + 2 - nt) * kstep : cB + (size_t)(t + 2) * kstep;
                if (t == nt - 2 && has_next) S.a_ready(nxt);
                PG8_LDB(B0, b, 0); PG8_LDB(B1, b, 1); PG8_SCHED; PG8_LDA(At, b, 0); PG8_STAGE(PG8_SA(1 - b, 1), a1 + hstep, voffA);
                PG8_WAIT_V(8); PG8_WAIT_L(0); PG8_BAR; PG8_MMA(0, 0, At, B0); PG8_MMA(0, 1, At, B1); PG8_BAR; PG8_SCHED;
                PG8_LDA(At, b, 1); PG8_STAGE(PG8_SB(b, 0), b2, voffB); PG8_STAGE(PG8_SB(b, 1), b2 + hstep, voffB); PG8_STAGE(PG8_SA(b, 0), a2, voffA);
                PG8_WAIT_V(8); PG8_WAIT_L(0); PG8_BAR; PG8_MMA(1, 0, At, B0); PG8_MMA(1, 1, At, B1); PG8_BAR; PG8_SCHED;
            }
        } else
        for (int t = 0; t < nt; t += 2) {
            const bool last = (t == nt - 2);
            const char* a1 = cA + (size_t)(t + 1) * kstep;
            const char* a2 = last ? nA : cA + (size_t)(t + 2) * kstep; const char* b2 = last ? nB : cB + (size_t)(t + 2) * kstep;
            const char* a3 = a2 + kstep; const char* b3 = b2 + kstep;
            if (last && has_next) S.a_ready(nxt);
            if constexpr (SP2) {
            PG8_LDB(B0, 0, 0); PG8_LDB(B1, 0, 1); PG8_SCHED; PG8_LDA(At, 0, 0); PG8_STAGE(PG8_SA(1, 1), a1 + hstep, voffA);
            PG8_WAIT_V(8); PG8_WAIT_L(0); PG8_BAR; PG8_MMA(0, 0, At, B0); PG8_MMA(0, 1, At, B1); PG8_BAR; PG8_SCHED;
            PG8_LDA(At, 0, 1); PG8_STAGE(PG8_SB(0, 0), b2, voffB); PG8_STAGE(PG8_SB(0, 1), b2 + hstep, voffB); PG8_STAGE(PG8_SA(0, 0), a2, voffA);
            PG8_WAIT_V(8); PG8_WAIT_L(0); PG8_BAR; PG8_MMA(1, 0, At, B0); PG8_MMA(1, 1, At, B1); PG8_BAR; PG8_SCHED;
            PG8_LDB(B0, 1, 0); PG8_LDB(B1, 1, 1); PG8_SCHED; PG8_LDA(At, 1, 0); PG8_STAGE(PG8_SA(0, 1), a2 + hstep, voffA);
            PG8_WAIT_V(8); PG8_WAIT_L(0); PG8_BAR; PG8_MMA(0, 0, At, B0); PG8_MMA(0, 1, At, B1); PG8_BAR; PG8_SCHED;
            PG8_LDA(At, 1, 1); PG8_STAGE(PG8_SB(1, 0), b3, voffB); PG8_STAGE(PG8_SB(1, 1), b3 + hstep, voffB); PG8_STAGE(PG8_SA(1, 0), a3, voffA);
            PG8_WAIT_V(8); PG8_WAIT_L(0); PG8_BAR; PG8_MMA(1, 0, At, B0); PG8_MMA(1, 1, At, B1); PG8_BAR; PG8_SCHED;
            } else {
            PG8_LDB(B0, 0, 0); PG8_SCHED; PG8_LDA(At, 0, 0); PG8_STAGE(PG8_SA(1, 1), a1 + hstep, voffA);
            PG8_WAIT_L(8); PG8_BAR; PG8_WAIT_L(0); PG8_MMA(0, 0, At, B0); PG8_BAR; PG8_SCHED;
            PG8_LDB(B1, 0, 1); PG8_STAGE(PG8_SB(0, 0), b2, voffB);
            PG8_BAR; PG8_WAIT_L(0); PG8_MMA(0, 1, At, B1); PG8_BAR;
            PG8_LDA(At, 0, 1); PG8_STAGE(PG8_SA(0, 0), a2, voffA);
            PG8_BAR; PG8_WAIT_L(0); PG8_MMA(1, 0, At, B0); PG8_BAR; PG8_SCHED;
            PG8_STAGE(PG8_SB(0, 1), b2 + hstep, voffB);
            PG8_WAIT_V(6); PG8_BAR; PG8_MMA(1, 1, At, B1); PG8_BAR;
            PG8_LDB(B0, 1, 0); PG8_SCHED; PG8_LDA(At, 1, 0); PG8_STAGE(PG8_SA(0, 1), a2 + hstep, voffA);
            PG8_WAIT_L(8); PG8_BAR; PG8_WAIT_L(0); PG8_MMA(0, 0, At, B0); PG8_BAR; PG8_SCHED;
            PG8_LDB(B1, 1, 1); PG8_STAGE(PG8_SB(1, 0), b3, voffB);
            PG8_BAR; PG8_WAIT_L(0); PG8_MMA(0, 1, At, B1); PG8_BAR;
            PG8_LDA(At, 1, 1); PG8_STAGE(PG8_SA(1, 0), a3, voffA);
            PG8_BAR; PG8_WAIT_L(0); PG8_MMA(1, 0, At, B0); PG8_BAR; PG8_SCHED;
            PG8_STAGE(PG8_SB(1, 1), b3 + hstep, voffB);
            PG8_WAIT_V(6); PG8_BAR; PG8_MMA(1, 1, At, B1); PG8_BAR;
            }
        }
        if constexpr (ALIGN_EPI) { if (wr == 0) PG8_BAR; }
        if constexpr (!Epi::AFTER_DRAIN) { E(acc, cur, wr, wc, fr, fq); S.done(cur); }
        if (!has_next) break;
#pragma unroll
        for (int a = 0; a < 2; ++a)
#pragma unroll
            for (int b = 0; b < 2; ++b)
#pragma unroll
                for (int m = 0; m < 4; ++m)
#pragma unroll
                    for (int n = 0; n < 2; ++n) acc[a][b][m][n] = (f32x4){0.f, 0.f, 0.f, 0.f};
        cur = nxt; cA = nA; cB = nB; ++ui;
        if constexpr (ALIGN_EPI) { if (wr == 1) PG8_BAR; }
    }
    PG8_WAIT_V(0);
    if constexpr (!ALIGN_EPI) { if (wr == 0) PG8_BAR; }
    PG8_BAR;
    if constexpr (Epi::AFTER_DRAIN) { E.fused(acc, cur, wr, wc, fr, fq, lds, wid, lane); S.done(cur); }
#undef PG8_SA
#undef PG8_SB
#undef PG8_STAGE
#undef PG8_LDA
#undef PG8_LDB
#undef PG8_MMA
#undef PG8_WAIT_V
#undef PG8_WAIT_L
#undef PG8_BAR
#undef PG8_SCHED
}
}
#define GAS __attribute__((address_space(1)))
#define LAS __attribute__((address_space(3)))
typedef unsigned short bf16;
typedef unsigned v4u __attribute__((ext_vector_type(4)));
typedef float f32x4 __attribute__((ext_vector_type(4)));
typedef short bf16x8 __attribute__((ext_vector_type(8)));
typedef GAS unsigned gu32;
typedef GAS unsigned long long gu64;
#define RLX_AGENT __ATOMIC_RELAXED, __HIP_MEMORY_SCOPE_AGENT
#define LDS_WAIT() asm volatile("s_waitcnt lgkmcnt(0)" ::: "memory")
#define VM_WAIT() asm volatile("s_waitcnt vmcnt(0)" ::: "memory")
__device__ __forceinline__ unsigned long long rt() { return __builtin_amdgcn_s_memrealtime(); }
__device__ __forceinline__ unsigned f2bf(float f) { unsigned u = __builtin_bit_cast(unsigned, f); return (u + 0x7fffu + ((u >> 16) & 1u)) >> 16; }
__device__ __forceinline__ unsigned pk2(float lo, float hi) { return f2bf(lo) | (f2bf(hi) << 16); }

#define XB_TMO      128
#define XB_XCNT(j)  (256  + 64 * (j))
#define XB_XSUB(j)  (1280 + 64 * (j))
#define XB_XGEN(j)  (2304 + 64 * (j))
#define XB_TOP      3328
#define XB_TOPGEN   3392
#define XCD_BAR_WORDS 3456
#define XB_SPIN_CAP (1u << 22)

__device__ __forceinline__ unsigned xb_ld(unsigned* p)              { return __hip_atomic_load(p, __ATOMIC_RELAXED, __HIP_MEMORY_SCOPE_AGENT); }
__device__ __forceinline__ unsigned xb_add(unsigned* p, unsigned v) { return __hip_atomic_fetch_add(p, v, __ATOMIC_RELAXED, __HIP_MEMORY_SCOPE_AGENT); }
__device__ __forceinline__ unsigned xb_xcc_id() { return (unsigned)__builtin_amdgcn_s_getreg((3 << 11) | 20) & 0xFu; }
#define XB_SPIN(cond, bar) do { unsigned _sp = 0; while (cond) { __builtin_amdgcn_s_sleep(1); \
    if ((++_sp & 255u) == 0u) { if (xb_ld(&(bar)[XB_TMO])) break; if (_sp > XB_SPIN_CAP) { atomicAdd(&(bar)[XB_TMO], 1u); break; } } } } while (0)

struct XcdBarrier {
    unsigned* bar; unsigned x;
    volatile LAS unsigned* st;
};

__device__ __forceinline__ XcdBarrier xcd_barrier_post(unsigned* bar, volatile LAS unsigned* st) {
    XcdBarrier b; b.bar = bar; b.x = xb_xcc_id(); b.st = st;
    if (threadIdx.x == 0) (void)xb_add(&bar[XB_XCNT(b.x)], 1u);
    return b;
}
__device__ __forceinline__ void xcd_barrier_complete(unsigned* bar, unsigned x, unsigned& nloc, unsigned& nx) {
    const unsigned G = gridDim.x * gridDim.y * gridDim.z;
    unsigned sum, cnt, mine, sp = 0u;
    for (;;) {
        sum = 0u; cnt = 0u; mine = 0u;
#pragma unroll
        for (unsigned j = 0; j < 16; ++j) { const unsigned c = xb_ld(&bar[XB_XCNT(j)]); sum += c; cnt += (c > 0u) ? 1u : 0u; mine = (j == x) ? c : mine; }
        if (sum == G) break;
        __builtin_amdgcn_s_sleep(1);
        if ((++sp & 255u) == 0u) { if (xb_ld(&bar[XB_TMO])) break; if (sp > XB_SPIN_CAP) { atomicAdd(&bar[XB_TMO], 1u); break; } }
    }
    nloc = mine > 0u ? mine : 1u; nx = cnt > 0u ? cnt : 1u;
}

__device__ __forceinline__ void xcd_barrier(const XcdBarrier& b) {
    asm volatile("s_waitcnt vmcnt(0)" ::: "memory");
    __syncthreads();
    if (threadIdx.x == 0) {
        unsigned* bar = b.bar;
        __builtin_amdgcn_s_waitcnt(0);
        unsigned nloc = b.st[0], nx = b.st[1];
        if (nloc == 0u) { xcd_barrier_complete(bar, b.x, nloc, nx); b.st[0] = nloc; b.st[1] = nx; }
        const unsigned old = xb_add(&bar[XB_XSUB(b.x)], 1u);
        const unsigned gen = old / nloc;
        if (old + 1u == (gen + 1u) * nloc) {
            __builtin_amdgcn_fence(__ATOMIC_RELEASE, "agent");
            asm volatile("s_waitcnt vmcnt(0)" ::: "memory");
            const unsigned og = xb_add(&bar[XB_TOP], 1u);
            const unsigned tg = og / nx;
            if (og + 1u == (tg + 1u) * nx) xb_add(&bar[XB_TOPGEN], 1u);
            else XB_SPIN(xb_ld(&bar[XB_TOPGEN]) == tg, bar);
            __builtin_amdgcn_fence(__ATOMIC_ACQUIRE, "agent");
            xb_add(&bar[XB_XGEN(b.x)], 1u);
            asm volatile("s_waitcnt vmcnt(0)" ::: "memory");
        } else {
            XB_SPIN(xb_ld(&bar[XB_XGEN(b.x)]) == gen, bar);
            __builtin_amdgcn_fence(__ATOMIC_ACQUIRE, "agent");
            asm volatile("s_waitcnt vmcnt(0)" ::: "memory");
        }
    }
    __syncthreads();
}

typedef unsigned u32x4 __attribute__((ext_vector_type(4)));
typedef unsigned u32x2 __attribute__((ext_vector_type(2)));
typedef short s16x4 __attribute__((ext_vector_type(4)));
typedef float f32x2t __attribute__((ext_vector_type(2)));
typedef __bf16 bf16x2t __attribute__((ext_vector_type(2)));
#define DI __device__ __forceinline__
DI unsigned cvtpk(float lo, float hi) { f32x2t v = {lo, hi}; bf16x2t b = __builtin_convertvector(v, bf16x2t); return __builtin_bit_cast(unsigned, b); }
DI float bflo(unsigned w) { return __uint_as_float(w << 16); }
DI float bfhi(unsigned w) { return __uint_as_float(w & 0xffff0000u); }
DI s16x4 tr_read(LAS unsigned char* p) { return __builtin_bit_cast(s16x4, __builtin_amdgcn_ds_read_tr16_b64_v4i16((LAS s16x4*)p)); }
DI bf16x8 cat8(s16x4 lo, s16x4 hi) { return (bf16x8){lo[0], lo[1], lo[2], lo[3], hi[0], hi[1], hi[2], hi[3]}; }
DI int fresh_tid(int wave_id) { unsigned ones = ~0u; asm volatile("" : "+s"(ones)); int t = wave_id * 64 + (int)__builtin_amdgcn_mbcnt_hi(ones, __builtin_amdgcn_mbcnt_lo(ones, 0u)); asm volatile("" : "+v"(t)); return t; }
#define MFMA16(a, b, c) __builtin_amdgcn_mfma_f32_16x16x32_bf16((a), (b), (c), 0, 0, 0)
DI float wave_sum(float v) {
#pragma unroll
    for (int o = 1; o < 64; o <<= 1) v += __shfl_xor(v, o);
    return v;
}

struct Frame {
    LAS unsigned char* lds;
    volatile LAS unsigned* MISC;
    gu32* ctl;
    int G, wave_id;
    unsigned char* ws;
    const float* const* in;
};

DI int perm_pairs(int p, int half) {
    const int g = p >> 3, r = p & 7; return (r < 4) ? 4 * g + r : half + 4 * g + (r - 4);
}
DI int inmap(int np) {
    if (np < 1024) { const int head = np >> 7, p = np & 127; return head * 128 + (p < 32 ? perm_pairs(p, 16) : p); }
    if (np < 1280) { const int c = np - 1024; if (c < 128) return 1024 + (c < 32 ? perm_pairs(c, 16) : c); return 1152 + (c - 128); }
    if (np < 2304) { const int q = np - 1280, head = q >> 6, p = q & 63; return 1280 + head * 64 + (p < 16 ? perm_pairs(p, 8) : p); }
    if (np < 2560) { const int c = np - 2304; if (c < 64) return 2304 + (c < 16 ? perm_pairs(c, 8) : c); if (c < 80) return 2368 + (c - 64); return -1; }
    if (np < 3584) { const int q = np - 2560, which = q >> 9, qq = q & 511, head = qq >> 6, p = qq & 63; return (which ? 2896 : 2384) + head * 64 + perm_pairs(p, 32); }
    if (np < 4608) return 3408 + (np - 3584);
    return 4432 + (np - 4608);
}
template <bool INMAP, bool OUT8 = false>
DI void transpose_item(const float* W, int K, int N, int NP, bf16* WT, const float* gain, LAS float* scr, int item, int lane) {
    const int nblk = NP / 64, kb = item / nblk, nb = item % nblk, k0 = 64 * kb, n0 = 64 * nb;
    const int kr = lane >> 4, nq = lane & 15;
    const int np = n0 + 4 * nq; const int L = INMAP ? inmap(np) : np;
    f32x4 v[16];
#pragma unroll
    for (int i = 0; i < 16; ++i) { v[i] = (f32x4){0.f, 0.f, 0.f, 0.f}; if (L >= 0) v[i] = *(const GAS f32x4*)(W + (size_t)(k0 + 4 * i + kr) * N + L); }
#pragma unroll
    for (int i = 0; i < 16; ++i) { const int kk = 4 * i + kr; f32x4 t = v[i]; if (gain) t = t * gain[k0 + kk]; *(LAS f32x4*)(scr + kk * 68 + 4 * nq) = t; }
    LDS_WAIT(); asm volatile("" ::: "memory");
    const int c = lane & 7;
#pragma unroll
    for (int j = 0; j < 8; ++j) { const int n = (lane >> 3) + 8 * j; const LAS float* s = scr + (8 * c) * 68 + n;
        if constexpr (OUT8) { unsigned w0 = 0u, w1 = 0u;
            w0 = __builtin_amdgcn_cvt_pk_fp8_f32(s[0 * 68] * W2_SCALE, s[1 * 68] * W2_SCALE, w0, false); w0 = __builtin_amdgcn_cvt_pk_fp8_f32(s[2 * 68] * W2_SCALE, s[3 * 68] * W2_SCALE, w0, true);
            w1 = __builtin_amdgcn_cvt_pk_fp8_f32(s[4 * 68] * W2_SCALE, s[5 * 68] * W2_SCALE, w1, false); w1 = __builtin_amdgcn_cvt_pk_fp8_f32(s[6 * 68] * W2_SCALE, s[7 * 68] * W2_SCALE, w1, true);
            *(GAS u32x2*)((unsigned char*)WT + (size_t)(n0 + n) * K + k0 + 8 * c) = (u32x2){w0, w1}; }
        else { v4u o; o.x = pk2(s[0 * 68], s[1 * 68]); o.y = pk2(s[2 * 68], s[3 * 68]); o.z = pk2(s[4 * 68], s[5 * 68]); o.w = pk2(s[6 * 68], s[7 * 68]);
            *(GAS v4u*)(WT + (size_t)(n0 + n) * K + k0 + 8 * c) = o; } }
    LDS_WAIT(); asm volatile("" ::: "memory");
}
DI void sincos_rr(float x, float& s, float& c) {
    const float k = rintf(x * 0.15915494309189535f);
    float r = fmaf(-k, 6.28318548202514648f, x); r = fmaf(-k, -1.74845553e-7f, r);
    const float f = r * 0.15915494309189535f;
    s = __builtin_amdgcn_sinf(f); c = __builtin_amdgcn_cosf(f);
}

DI void p0_prologue(Frame& F, const float* x, const int* positions, const float* w_in, const float* w_out, const float* w_ff1, const float* w_ff2, const float* w_ple, const float* w_gate,
                    const float* pre_mix, const float* pre_ff) {
    const int tid = fresh_tid(F.wave_id), lane = tid & 63, wave = __builtin_amdgcn_readfirstlane(tid >> 6);
    LAS float* scr = (LAS float*)(F.lds + RING_OFF + wave * 17408);
    const int gw = blockIdx.x * NWAVES + wave, NGW = F.G * NWAVES;
    constexpr int I_IN = (DM / 64) * (NINP / 64), I_OUT = (DM / 64) * (DM / 64), I_FF1 = (DM / 64) * (DFF / 64), I_FF2 = (DFF / 64) * (DM / 64), I_PLE = (PLE / 64) * (DM / 64), I_GATE = I_OUT;
    static_assert(NWAVES * 17408 <= RING_BYTES, "prologue LDS");
    constexpr int PER_LAYER = I_IN + I_OUT + I_FF1 + I_FF2 + I_PLE + I_GATE;
    for (int it = gw; it < DEPTH * PER_LAYER; it += NGW) {
        const int l = it / PER_LAYER; int r = it % PER_LAYER;
        unsigned char* wl = F.ws + WS_W + (size_t)l * W_LAYER;
        if (r < I_IN)  { transpose_item<true >(w_in  + (size_t)l * DM * NINL, DM, NINL, NINP, (bf16*)(wl + WO_IN),  pre_mix + l * DM, scr, r, lane); continue; } r -= I_IN;
        if (r < I_OUT) { transpose_item<false>(w_out + (size_t)l * DM * DM,   DM, DM,  DM,    (bf16*)(wl + WO_OUT), nullptr,          scr, r, lane); continue; } r -= I_OUT;
        if (r < I_FF1) { transpose_item<false>(w_ff1 + (size_t)l * DM * DFF,  DM, DFF, DFF,   (bf16*)(wl + WO_FF1), pre_ff + l * DM,  scr, r, lane); continue; } r -= I_FF1;
        if (r < I_FF2) { transpose_item<false, true>(w_ff2 + (size_t)l * DFF * DM,  DFF, DM, DM,    (bf16*)(wl + WO_FF2), nullptr,          scr, r, lane); continue; } r -= I_FF2;
        if (r < I_PLE) { transpose_item<false>(w_ple + (size_t)l * PLE * DM,  PLE, DM, DM,    (bf16*)(wl + WO_PLE), nullptr,          scr, r, lane); continue; } r -= I_PLE;
        transpose_item<false>(w_gate + (size_t)l * DM * DM, DM, DM, DM, (bf16*)(wl + WO_GATE), nullptr, scr, r, lane);
    }
    float* rope = (float*)(F.ws + WS_ROPE);
    for (int e = blockIdx.x * (NWAVES * 64) + tid; e < M * 56; e += F.G * NWAVES * 64) {
        const int m = e / 56, i = e % 56; const float pos = (float)positions[m];
        float inv; int co, so;
        if (i < 16)      { inv = __builtin_amdgcn_exp2f(-(float)i * (1.0f / 16.0f) * LOG2_THETA_A);        co = i;             so = 16 + i; }
        else if (i < 24) { inv = __builtin_amdgcn_exp2f(-(float)(i - 16) * (1.0f / 8.0f) * LOG2_THETA_A);  co = 32 + (i - 16); so = 40 + (i - 16); }
        else             { inv = __builtin_amdgcn_exp2f(-(float)(i - 24) * (1.0f / 32.0f) * LOG2_THETA_R); co = 48 + (i - 24); so = 80 + (i - 24); }
        float s, c; sincos_rr(pos * inv, s, c);
        rope[(size_t)m * ROPE_W + co] = c; rope[(size_t)m * ROPE_W + so] = s;
    }
    bf16* HB = (bf16*)(F.ws + WS_HB); float* RS = (float*)(F.ws + WS_RS);
    for (int row = gw; row < M; row += NGW) {
        const GAS f32x4* xr = (const GAS f32x4*)(x + (size_t)row * DM) + lane; GAS u32x2* hb = (GAS u32x2*)(HB + (size_t)row * DM) + lane; float ss = 0.f;
#pragma unroll
        for (int j = 0; j < 8; ++j) { const f32x4 v = xr[64 * j]; ss += (v.x * v.x + v.y * v.y) + (v.z * v.z + v.w * v.w); u32x2 o; o.x = cvtpk(v.x, v.y); o.y = cvtpk(v.z, v.w); hb[64 * j] = o; }
        ss = wave_sum(ss);
        if (lane == 0) RS[row] = 1.0f / sqrtf(ss * (1.0f / DM) + RMS_EPS);
    }
}

DI void thin_phase(Frame& F, float* fout, const float* wpost, const float* pconv) {
    const int tid = fresh_tid(F.wave_id), lane = tid & 63, wave = __builtin_amdgcn_readfirstlane(tid >> 6);
    const int gw = blockIdx.x * NWAVES + wave, NGW = F.G * NWAVES;
    const bf16* Y = (const bf16*)(F.ws + WS_Y); const float* SS = (const float*)(F.ws + WS_SS); bf16* HB = (bf16*)(F.ws + WS_HB); float* RS = (float*)(F.ws + WS_RS);
    bf16* PB = (bf16*)(F.ws + WS_BIG + BO_PB);
    f32x4 w[8];
#pragma unroll
    for (int j = 0; j < 8; ++j) w[j] = *((const GAS f32x4*)wpost + lane + 64 * j);
    for (int row = gw; row < M; row += NGW) {
        float q = (lane < 32) ? SS[(size_t)row * 32 + lane] : 0.f; q = wave_sum(q);
        const float rstd = 1.0f / sqrtf(q * (1.0f / DM) + RMS_EPS);
        const GAS u32x2* yr = (const GAS u32x2*)(Y + (size_t)row * DM) + lane; GAS u32x2* hb = (GAS u32x2*)(HB + (size_t)row * DM) + lane; float ss = 0.f;
        u32x2 hv[8], yv[8];
#pragma unroll
        for (int j = 0; j < 8; ++j) { hv[j] = hb[64 * j]; yv[j] = yr[64 * j]; }
#pragma unroll
        for (int j = 0; j < 8; ++j) { f32x4 h;
            h.x = bflo(hv[j].x) + bflo(yv[j].x) * rstd * w[j].x; h.y = bfhi(hv[j].x) + bfhi(yv[j].x) * rstd * w[j].y; h.z = bflo(hv[j].y) + bflo(yv[j].y) * rstd * w[j].z; h.w = bfhi(hv[j].y) + bfhi(yv[j].y) * rstd * w[j].w;
            if (fout) { *((GAS f32x4*)(fout + (size_t)row * DM) + lane + 64 * j) = h; }
            else { u32x2 o; o.x = cvtpk(h.x, h.y); o.y = cvtpk(h.z, h.w); hb[64 * j] = o;
                   const float rx = bflo(o.x), ry = bfhi(o.x), rz = bflo(o.y), rw = bfhi(o.y); ss += (rx * rx + ry * ry) + (rz * rz + rw * rw); } }
        if (!fout) { ss = wave_sum(ss); if (lane == 0) RS[row] = 1.0f / sqrtf(ss * (1.0f / DM) + RMS_EPS); }
        if (pconv) { const f32x4 pv = *((const GAS f32x4*)(pconv + (size_t)row * PLE) + lane); u32x2 o; o.x = cvtpk(pv.x, pv.y); o.y = cvtpk(pv.z, pv.w); *((GAS u32x2*)(PB + (size_t)row * PLE) + lane) = o; }
    }
}

constexpr int ATT_WL = 16384 + 512;
constexpr int RET_KST = 144, RET_VST = 288, RET_K = 0, RET_V = 128 * RET_KST, RET_R = RET_V + 128 * RET_VST, RET_BYTES = RET_R + 128 * RET_KST;
static_assert(NWAVES * ATT_WL <= RING_BYTES && RET_BYTES <= RING_BYTES, "mixer LDS");
constexpr int N_RET_ITEMS = BATCH * 8, N_ATT_ITEMS = BATCH * (SEQ / NWAVES), N_MIX_ITEMS = N_RET_ITEMS + N_ATT_ITEMS;

DI void dma16(const void* g, LAS unsigned char* l) { __builtin_amdgcn_global_load_lds((const unsigned*)g, (LAS unsigned*)l, 16, 0, 0); }
#define VMW(n) asm volatile("s_waitcnt vmcnt(" #n ")" ::: "memory")
#ifndef PROF_SEC
#define PROF_SEC 0
#endif
#define PROF_T() ((unsigned)__builtin_amdgcn_s_memrealtime())
#define PROF_BEGIN(k) unsigned pt_##k = 0; if (PROF_SEC == (k)) pt_##k = PROF_T();
#define PROF_END(k) if (PROF_SEC == (k)) pacc += PROF_T() - pt_##k;
DI void attn_item(LAS unsigned char* ring, unsigned char* ws, int b, int t0, int lane, int wave, unsigned& pacc) {
    const int g = lane >> 4, c = lane & 15;
    const int t = t0 + wave;
    LAS unsigned char* wl = ring + wave * 16384;
    const bf16* AQ = (const bf16*)(ws + WS_BIG + BO_AQ); const bf16* AKV = (const bf16*)(ws + WS_BIG + BO_AKV); const bf16* IQ = (const bf16*)(ws + WS_BIG + BO_IQ);
    const bf16* IK = (const bf16*)(ws + WS_BIG + BO_IK); const float* IW = (const float*)(ws + WS_BIG + BO_IW); bf16* MIX = (bf16*)(ws + WS_BIG + BO_MIX);
    const size_t m = (size_t)b * SEQ + t; const size_t brow = (size_t)b * SEQ;
    LAS unsigned short* idx = (LAS unsigned short*)(ring + 131072 + 512 * wave);
    const int nk = t + 1; int nsel;
    if (t0 >= 256) {
        PROF_BEGIN(1)
        const bf16* iqp = IQ + m * 1024 + c * 64 + 8 * g;
        const bf16x8 a0 = *(const bf16x8*)iqp, a1 = *(const bf16x8*)(iqp + 32);
        const f32x4 w4 = *(const f32x4*)(IW + m * 16 + 4 * g);
        u32x4 wfu; wfu.x = cvtpk(w4.x, w4.y); wfu.y = cvtpk(w4.z, w4.w); wfu.z = 0u; wfu.w = 0u;
        const bf16x8 wfrag = __builtin_bit_cast(bf16x8, wfu); const bf16x8 zfrag = (bf16x8){0, 0, 0, 0, 0, 0, 0, 0};
        asm volatile("s_waitcnt vmcnt(0)" :: "v"(a0), "v"(a1), "v"(wfrag) : "memory");
        const int nchunk = (t0 + 8 + 255) >> 8;
        const int r8 = lane >> 3, s8 = lane & 7;
#define ISSUE_IK(k) do { _Pragma("unroll") for (int i_ = 0; i_ < 4; ++i_) { const int row_ = 32 * wave + 8 * i_; \
            dma16(IK + (brow + 256 * (k) + row_ + r8) * 64 + 8 * (s8 ^ (((row_ + r8) >> 1) & 7)), ring + ((k) & 3) * 32768 + 128 * row_); } } while (0)
#pragma unroll
        for (int k = 0; k < 3; ++k) if (k < nchunk) ISSUE_IK(k);
        unsigned u[32];
#pragma unroll
        for (int k = 0; k < 8; ++k) {
            f32x4 d2 = {0.f, 0.f, 0.f, 0.f};
            if (k < nchunk) {
                const int ahead = nchunk - 1 - k;
                if (ahead >= 2) VMW(8); else if (ahead == 1) VMW(4); else VMW(0);
                __builtin_amdgcn_s_barrier();
                asm volatile("" ::: "memory");
                if (k + 3 < nchunk) ISSUE_IK(k + 3);
                int cc = c; asm volatile("" : "+v"(cc));
                const LAS unsigned char* kbase = ring + (k & 3) * 32768 + 128 * cc;
#pragma unroll
                for (int j = 0; j < 16; ++j) {
                    if (256 * k + 16 * j <= t0 + 7) {
                        const LAS unsigned char* kp = kbase + 2048 * j;
                        const int sw = ((16 * j + cc) >> 1) & 7;
                        const bf16x8 kb0 = *(const LAS bf16x8*)(kp + 16 * (g ^ sw)), kb1 = *(const LAS bf16x8*)(kp + 16 * ((4 + g) ^ sw));
                        f32x4 d = {0.f, 0.f, 0.f, 0.f};
                        d = MFMA16(a0, kb0, d); d = MFMA16(a1, kb1, d);
                        u32x4 ru; ru.x = cvtpk(fmaxf(d.x, 0.f), fmaxf(d.y, 0.f)); ru.y = cvtpk(fmaxf(d.z, 0.f), fmaxf(d.w, 0.f)); ru.z = 0u; ru.w = 0u;
                        d2 = MFMA16((cc == j) ? wfrag : zfrag, __builtin_bit_cast(bf16x8, ru), d2);
                    }
                }
            }
#pragma unroll
            for (int r = 0; r < 4; ++r) { const int key = 256 * k + 16 * (4 * g + r) + c; const unsigned bb = __float_as_uint(d2[r]); const unsigned ok = (bb & 0x80000000u) ? ~bb : (bb | 0x80000000u); u[4 * k + r] = (key < nk) ? ok : 0u; }
        }
        asm volatile("s_waitcnt lgkmcnt(0)" ::: "memory");
        __builtin_amdgcn_s_barrier();
        asm volatile("" ::: "memory");
#undef ISSUE_IK
        PROF_END(1)
        PROF_BEGIN(2)
        const int nb4 = 4 * ((t >> 8) + 1);
        unsigned T = 0u;
        for (int bit = 31; bit >= 0; --bit) {
            const unsigned cand = T | (1u << bit); int cnt = 0;
#pragma unroll
            for (int i = 0; i < 32; i += 8) if (i < nb4) {
                unsigned long long m0, m1, m2, m3, m4, m5, m6, m7;
                asm("v_cmp_ge_u32_e64 %0, %8, %16\n\tv_cmp_ge_u32_e64 %1, %9, %16\n\tv_cmp_ge_u32_e64 %2, %10, %16\n\tv_cmp_ge_u32_e64 %3, %11, %16\n\t"
                    "v_cmp_ge_u32_e64 %4, %12, %16\n\tv_cmp_ge_u32_e64 %5, %13, %16\n\tv_cmp_ge_u32_e64 %6, %14, %16\n\tv_cmp_ge_u32_e64 %7, %15, %16"
                    : "=&s"(m0), "=&s"(m1), "=&s"(m2), "=&s"(m3), "=&s"(m4), "=&s"(m5), "=&s"(m6), "=&s"(m7)
                    : "v"(u[i]), "v"(u[i + 1]), "v"(u[i + 2]), "v"(u[i + 3]), "v"(u[i + 4]), "v"(u[i + 5]), "v"(u[i + 6]), "v"(u[i + 7]), "v"(cand));
                cnt += ((__popcll(m0) + __popcll(m1)) + (__popcll(m2) + __popcll(m3))) + ((__popcll(m4) + __popcll(m5)) + (__popcll(m6) + __popcll(m7)));
            }
            if (cnt >= 256) T = cand;
            if (cnt == 256) break;
        }
        int cntT = 0;
        unsigned long long mge[32];
#pragma unroll
        for (int i = 0; i < 32; i += 8) if (i < nb4) {
            asm("v_cmp_ge_u32_e64 %0, %8, %16\n\tv_cmp_ge_u32_e64 %1, %9, %16\n\tv_cmp_ge_u32_e64 %2, %10, %16\n\tv_cmp_ge_u32_e64 %3, %11, %16\n\t"
                "v_cmp_ge_u32_e64 %4, %12, %16\n\tv_cmp_ge_u32_e64 %5, %13, %16\n\tv_cmp_ge_u32_e64 %6, %14, %16\n\tv_cmp_ge_u32_e64 %7, %15, %16"
                : "=&s"(mge[i]), "=&s"(mge[i + 1]), "=&s"(mge[i + 2]), "=&s"(mge[i + 3]), "=&s"(mge[i + 4]), "=&s"(mge[i + 5]), "=&s"(mge[i + 6]), "=&s"(mge[i + 7])
                : "v"(u[i]), "v"(u[i + 1]), "v"(u[i + 2]), "v"(u[i + 3]), "v"(u[i + 4]), "v"(u[i + 5]), "v"(u[i + 6]), "v"(u[i + 7]), "v"(T));
#pragma unroll
            for (int j = 0; j < 8; ++j) cntT += __popcll(mge[i + j]);
        } else {
#pragma unroll
            for (int j = 0; j < 8; ++j) mge[i + j] = 0ull;
        }
        if (cntT == 256) {
            int base = 0;
#pragma unroll
            for (int i = 0; i < 32; ++i) if ((i & ~7) < nb4) {
                const unsigned long long ms = mge[i];
                const int pos = (int)__builtin_amdgcn_mbcnt_hi((unsigned)(ms >> 32), __builtin_amdgcn_mbcnt_lo((unsigned)ms, (unsigned)base));
                if ((ms >> lane) & 1ull) idx[pos] = (unsigned short)(256 * (i >> 2) + 16 * (4 * g + (i & 3)) + c);
                base += __popcll(ms);
            }
        } else {
            int cgt = 0;
#pragma unroll
            for (int i = 0; i < 32; ++i) if ((i & ~7) < nb4) cgt += __popcll(__ballot(u[i] > T));
            const int quota = 256 - cgt;
            const unsigned long long lt = (1ull << lane) - 1ull;
            int base = 0, eqrun = 0;
#pragma unroll
            for (int i = 0; i < 32; ++i) if ((i & ~7) < nb4) {
                const bool gt = u[i] > T, eq = u[i] == T;
                const unsigned long long meq = __ballot(eq);
                const int eqrank = eqrun + __popcll(meq & lt);
                const bool sel = gt || (eq && eqrank < quota);
                const unsigned long long ms = __ballot(sel);
                if (sel) idx[base + __popcll(ms & lt)] = (unsigned short)(256 * (i >> 2) + 16 * (4 * g + (i & 3)) + c);
                base += __popcll(ms); eqrun += __popcll(meq);
            }
        }
        PROF_END(2)
        nsel = 256;
    } else {
#pragma unroll
        for (int r = 0; r < 4; ++r) { const int j = lane + 64 * r; idx[j] = (unsigned short)(j < nk ? j : 0); }
        nsel = nk;
    }
    LDS_WAIT(); __builtin_amdgcn_wave_barrier();
    PROF_BEGIN(3)
    int lane3 = lane; asm volatile("" : "+v"(lane3));
    const int G3 = lane3 >> 4, C3 = lane3 & 15;
    bf16x8 qf[4];
#pragma unroll
    for (int ks = 0; ks < 4; ++ks) { qf[ks] = (bf16x8){0, 0, 0, 0, 0, 0, 0, 0}; if (C3 < 8) qf[ks] = *(const bf16x8*)(AQ + m * 1024 + C3 * 128 + 32 * ks + 8 * G3); }
    asm volatile("s_waitcnt vmcnt(0)" :: "v"(qf[0]), "v"(qf[1]), "v"(qf[2]), "v"(qf[3]) : "memory");
    const int ntile = (nsel + 15) >> 4;
#define ISSUE_K(kt) do { const u32x2 iw_ = *(const LAS u32x2*)(idx + 16 * (kt) + 4 * G3); \
        _Pragma("unroll") for (int i_ = 0; i_ < 4; ++i_) { const int r_ = 4 * i_ + G3; const int key_ = (int)(((i_ & 2) ? iw_.y : iw_.x) >> (16 * (i_ & 1))) & 0xffff; \
        dma16(AKV + (brow + key_) * 256 + 8 * (C3 ^ r_), wl + ((kt) & 3) * 4096 + 1024 * i_); } } while (0)
#pragma unroll
    for (int kt = 0; kt < 4; ++kt) if (kt < ntile) ISSUE_K(kt);
    f32x4 s[16];
#pragma unroll
    for (int kt = 0; kt < 16; ++kt) {
        s[kt] = (f32x4){-INFINITY, -INFINITY, -INFINITY, -INFINITY};
        if (kt < ntile) {
            const int ahead = ntile - 1 - kt;
            if (ahead >= 3) VMW(12); else if (ahead == 2) VMW(8); else if (ahead == 1) VMW(4); else VMW(0);
            const LAS unsigned char* kp = wl + (kt & 3) * 4096 + 256 * C3;
            bf16x8 ka[4];
#pragma unroll
            for (int ks = 0; ks < 4; ++ks) ka[ks] = *(const LAS bf16x8*)(kp + 16 * ((4 * ks + G3) ^ C3));
            f32x4 d = {0.f, 0.f, 0.f, 0.f};
#pragma unroll
            for (int ks = 0; ks < 4; ++ks) d = MFMA16(ka[ks], qf[ks], d);
#pragma unroll
            for (int r = 0; r < 4; ++r) s[kt][r] = (16 * kt + 4 * r + G3 < nsel) ? d[r] : -INFINITY;
            asm volatile("" :: "v"(d) : "memory");
            if (kt + 4 < ntile) ISSUE_K(kt + 4);
        }
    }
    const int nstep = (nsel + 31) >> 5;
#define ISSUE_V(st) do { const u32x2 ia_ = *(const LAS u32x2*)(idx + 32 * (st) + 4 * G3), ib_ = *(const LAS u32x2*)(idx + 32 * (st) + 16 + 4 * G3); \
        _Pragma("unroll") for (int i_ = 0; i_ < 8; ++i_) { const int r_ = 4 * i_ + G3; const u32x2 iw_ = (i_ & 4) ? ib_ : ia_; const int key_ = (int)(((i_ & 2) ? iw_.y : iw_.x) >> (16 * (i_ & 1))) & 0xffff; \
        dma16(AKV + (brow + key_) * 256 + 128 + 8 * (C3 ^ (2 * (r_ & 7))), wl + ((st) & 1) * 8192 + 1024 * i_); } } while (0)
    ISSUE_V(0);
    if (nstep > 1) ISSUE_V(1);
    float mx = -INFINITY;
#pragma unroll
    for (int kt = 0; kt < 16; ++kt) mx = fmaxf(fmaxf(mx, fmaxf(s[kt][0], s[kt][1])), fmaxf(s[kt][2], s[kt][3]));
    mx = fmaxf(mx, __shfl_xor(mx, 16)); mx = fmaxf(mx, __shfl_xor(mx, 32));
    float l = 0.f;
#pragma unroll
    for (int kt = 0; kt < 16; ++kt)
#pragma unroll
        for (int r = 0; r < 4; ++r) { const float p = __builtin_amdgcn_exp2f(s[kt][r] - mx); s[kt][r] = p; l += p; }
    l += __shfl_xor(l, 16); l += __shfl_xor(l, 32);
    const float inv = 1.0f / l;
    f32x4 o[8];
#pragma unroll
    for (int dt = 0; dt < 8; ++dt) o[dt] = (f32x4){0.f, 0.f, 0.f, 0.f};
    const int q4 = C3 >> 2, p4 = C3 & 3, r0 = 4 * G3 + q4;
#pragma unroll
    for (int st = 0; st < 8; ++st) {
        if (st < nstep) {
            if (st + 1 < nstep) VMW(8); else VMW(0);
            u32x4 pw; pw.x = cvtpk(s[2 * st][0], s[2 * st][1]); pw.y = cvtpk(s[2 * st][2], s[2 * st][3]); pw.z = cvtpk(s[2 * st + 1][0], s[2 * st + 1][1]); pw.w = cvtpk(s[2 * st + 1][2], s[2 * st + 1][3]);
            const bf16x8 pb = __builtin_bit_cast(bf16x8, pw);
            const unsigned vb = (unsigned)(uintptr_t)(wl + (st & 1) * 8192 + 256 * r0 + 8 * (p4 & 1));
            s16x4 lo[8], hi[8];
#pragma unroll
            for (int dt = 0; dt < 8; ++dt) {
                const unsigned pos = vb + 16 * ((2 * dt + (p4 >> 1)) ^ (2 * (r0 & 7)));
                asm volatile("ds_read_b64_tr_b16 %0, %1" : "=&v"(lo[dt]) : "v"(pos) : "memory");
                asm volatile("ds_read_b64_tr_b16 %0, %1 offset:4096" : "=&v"(hi[dt]) : "v"(pos) : "memory");
            }
            asm volatile("s_waitcnt lgkmcnt(0)" : "+v"(lo[0]), "+v"(lo[1]), "+v"(lo[2]), "+v"(lo[3]), "+v"(lo[4]), "+v"(lo[5]), "+v"(lo[6]), "+v"(lo[7]),
                                                  "+v"(hi[0]), "+v"(hi[1]), "+v"(hi[2]), "+v"(hi[3]), "+v"(hi[4]), "+v"(hi[5]), "+v"(hi[6]), "+v"(hi[7]) :: "memory");
#pragma unroll
            for (int dt = 0; dt < 8; ++dt) o[dt] = MFMA16(cat8(lo[dt], hi[dt]), pb, o[dt]);
            asm volatile("" :: "v"(o[7]) : "memory");
            if (st + 2 < nstep) ISSUE_V(st + 2);
        }
    }
    if (C3 < 8) {
        bf16* op = MIX + m * 2048 + C3 * 128 + 4 * G3;
#pragma unroll
        for (int dt = 0; dt < 8; ++dt) { u32x2 w; w.x = cvtpk(o[dt][0] * inv, o[dt][1] * inv); w.y = cvtpk(o[dt][2] * inv, o[dt][3] * inv); *(u32x2*)(op + 16 * dt) = w; }
    }
    PROF_END(3)
#undef ISSUE_K
#undef ISSUE_V
}

DI void ret_chain(Frame& F, int b, int h, const float* gn) {
    LAS unsigned char* lds = F.lds + RING_OFF; unsigned char* ws = F.ws;
    const bf16* RQ = (const bf16*)(ws + WS_BIG + BO_RQ); const bf16* RK = (const bf16*)(ws + WS_BIG + BO_RK); const bf16* RV = (const bf16*)(ws + WS_BIG + BO_RV);
    const bf16* RG = (const bf16*)(ws + WS_BIG + BO_RG); bf16* MIX = (bf16*)(ws + WS_BIG + BO_MIX);
    const int tid = fresh_tid(F.wave_id), lane = tid & 63, w = __builtin_amdgcn_readfirstlane(tid >> 6), g = lane >> 4, c = lane & 15, q4 = c >> 2, p4 = c & 3;
    const float lg = pg8::log2_gamma(h);
    const int i = 16 * w + c;
    const float xi = __builtin_amdgcn_exp2f((float)(i + 1) * lg), fi = __builtin_amdgcn_exp2f((float)(i - 127) * lg), gC = __builtin_amdgcn_exp2f(128.0f * lg);
    f32x4 RT[4];
#pragma unroll
    for (int dt = 0; dt < 4; ++dt) RT[dt] = (f32x4){0.f, 0.f, 0.f, 0.f};
    for (int ch = 0; ch < 16; ++ch) {
        const size_t row0 = (size_t)b * SEQ + 128 * ch;
        __syncthreads();
#pragma unroll
        for (int r = 0; r < 2; ++r) { const int row = (tid >> 3) + 64 * r, ck = tid & 7; *(LAS u32x4*)(lds + RET_K + row * RET_KST + 16 * ck) = *(const u32x4*)(RK + (row0 + row) * 512 + h * 64 + 8 * ck); }
#pragma unroll
        for (int r = 0; r < 4; ++r) { const int row = (tid >> 4) + 32 * r, ck = tid & 15; *(LAS u32x4*)(lds + RET_V + row * RET_VST + 16 * ck) = *(const u32x4*)(RV + (row0 + row) * 1024 + h * 128 + 8 * ck); }
#pragma unroll
        for (int dt = 0; dt < 4; ++dt)
#pragma unroll
            for (int r = 0; r < 4; ++r) *(LAS unsigned short*)(lds + RET_R + (16 * w + 4 * g + r) * RET_KST + 2 * (16 * dt + c)) = (unsigned short)f2bf(RT[dt][r]);
        __syncthreads();
        const bf16* qp = RQ + (row0 + i) * 512 + h * 64 + 8 * g;
        const bf16x8 qb0 = *(const bf16x8*)qp, qb1 = *(const bf16x8*)(qp + 32);
        f32x4 o[8];
#pragma unroll
        for (int vt = 0; vt < 8; ++vt) o[vt] = (f32x4){0.f, 0.f, 0.f, 0.f};
        if (ch > 0) {
#pragma unroll
            for (int vt = 0; vt < 8; ++vt) {
                const LAS unsigned char* rp = lds + RET_R + (16 * vt + c) * RET_KST + 16 * g;
                o[vt] = MFMA16(*(const LAS bf16x8*)rp, qb0, o[vt]); o[vt] = MFMA16(*(const LAS bf16x8*)(rp + 64), qb1, o[vt]);
            }
#pragma unroll
            for (int vt = 0; vt < 8; ++vt) o[vt] = o[vt] * xi;
        }
#pragma unroll
        for (int st = 0; st < 4; ++st) {
            if (2 * st <= w) {
                f32x4 d0 = {0.f, 0.f, 0.f, 0.f}, d1 = {0.f, 0.f, 0.f, 0.f};
                { const LAS unsigned char* kp = lds + RET_K + (32 * st + c) * RET_KST + 16 * g;
                  d0 = MFMA16(*(const LAS bf16x8*)kp, qb0, d0); d0 = MFMA16(*(const LAS bf16x8*)(kp + 64), qb1, d0);
                  d1 = MFMA16(*(const LAS bf16x8*)(kp + 16 * RET_KST), qb0, d1); d1 = MFMA16(*(const LAS bf16x8*)(kp + 16 * RET_KST + 64), qb1, d1); }
#pragma unroll
                for (int r = 0; r < 4; ++r) { const int j0 = 32 * st + 4 * g + r; d0[r] = (j0 <= i) ? d0[r] * fi : 0.f; d1[r] = (j0 + 16 <= i) ? d1[r] * fi : 0.f; }
                u32x4 pw; pw.x = cvtpk(d0[0], d0[1]); pw.y = cvtpk(d0[2], d0[3]); pw.z = cvtpk(d1[0], d1[1]); pw.w = cvtpk(d1[2], d1[3]);
                const bf16x8 pb = __builtin_bit_cast(bf16x8, pw);
                LAS unsigned char* vb = lds + RET_V + (32 * st + 4 * g + q4) * RET_VST + 8 * p4;
#pragma unroll
                for (int vt = 0; vt < 8; ++vt) {
                    const s16x4 lo = tr_read(vb + 32 * vt), hi = tr_read(vb + 16 * RET_VST + 32 * vt);
                    o[vt] = MFMA16(cat8(lo, hi), pb, o[vt]);
                }
            }
        }
        {
            float sm = 0.f;
#pragma unroll
            for (int vt = 0; vt < 8; ++vt) sm += (o[vt][0] + o[vt][1]) + (o[vt][2] + o[vt][3]);
            sm += __shfl_xor(sm, 16); sm += __shfl_xor(sm, 32);
            const float mu = sm * (1.0f / 128.0f); float vq = 0.f;
#pragma unroll
            for (int vt = 0; vt < 8; ++vt) { const f32x4 dd = o[vt] - mu; vq += (dd[0] * dd[0] + dd[1] * dd[1]) + (dd[2] * dd[2] + dd[3] * dd[3]); }
            vq += __shfl_xor(vq, 16); vq += __shfl_xor(vq, 32);
            const float rstd = 1.0f / sqrtf(vq * (1.0f / 128.0f) + GN_EPS);
            const size_t mrow = row0 + i;
#pragma unroll
            for (int vt = 0; vt < 8; ++vt) {
                const int v0 = h * 128 + 16 * vt + 4 * g;
                const f32x4 gw = *(const f32x4*)(gn + v0); const u32x2 gt = *(const u32x2*)(RG + mrow * 1024 + v0);
                const float y0 = (o[vt][0] - mu) * rstd * gw[0] * bflo(gt.x), y1 = (o[vt][1] - mu) * rstd * gw[1] * bfhi(gt.x), y2 = (o[vt][2] - mu) * rstd * gw[2] * bflo(gt.y), y3 = (o[vt][3] - mu) * rstd * gw[3] * bfhi(gt.y);
                u32x2 ow; ow.x = cvtpk(y0, y1); ow.y = cvtpk(y2, y3); *(u32x2*)(MIX + mrow * 2048 + 1024 + v0) = ow;
            }
        }
#pragma unroll
        for (int dt = 0; dt < 4; ++dt) RT[dt] = RT[dt] * gC;
#pragma unroll
        for (int st = 0; st < 4; ++st) {
            LAS unsigned char* vb = lds + RET_V + (32 * st + 8 * g + q4) * RET_VST + 32 * w + 8 * p4;
            const bf16x8 va = cat8(tr_read(vb), tr_read(vb + 4 * RET_VST));
            LAS unsigned char* kp = lds + RET_K + (32 * st + 8 * g + q4) * RET_KST + 8 * p4;
#pragma unroll
            for (int dt = 0; dt < 4; ++dt) { const bf16x8 kbf = cat8(tr_read(kp + 32 * dt), tr_read(kp + 4 * RET_KST + 32 * dt)); RT[dt] = MFMA16(va, kbf, RT[dt]); }
        }
    }
    __syncthreads();
}

constexpr int N_Q_ITEMS = 16 + 2 * (SEQ / NWAVES);
DI void mixer_phase(Frame& F, int lq, const float* gn) {
    const int tid = fresh_tid(F.wave_id), lane = tid & 63, wave = __builtin_amdgcn_readfirstlane(tid >> 6);
    unsigned pacc = 0;
    gu32* qbase = F.ctl + CW_Q + 64 * 8 * lq;
    int q = (int)(xb_xcc_id() & 7u);
    unsigned nxt = 0xffffffffu;
    if (tid == 0) nxt = __hip_atomic_fetch_add(qbase + 64 * q, 1u, __ATOMIC_RELAXED, __HIP_MEMORY_SCOPE_AGENT);
    for (;;) {
        if (tid == 0) {
            for (int tries = 0; nxt >= (unsigned)N_Q_ITEMS && tries < 8; ++tries) { q = (q + 1) & 7;
                if (__hip_atomic_load(qbase + 64 * q, __ATOMIC_RELAXED, __HIP_MEMORY_SCOPE_AGENT) < (unsigned)N_Q_ITEMS) nxt = __hip_atomic_fetch_add(qbase + 64 * q, 1u, __ATOMIC_RELAXED, __HIP_MEMORY_SCOPE_AGENT); }
            F.MISC[0] = nxt < (unsigned)N_Q_ITEMS ? nxt : 0xffffffffu; F.MISC[1] = (unsigned)q;
        }
        __syncthreads();
        const unsigned item = F.MISC[0]; const int qi = (int)F.MISC[1];
        __syncthreads();
        if (item == 0xffffffffu) break;
        if (tid == 0) nxt = __hip_atomic_fetch_add(qbase + 64 * q, 1u, __ATOMIC_RELAXED, __HIP_MEMORY_SCOPE_AGENT);
        if (item < 16u) { PROF_BEGIN(4) ret_chain(F, 2 * qi + (int)(item >> 3), (int)(item & 7u), gn); PROF_END(4) }
        else { const int ia = (int)item - 16; const int tb = (SEQ / NWAVES - 1) - (ia >> 1), b = 2 * qi + (ia & 1);
            PROF_BEGIN(5) attn_item(F.lds + RING_OFF, F.ws, b, tb * NWAVES, lane, wave, pacc); PROF_END(5) }
    }
    if (PROF_SEC != 0) { pacc = __builtin_amdgcn_readfirstlane(pacc); const unsigned t0 = PROF_T(); while (PROF_T() - t0 < pacc && pacc < 400000000u) __builtin_amdgcn_s_sleep(4); }
}

#ifndef MK_N_LAUNCHES
#define MK_N_LAUNCHES 1
#endif
constexpr int NPH = 1 + 10 * DEPTH;
constexpr int N_LAUNCHES = MK_N_LAUNCHES;
static_assert(N_LAUNCHES == 1 || N_LAUNCHES == NPH, "MK_N_LAUNCHES must be 1 or NPH");
struct Args { const void* in[15]; float* out; unsigned char* ws; int ph_lo, ph_hi, li, pad; };

__global__ void __launch_bounds__(NWAVES * 64, 2) hyb_fwd(Args args) {
    extern __shared__ __attribute__((aligned(16))) unsigned char lds[];
    Frame F;
    F.lds = (LAS unsigned char*)lds;
    F.MISC = (volatile LAS unsigned*)(F.lds + MISC_OFF);
    F.wave_id = __builtin_amdgcn_readfirstlane((int)(threadIdx.x >> 6));
    F.G = gridDim.x; F.ws = args.ws; F.ctl = (gu32*)(args.ws + WS_CTL); F.in = nullptr;
    for (int u = threadIdx.x; u < (LDS_BYTES - LDSCTL_OFF) / 4; u += NWAVES * 64) ((LAS unsigned*)(F.lds + LDSCTL_OFF))[u] = 0u;
    __syncthreads();
    XcdBarrier bar; bar.bar = (unsigned*)(F.ctl + CW_BAR); bar.x = 0; bar.st = nullptr;
    if (N_LAUNCHES == 1) bar = xcd_barrier_post((unsigned*)(F.ctl + CW_BAR), F.MISC + 8);
    const int lo = args.ph_lo, hi = args.ph_hi;
#ifndef PHASE_MASK
#define PHASE_MASK 0x7ff
#endif
#define PON(j) (((PHASE_MASK) >> (j)) & 1)
#ifndef PROBE_DUP
#define PROBE_DUP 0
#endif
#define DUPN(j) (1 + (((PROBE_DUP) >> (j)) & 1))
#define IN(k) (lo <= (k) && (k) < hi)
#ifndef PROF_PHASE
#define PROF_PHASE 0
#endif
    unsigned pp_acc = 0, pp_t0 = 0;
#define PP_ON(j) ((((PROF_PHASE) >> (j)) & 1) != 0)
#define PP_BEGIN(j) do { if (PP_ON(j)) pp_t0 = (unsigned)__builtin_amdgcn_s_memrealtime(); } while (0)
#define PP_END(j) do { if (PP_ON(j)) pp_acc += (unsigned)__builtin_amdgcn_s_memrealtime() - pp_t0; } while (0)
#define SEAM(k) do { if (N_LAUNCHES == 1 && IN(k) && IN((k) + 1)) xcd_barrier(bar); } while (0)
    volatile LAS unsigned long long* PT = (volatile LAS unsigned long long*)(F.lds + LDSCTL_OFF + 1024);
    if (threadIdx.x < 15) PT[threadIdx.x] = (unsigned long long)(uintptr_t)args.in[threadIdx.x];
    if (threadIdx.x == 15) PT[15] = (unsigned long long)(uintptr_t)args.out;
    if (threadIdx.x == 16) PT[16] = (unsigned long long)(uintptr_t)args.ws;
    __syncthreads();
#define LDP(k) ((const float*)(uintptr_t)(((unsigned long long)(unsigned)__builtin_amdgcn_readfirstlane((int)(unsigned)(PT[k] >> 32)) << 32) | (unsigned long long)(unsigned)__builtin_amdgcn_readfirstlane((int)(unsigned)PT[k])))
#define WSP() ((unsigned char*)LDP(16))
    PP_BEGIN(0);
    if (PON(0) && IN(0)) for (int rep = 0; rep < DUPN(0); ++rep) p0_prologue(F, LDP(0), (const int*)LDP(2), LDP(3), LDP(4), LDP(5), LDP(6), LDP(7), LDP(8), LDP(9), LDP(11));
    SEAM(0); PP_END(0);
    for (int l = 0; l < DEPTH; ++l) {
        const int pb = 1 + 10 * l;
        PP_BEGIN(1);
        if (PON(1) && IN(pb + 0)) for (int rep = 0; rep < DUPN(1); ++rep) {
            unsigned char* ws = WSP(); unsigned char* wl = ws + WS_W + (size_t)l * W_LAYER; unsigned char* big = ws + WS_BIG;
            pg8::Gemm g{(const pg8::bf16_t*)(ws + WS_HB), (const pg8::bf16_t*)(wl + WO_IN), M, NINP, DM}; pg8::StaticOrder S; S.init(M, NINP, F.G, (int)blockIdx.x);
            pg8::EpiIn E{big, (const float*)(ws + WS_RS), (const float*)(ws + WS_ROPE)};
            pg8::gemm_phase<pg8::EpiIn, pg8::StaticOrder, true, true>(F.lds + RING_OFF, g, S, E, F.wave_id);
        }
        SEAM(pb + 0); PP_END(1);
        PP_BEGIN(2);
        if (PON(2) && IN(pb + 1)) for (int rep = 0; rep < DUPN(2); ++rep) mixer_phase(F, l + 2 * rep, LDP(14) + (size_t)l * 1024);
        SEAM(pb + 1); PP_END(2);
        PP_BEGIN(3);
        if (PON(3) && IN(pb + 2)) for (int rep = 0; rep < DUPN(3); ++rep) {
            unsigned char* ws = WSP(); unsigned char* wl = ws + WS_W + (size_t)l * W_LAYER; unsigned char* big = ws + WS_BIG;
            pg8::Gemm g{(const pg8::bf16_t*)(big + BO_MIX), (const pg8::bf16_t*)(wl + WO_OUT), M, DM, DM}; pg8::StaticOrder S; S.init(M, DM, F.G, (int)blockIdx.x);
            pg8::EpiY E{(pg8::bf16_t*)(ws + WS_Y), (float*)(ws + WS_SS), nullptr, 1.0f};
            pg8::gemm_phase<pg8::EpiY, pg8::StaticOrder, true, true>(F.lds + RING_OFF, g, S, E, F.wave_id);
        }
        SEAM(pb + 2); PP_END(3);
        PP_BEGIN(4);
        if (PON(4) && IN(pb + 3)) thin_phase(F, nullptr, LDP(10) + (size_t)l * DM, nullptr);
        SEAM(pb + 3); PP_END(4);
        PP_BEGIN(5);
        if (PON(5) && IN(pb + 4)) for (int rep = 0; rep < DUPN(5); ++rep) {
            unsigned char* ws = WSP(); unsigned char* wl = ws + WS_W + (size_t)l * W_LAYER; unsigned char* big = ws + WS_BIG;
            pg8::Gemm g{(const pg8::bf16_t*)(ws + WS_HB), (const pg8::bf16_t*)(wl + WO_FF1), M, DFF, DM}; pg8::StaticOrder S; S.init(M, DFF, F.G, (int)blockIdx.x);
            pg8::EpiFF1 E{big + BO_HID, (const float*)(ws + WS_RS)};
            pg8::gemm_phase<pg8::EpiFF1, pg8::StaticOrder, true, true>(F.lds + RING_OFF, g, S, E, F.wave_id);
        }
        SEAM(pb + 4); PP_END(5);
        PP_BEGIN(6);
        if (PON(6) && IN(pb + 5)) for (int rep = 0; rep < DUPN(6); ++rep) {
            unsigned char* ws = WSP(); unsigned char* wl = ws + WS_W + (size_t)l * W_LAYER; unsigned char* big = ws + WS_BIG;
            pg8::Gemm g{(const pg8::bf16_t*)(big + BO_HID), (const pg8::bf16_t*)(wl + WO_FF2), M, DM, DFF / 2};
            pg8::StaticOrder S; S.init(M, DM, F.G, (int)blockIdx.x);
            pg8::EpiYT<false> E{(pg8::bf16_t*)(ws + WS_Y), (float*)(ws + WS_SS), nullptr, 1.0f / (HID_SCALE * W2_SCALE)};
            pg8::gemm_phase<pg8::EpiYT<false>, pg8::StaticOrder, true, true, true>(F.lds + RING_OFF, g, S, E, F.wave_id);
        }
        SEAM(pb + 5); PP_END(6);
        PP_BEGIN(7);
        if (PON(7) && IN(pb + 6)) thin_phase(F, nullptr, LDP(12) + (size_t)l * DM, LDP(1) + (size_t)l * M * PLE);
        SEAM(pb + 6); PP_END(7);
        PP_BEGIN(8);
        if (PON(8) && IN(pb + 7)) for (int rep = 0; rep < DUPN(8); ++rep) {
            int kple = PLE; asm volatile("" : "+s"(kple));
            unsigned char* ws = WSP(); unsigned char* wl = ws + WS_W + (size_t)l * W_LAYER; unsigned char* big = ws + WS_BIG;
            pg8::Gemm g{(const pg8::bf16_t*)(big + BO_PB), (const pg8::bf16_t*)(wl + WO_PLE), M, DM, kple}; pg8::StaticOrder S; S.init(M, DM, F.G, (int)blockIdx.x);
            pg8::EpiPlain E{(pg8::bf16_t*)(big + BO_E), DM};
            pg8::gemm_phase<pg8::EpiPlain, pg8::StaticOrder, true, true>(F.lds + RING_OFF, g, S, E, F.wave_id);
        }
        SEAM(pb + 7); PP_END(8);
        PP_BEGIN(9);
        if (PON(9) && IN(pb + 8)) for (int rep = 0; rep < DUPN(9); ++rep) {
            unsigned char* ws = WSP(); unsigned char* wl = ws + WS_W + (size_t)l * W_LAYER; unsigned char* big = ws + WS_BIG;
            pg8::Gemm g{(const pg8::bf16_t*)(ws + WS_HB), (const pg8::bf16_t*)(wl + WO_GATE), M, DM, DM}; pg8::StaticOrder S; S.init(M, DM, F.G, (int)blockIdx.x);
            pg8::EpiY E{(pg8::bf16_t*)(ws + WS_Y), (float*)(ws + WS_SS), (const pg8::bf16_t*)(big + BO_E), 1.0f};
            pg8::gemm_phase<pg8::EpiY, pg8::StaticOrder, true, true>(F.lds + RING_OFF, g, S, E, F.wave_id);
        }
        SEAM(pb + 8); PP_END(9);
        PP_BEGIN(10);
        if (PON(10) && IN(pb + 9)) thin_phase(F, l == DEPTH - 1 ? (float*)LDP(15) : nullptr, LDP(13) + (size_t)l * DM, nullptr);
        SEAM(pb + 9); PP_END(10);
    }
    if (PROF_PHASE != 0) { pp_acc = __builtin_amdgcn_readfirstlane(pp_acc); const unsigned t0 = (unsigned)__builtin_amdgcn_s_memrealtime(); while ((unsigned)__builtin_amdgcn_s_memrealtime() - t0 < pp_acc) __builtin_amdgcn_s_sleep(4); }
#undef IN
#undef SEAM
}

extern "C" void kernel_launch(void* const* d_in, const int* in_sizes, int n_in, void* d_out, int out_size, void* d_ws, size_t ws_size, hipStream_t stream) {
    static int grid = 0;
    if (grid == 0) {
        if (n_in != 15 || out_size != M * DM || ws_size < WS_END) { fprintf(stderr, "kernel_launch: unexpected shapes (n_in %d, out %d, ws %zu, need %zu)\n", n_in, out_size, ws_size, (size_t)WS_END); grid = -1; return; }
        int dev = 0, cus = 0, per_cu = 0;
        if (hipGetDevice(&dev) != hipSuccess || hipDeviceGetAttribute(&cus, hipDeviceAttributeMultiprocessorCount, dev) != hipSuccess) { grid = -1; return; }
        if (hipFuncSetAttribute((const void*)hyb_fwd, hipFuncAttributeMaxDynamicSharedMemorySize, LDS_BYTES) != hipSuccess) { fprintf(stderr, "kernel_launch: hipFuncSetAttribute failed\n"); grid = -1; return; }
        if (hipOccupancyMaxActiveBlocksPerMultiprocessor(&per_cu, (const void*)hyb_fwd, NWAVES * 64, LDS_BYTES) != hipSuccess || per_cu < 1)
            fprintf(stderr, "kernel_launch: note: occupancy query reports %d workgroups per CU\n", per_cu);
        (void)hipGetLastError();
        grid = cus;
    }
    if (grid < 0) return;
    if (hipMemsetAsync((char*)d_ws + WS_CTL, 0, CTL_ZERO_BYTES, stream) != hipSuccess) return;
    Args a{};
    for (int i = 0; i < 15; ++i) a.in[i] = d_in[i];
    a.out = (float*)d_out; a.ws = (unsigned char*)d_ws;
    for (int li = 0; li < N_LAUNCHES; ++li) {
        a.ph_lo = (N_LAUNCHES == 1) ? 0 : li; a.ph_hi = (N_LAUNCHES == 1) ? NPH : li + 1; a.li = li; a.pad = 0;
        hipLaunchKernelGGL(hyb_fwd, dim3(grid), dim3(NWAVES * 64), LDS_BYTES, stream, a);
        if (hipPeekAtLastError() != hipSuccess) { fprintf(stderr, "kernel_launch: launch %d failed\n", li); break; }
    }
}
```
